# Optimizing an MI355X kernel written in HIP

```python
import jax, jax.numpy as jnp
from jax import lax
import numpy as np

D_MODEL = 2048
BATCH = 4
SEQ = 4096
DEPTH = 1

GRID_W = 64
D_MIX = D_MODEL
D_RWKV = D_MIX // 2
D_NA = D_MIX - D_RWKV
HEAD_DIM = 64
H_RWKV = D_RWKV // HEAD_DIM
H_NA = D_NA // HEAD_DIM
DECAY_LORA = 64
AAA_LORA = 64
GATE_LORA = 160
TOKEN_SHIFT_TAPS = 3
RWKV_IN = 3 * D_RWKV + 2 * DECAY_LORA + 2 * AAA_LORA + GATE_LORA
D_IN = RWKV_IN + 3 * D_NA
GN_EPS = 64e-5
L2_EPS = 1e-12
WIN_R = 8
WIN_C = 16
Q_BLOCK_C = 16
K_BLOCK_C = Q_BLOCK_C + WIN_C
N_COL_BLOCKS = GRID_W // Q_BLOCK_C
N_EXPERTS = 64
TOP_K = 6
EXPERT_FF = 512
SHARED_FF = EXPERT_FF
N_GROUPS = 8
TOPK_GROUPS = 4
ROUTED_SCALE = 2.5
DISPATCH_BLOCK = 256
NORM_EPS = 1e-6

kernel_name = 'hybrid_rwkv7_natten_moe_adaln_encoder'


def rms_norm(x, w, eps=NORM_EPS):
    xf = x.astype(jnp.float32)
    y = xf * lax.rsqrt(jnp.mean(xf * xf, axis=-1, keepdims=True) + eps)
    return (y * w.astype(jnp.float32)).astype(x.dtype)


def swiglu(x, w_gate, w_up, w_down):
    return (jax.nn.silu(x @ w_gate) * (x @ w_up)) @ w_down


def centred_shift(t, w):
    tp = jnp.pad(t, ((0, 0), (1, 1), (0, 0)))
    return w[0] * tp[:, :-2] + w[1] * tp[:, 1:-1] + w[2] * tp[:, 2:]


def wkv_scan(r, w, k, v, a, b, reverse):
    bn, sn, h, n = r.shape
    xs = tuple(jnp.moveaxis(t.astype(jnp.float32), 1, 0) for t in (r, w, k, v, a, b))

    def step(state, inp):
        r_t, w_t, k_t, v_t, a_t, b_t = inp

        def update(st):
            sa = jnp.einsum('bhij,bhj->bhi', st, a_t)
            return (st * w_t[:, :, None, :] + sa[..., None] * b_t[:, :, None, :]
                    + v_t[..., None] * k_t[:, :, None, :])

        if reverse:
            y = jnp.einsum('bhij,bhj->bhi', state, r_t)
            state = update(state)
        else:
            state = update(state)
            y = jnp.einsum('bhij,bhj->bhi', state, r_t)
        return state, y

    s0 = jnp.zeros((bn, h, n, n), jnp.float32)
    _, ys = lax.scan(step, s0, xs, reverse=reverse)
    return jnp.moveaxis(ys, 0, 1).astype(r.dtype)


def rwkv7_bidirectional(z, shift_w, w0_f, w_up_f, w0_b, w_up_b, a0_f, a_up_f, a0_b, a_up_b,
                        g_up, k_k, k_a, r_k, ln_w, ln_b):
    bn, sn, _ = z.shape
    z = centred_shift(z, shift_w)
    sizes = [D_RWKV, D_RWKV, D_RWKV, DECAY_LORA, DECAY_LORA, AAA_LORA, AAA_LORA, GATE_LORA]
    r, k, v, wd_f, wd_b, ad_f, ad_b, gd = jnp.split(z, list(np.cumsum(sizes)[:-1]), axis=-1)

    def heads(t):
        return t.reshape(bn, sn, H_RWKV, HEAD_DIM)

    g = jax.nn.sigmoid(gd) @ g_up
    kk = heads(k * k_k).astype(jnp.float32)
    kk = kk * lax.rsqrt(jnp.maximum(jnp.sum(kk * kk, axis=-1, keepdims=True), L2_EPS))

    def direction(w0, w_up, wd, a0, a_up, ad, reverse):
        w_log = -jax.nn.softplus(-(w0 + jnp.tanh(wd) @ w_up)) - 0.5
        decay = jnp.exp(-jnp.exp(w_log))
        a = jax.nn.sigmoid(a0 + ad @ a_up)
        k_dir = k * (1 + (a - 1) * k_a)
        y = wkv_scan(heads(r), heads(decay), heads(k_dir), heads(v), -kk, kk * heads(a), reverse)
        return y, k_dir

    y_f, k_f = direction(w0_f, w_up_f, wd_f, a0_f, a_up_f, ad_f, False)
    y_b, _ = direction(w0_b, w_up_b, wd_b, a0_b, a_up_b, ad_b, True)
    y = (y_f + y_b).astype(jnp.float32)
    mu = jnp.mean(y, axis=-1, keepdims=True)
    var = jnp.mean(jnp.square(y - mu), axis=-1, keepdims=True)
    y = ((y - mu) * lax.rsqrt(var + GN_EPS)).reshape(bn, sn, D_RWKV) * ln_w + ln_b
    bonus = jnp.sum(heads(r) * heads(k_f) * r_k, axis=-1, keepdims=True) * heads(v)
    return (y.astype(z.dtype) + bonus.reshape(bn, sn, D_RWKV)) * g


def neighbourhood_attention_2d(q, k, v, q_norm_w, k_norm_w, rel_bias):
    bn, sn, _ = q.shape
    rows = sn // GRID_W
    kr = min(WIN_R, rows)

    def grid(t):
        return t.reshape(bn, rows, GRID_W, H_NA, HEAD_DIM)

    qg = rms_norm(grid(q), q_norm_w) * (HEAD_DIM ** -0.5)
    kg = rms_norm(grid(k), k_norm_w)
    vg = grid(v)
    q_cols = np.arange(GRID_W).reshape(N_COL_BLOCKS, Q_BLOCK_C)
    win_c0 = np.clip(q_cols - WIN_C // 2, 0, GRID_W - WIN_C)
    key_c0 = np.clip(np.arange(N_COL_BLOCKS) * Q_BLOCK_C - WIN_C // 2, 0, GRID_W - K_BLOCK_C)
    key_cols = key_c0[:, None] + np.arange(K_BLOCK_C)
    col_valid = ((key_cols[:, None, :] >= win_c0[:, :, None])
                 & (key_cols[:, None, :] < win_c0[:, :, None] + WIN_C))
    col_off = np.clip(key_cols[:, None, :] - q_cols[:, :, None] + WIN_C - 1, 0, 2 * WIN_C - 2)
    col_bias = rel_bias[:, :, col_off].astype(jnp.float32)
    k_cb = kg[:, :, key_cols]
    v_cb = vg[:, :, key_cols]

    def row_block(i):
        rs = jnp.clip(i - kr // 2, 0, rows - kr)
        kb = lax.dynamic_slice_in_dim(k_cb, rs, kr, axis=1).astype(jnp.float32)
        vb = lax.dynamic_slice_in_dim(v_cb, rs, kr, axis=1)
        qi = lax.dynamic_index_in_dim(qg, i, axis=1, keepdims=False)
        qi = qi.reshape(bn, N_COL_BLOCKS, Q_BLOCK_C, H_NA, HEAD_DIM).astype(jnp.float32)
        s = jnp.einsum('bcqhd,brckhd->bhcqrk', qi, kb)
        row_off = rs + jnp.arange(kr) - i + WIN_R - 1
        bias = jnp.transpose(col_bias[:, row_off], (0, 2, 3, 1, 4))
        s = jnp.where(col_valid[None, None, :, :, None, :], s + bias[None], -jnp.inf)
        p = jax.nn.softmax(s.reshape(s.shape[:4] + (kr * K_BLOCK_C,)), axis=-1)
        p = p.reshape(s.shape).astype(vb.dtype)
        o = jnp.einsum('bhcqrk,brckhd->bcqhd', p, vb)
        return o.reshape(bn, GRID_W, D_NA)

    out = lax.map(row_block, jnp.arange(rows))
    return jnp.transpose(out, (1, 0, 2, 3)).reshape(bn, sn, D_NA)


def routed_experts(h, w_router, router_bias, w_gate_e, w_up_e, w_down_e):
    t, d = h.shape
    scores = jax.nn.sigmoid(h.astype(jnp.float32) @ w_router.astype(jnp.float32))
    biased = scores + router_bias.astype(jnp.float32)
    grp_score = jnp.sum(lax.top_k(biased.reshape(t, N_GROUPS, -1), 2)[0], axis=-1)
    _, top_g = lax.top_k(grp_score, TOPK_GROUPS)
    gmask = jnp.any(top_g[:, :, None] == jnp.arange(N_GROUPS)[None, None, :], axis=1)
    masked = jnp.where(jnp.repeat(gmask, N_EXPERTS // N_GROUPS, axis=1), biased, -jnp.inf)
    _, idx = lax.top_k(masked, TOP_K)
    gw = jnp.take_along_axis(scores, idx, axis=1)
    gw = gw / jnp.sum(gw, axis=-1, keepdims=True) * ROUTED_SCALE

    m = DISPATCH_BLOCK
    n_assign = t * TOP_K
    flat_e = idx.reshape(-1)
    flat_tok = jnp.repeat(jnp.arange(t, dtype=jnp.int32), TOP_K)
    flat_w = gw.reshape(-1)
    order = jnp.argsort(flat_e)
    e_s, tok_s, w_s = flat_e[order], flat_tok[order], flat_w[order]
    counts = jnp.bincount(flat_e, length=N_EXPERTS)
    padded = (counts + m - 1) // m * m
    pad_end = jnp.cumsum(padded)
    pad_start = pad_end - padded
    start = jnp.cumsum(counts) - counts
    dest = pad_start[e_s] + jnp.arange(n_assign) - start[e_s]
    n_blocks = -(-(n_assign + N_EXPERTS * m) // m)
    total = n_blocks * m
    buf_tok = jnp.zeros((total,), jnp.int32).at[dest].set(tok_s)
    buf_w = jnp.zeros((total,), h.dtype).at[dest].set(w_s.astype(h.dtype))
    block_e = jnp.minimum(jnp.searchsorted(pad_end, jnp.arange(n_blocks) * m, side='right'),
                          N_EXPERTS - 1)

    def expert_block(args):
        e, tok, w = args
        y = swiglu(h[tok], w_gate_e[e], w_up_e[e], w_down_e[e])
        return y * w[:, None].astype(y.dtype)

    ys = lax.map(expert_block, (block_e, buf_tok.reshape(n_blocks, m), buf_w.reshape(n_blocks, m)))
    return jnp.zeros_like(h).at[buf_tok].add(ys.reshape(total, d).astype(h.dtype))


def setup_inputs(seed: int = 0) -> dict:
    key = jax.random.key(seed)
    ks = iter(jax.random.split(key, 40))
    L = DEPTH

    def nrm(shape, scale):
        return jax.random.normal(next(ks), shape, jnp.float32) * scale

    def gain(shape):
        return 1.0 + nrm(shape, 0.1)

    shift_base = jnp.array([0.25, 0.5, 0.25], jnp.float32)[None, :, None]
    return {
        'x': nrm((BATCH, SEQ, D_MODEL), 1.0),
        'c': nrm((BATCH, D_MODEL), 1.0),
        'w_ada': nrm((L, D_MODEL, 6 * D_MODEL), 0.5 * D_MODEL ** -0.5),
        'b_ada': nrm((L, 6 * D_MODEL), 0.02),
        'norm1_w': gain((L, D_MODEL)),
        'w_in': nrm((L, D_MODEL, D_IN), D_MODEL ** -0.5),
        'rwkv_shift': shift_base + nrm((L, TOKEN_SHIFT_TAPS, RWKV_IN), 0.1),
        'w0_f': jax.random.uniform(next(ks), (L, D_RWKV), jnp.float32, -4.0, 1.0),
        'w_up_f': nrm((L, DECAY_LORA, D_RWKV), 0.5 * DECAY_LORA ** -0.5),
        'w0_b': jax.random.uniform(next(ks), (L, D_RWKV), jnp.float32, -4.0, 1.0),
        'w_up_b': nrm((L, DECAY_LORA, D_RWKV), 0.5 * DECAY_LORA ** -0.5),
        'a0_f': nrm((L, D_RWKV), 0.5),
        'a_up_f': nrm((L, AAA_LORA, D_RWKV), 0.5 * AAA_LORA ** -0.5),
        'a0_b': nrm((L, D_RWKV), 0.5),
        'a_up_b': nrm((L, AAA_LORA, D_RWKV), 0.5 * AAA_LORA ** -0.5),
        'g_up': nrm((L, GATE_LORA, D_RWKV), GATE_LORA ** -0.5),
        'k_k': 0.85 + nrm((L, D_RWKV), 0.1),
        'k_a': gain((L, D_RWKV)),
        'r_k': nrm((L, H_RWKV, HEAD_DIM), 0.1),
        'ln_x_w': gain((L, D_RWKV)),
        'ln_x_b': nrm((L, D_RWKV), 0.02),
        'q_norm_w': gain((L, HEAD_DIM)),
        'k_norm_w': gain((L, HEAD_DIM)),
        'rel_bias': nrm((L, H_NA, 2 * WIN_R - 1, 2 * WIN_C - 1), 0.2),
        'w_out': nrm((L, D_MIX, D_MODEL), D_MIX ** -0.5),
        'norm2_w': gain((L, D_MODEL)),
        'w_router': nrm((L, D_MODEL, N_EXPERTS), D_MODEL ** -0.5),
        'router_bias': nrm((L, N_EXPERTS), 0.01),
        'w_gate_e': nrm((L, N_EXPERTS, D_MODEL, EXPERT_FF), D_MODEL ** -0.5),
        'w_up_e': nrm((L, N_EXPERTS, D_MODEL, EXPERT_FF), D_MODEL ** -0.5),
        'w_down_e': nrm((L, N_EXPERTS, EXPERT_FF, D_MODEL), EXPERT_FF ** -0.5),
        'w_gate_s': nrm((L, D_MODEL, SHARED_FF), D_MODEL ** -0.5),
        'w_up_s': nrm((L, D_MODEL, SHARED_FF), D_MODEL ** -0.5),
        'w_down_s': nrm((L, SHARED_FF, D_MODEL), SHARED_FF ** -0.5),
    }


def reference(x, c, w_ada, b_ada, norm1_w, w_in, rwkv_shift, w0_f, w_up_f, w0_b, w_up_b,
              a0_f, a_up_f, a0_b, a_up_b, g_up, k_k, k_a, r_k, ln_x_w, ln_x_b,
              q_norm_w, k_norm_w, rel_bias, w_out, norm2_w, w_router, router_bias,
              w_gate_e, w_up_e, w_down_e, w_gate_s, w_up_s, w_down_s):
    bn, sn, d = x.shape
    for l in range(DEPTH):
        mod = jax.nn.silu(c) @ w_ada[l] + b_ada[l]
        shift1, scale1, gate1, shift2, scale2, gate2 = jnp.split(mod[:, None, :], 6, axis=-1)
        h = rms_norm(x, norm1_w[l]) * (1 + scale1) + shift1
        proj = h @ w_in[l]
        rwkv_in = proj[..., :RWKV_IN]
        q, k, v = jnp.split(proj[..., RWKV_IN:], 3, axis=-1)
        y_rwkv = rwkv7_bidirectional(rwkv_in, rwkv_shift[l], w0_f[l], w_up_f[l], w0_b[l], w_up_b[l],
                                     a0_f[l], a_up_f[l], a0_b[l], a_up_b[l], g_up[l],
                                     k_k[l], k_a[l], r_k[l], ln_x_w[l], ln_x_b[l])
        y_na = neighbourhood_attention_2d(q, k, v, q_norm_w[l], k_norm_w[l], rel_bias[l])
        x = x + gate1 * (jnp.concatenate([y_rwkv, y_na], axis=-1) @ w_out[l])
        h2 = (rms_norm(x, norm2_w[l]) * (1 + scale2) + shift2).reshape(bn * sn, d)
        y = swiglu(h2, w_gate_s[l], w_up_s[l], w_down_s[l]) + routed_experts(
            h2, w_router[l], router_bias[l], w_gate_e[l], w_up_e[l], w_down_e[l])
        x = x + gate2 * y.reshape(bn, sn, d)
    return x
```

```cpp
#include <hip/hip_runtime.h>
#include <stdint.h>
#include <stdio.h>

#ifndef DUP_PHASE
#define DUP_PHASE -1
#endif
#ifndef N_LAUNCH_SPLIT
#define N_LAUNCH_SPLIT 0
#endif

typedef unsigned short bf16_t;
typedef short bf16x8 __attribute__((ext_vector_type(8)));
typedef float f32x4 __attribute__((ext_vector_type(4)));
typedef unsigned u32x2 __attribute__((ext_vector_type(2)));
typedef int i32x4 __attribute__((ext_vector_type(4)));
typedef unsigned u32x4 __attribute__((ext_vector_type(4)));
typedef int i32x8 __attribute__((ext_vector_type(8)));
typedef unsigned char fp8_t;
typedef float f32x2 __attribute__((ext_vector_type(2)));
#define LAS __attribute__((address_space(3)))

constexpr int T_ = 16384, SEQ_ = 4096, NB_ = 4, D_ = 2048, DR_ = 1024;
constexpr int NPROJ = 6656;
constexpr int RWKV_IN_ = 3488;
constexpr int PC_R = 0, PC_K = 1024, PC_V = 2048, PC_L = 3072, PC_Q = 3584, PC_KN = 4608, PC_VN = 5632;
constexpr int NEXP = 64, TOPK = 6, EFF = 512, NSLOT = 7;
constexpr int LIST_CAP = 16384;
constexpr int NTHREADS = 512;
constexpr int GEMM_LDS = 131072;
constexpr int CTRL_OFF = 17 * 9216;
constexpr int DYN_LDS = CTRL_OFF + 1024;

#define XB_TMO      128
#define XB_XCNT(j)  (256  + 64 * (j))
#define XB_XSUB(j)  (1280 + 64 * (j))
#define XB_XGEN(j)  (2304 + 64 * (j))
#define XB_TOP      3328
#define XB_TOPGEN   3392
#define XCD_BAR_WORDS 3456
#define XB_SPIN_CAP (1u << 18)

__device__ __forceinline__ unsigned xb_ld(unsigned* p)              { return __hip_atomic_load(p, __ATOMIC_RELAXED, __HIP_MEMORY_SCOPE_AGENT); }
__device__ __forceinline__ unsigned xb_add(unsigned* p, unsigned v) { return __hip_atomic_fetch_add(p, v, __ATOMIC_RELAXED, __HIP_MEMORY_SCOPE_AGENT); }
__device__ __forceinline__ unsigned xb_xcc_id() { return (unsigned)__builtin_amdgcn_s_getreg((3 << 11) | 20) & 0xFu; }
#define XB_SPIN(cond, bar) do { unsigned _sp = 0; while (cond) { __builtin_amdgcn_s_sleep(1); \
    if ((++_sp & 255u) == 0u) { if (xb_ld(&(bar)[XB_TMO])) break; if (_sp > XB_SPIN_CAP) { atomicAdd(&(bar)[XB_TMO], 1u); break; } } } } while (0)

struct XcdBarrier { unsigned* bar; unsigned x; volatile LAS unsigned* st; };

__device__ __forceinline__ XcdBarrier xcd_barrier_post(unsigned* bar, volatile LAS unsigned* st) {
    XcdBarrier b; b.bar = bar; b.x = xb_xcc_id(); b.st = st;
    if (threadIdx.x == 0) (void)xb_add(&bar[XB_XCNT(b.x)], 1u);
    return b;
}
__device__ __forceinline__ void xcd_barrier_complete(unsigned* bar, unsigned x, unsigned& nloc, unsigned& nx) {
    const unsigned G = gridDim.x * gridDim.y * gridDim.z;
    unsigned sum, cnt, mine, sp = 0u;
    for (;;) {
        sum = 0u; cnt = 0u; mine = 0u;
#pragma unroll
        for (unsigned j = 0; j < 16; ++j) { const unsigned c = xb_ld(&bar[XB_XCNT(j)]); sum += c; cnt += (c > 0u) ? 1u : 0u; mine = (j == x) ? c : mine; }
        if (sum == G) break;
        __builtin_amdgcn_s_sleep(1);
        if ((++sp & 255u) == 0u) { if (xb_ld(&bar[XB_TMO])) break; if (sp > XB_SPIN_CAP) { atomicAdd(&bar[XB_TMO], 1u); break; } }
    }
    nloc = mine > 0u ? mine : 1u; nx = cnt > 0u ? cnt : 1u;
}
__device__ __forceinline__ void xcd_barrier(const XcdBarrier& b) {
    asm volatile("s_waitcnt vmcnt(0)" ::: "memory");
    __syncthreads();
    if (threadIdx.x == 0) {
        unsigned* bar = b.bar;
        __builtin_amdgcn_s_waitcnt(0);
        unsigned nloc = b.st[0], nx = b.st[1];
        if (nloc == 0u) { xcd_barrier_complete(bar, b.x, nloc, nx); b.st[0] = nloc; b.st[1] = nx; }
        const unsigned old = xb_add(&bar[XB_XSUB(b.x)], 1u);
        const unsigned gen = old / nloc;
        if (old + 1u == (gen + 1u) * nloc) {
            __builtin_amdgcn_fence(__ATOMIC_RELEASE, "agent");
            asm volatile("s_waitcnt vmcnt(0)" ::: "memory");
            const unsigned og = xb_add(&bar[XB_TOP], 1u);
            const unsigned tg = og / nx;
            if (og + 1u == (tg + 1u) * nx) xb_add(&bar[XB_TOPGEN], 1u);
            else XB_SPIN(xb_ld(&bar[XB_TOPGEN]) == tg, bar);
            __builtin_amdgcn_fence(__ATOMIC_ACQUIRE, "agent");
            xb_add(&bar[XB_XGEN(b.x)], 1u);
            asm volatile("s_waitcnt vmcnt(0)" ::: "memory");
        } else {
            XB_SPIN(xb_ld(&bar[XB_XGEN(b.x)]) == gen, bar);
            __builtin_amdgcn_fence(__ATOMIC_ACQUIRE, "agent");
            asm volatile("s_waitcnt vmcnt(0)" ::: "memory");
        }
    }
    __syncthreads();
}

struct Params {
    const float *x, *c, *w_ada, *b_ada, *norm1_w, *w_in, *rwkv_shift, *w0_f, *w_up_f, *w0_b, *w_up_b, *a0_f, *a_up_f, *a0_b, *a_up_b,
                *g_up, *k_k, *k_a, *r_k, *ln_w, *ln_b, *qn_w, *kn_w, *rel_bias, *w_out, *norm2_w, *w_router, *router_bias,
                *w_gate_e, *w_up_e, *w_down_e, *w_gate_s, *w_up_s, *w_down_s;
    float* out;
    unsigned* bar; float* mod; unsigned* cnt; float* lbias; unsigned* qctr;
    bf16_t *Wlora, *H, *Win, *Wout, *proj, *Alora, *QN, *KN, *VT, *ycat, *LO;
    fp8_t *We1q, *We2q, *Ws1q, *Ws2q, *H8, *actq;
    bf16_t *rb, *kb, *vb, *kkb;
    fp8_t *slot; unsigned* list; float* gw;
    float* ssq;
    long long ph_lo, ph_hi;
};

extern __shared__ __attribute__((aligned(16))) char dynlds[];

__device__ __forceinline__ int opaque_tid() { int t = threadIdx.x; asm volatile("" : "+v"(t)); return t; }
typedef __bf16 bf16x2_t __attribute__((ext_vector_type(2)));
__device__ __forceinline__ unsigned pk2(float lo, float hi) { bf16x2_t v = {(__bf16)lo, (__bf16)hi}; return __builtin_bit_cast(unsigned, v); }
__device__ __forceinline__ float bflo(unsigned u) { return __uint_as_float(u << 16); }
__device__ __forceinline__ float bfhi(unsigned u) { return __uint_as_float(u & 0xffff0000u); }
__device__ __forceinline__ void unpack8(const uint4& u, float (&f)[8]) {
    f[0] = bflo(u.x); f[1] = bfhi(u.x); f[2] = bflo(u.y); f[3] = bfhi(u.y); f[4] = bflo(u.z); f[5] = bfhi(u.z); f[6] = bflo(u.w); f[7] = bfhi(u.w);
}
__device__ __forceinline__ u32x4 pack8v(const float (&f)[8]) { u32x4 r; r.x = pk2(f[0], f[1]); r.y = pk2(f[2], f[3]); r.z = pk2(f[4], f[5]); r.w = pk2(f[6], f[7]); return r; }
__device__ __forceinline__ uint4 pack8(const float (&f)[8]) { uint4 r; r.x = pk2(f[0], f[1]); r.y = pk2(f[2], f[3]); r.z = pk2(f[4], f[5]); r.w = pk2(f[6], f[7]); return r; }
__device__ __forceinline__ float clamp448(float x) { return fminf(fmaxf(x, -448.0f), 448.0f); }
__device__ __forceinline__ unsigned pk4_fp8(float a, float b, float c, float d) {
    int w = 0;
    w = __builtin_amdgcn_cvt_pk_fp8_f32(clamp448(a), clamp448(b), w, false);
    w = __builtin_amdgcn_cvt_pk_fp8_f32(clamp448(c), clamp448(d), w, true);
    return (unsigned)w;
}
template <int CTRL> __device__ __forceinline__ float dppf(float x) { return __builtin_bit_cast(float, __builtin_amdgcn_mov_dpp(__builtin_bit_cast(int, x), CTRL, 0xf, 0xf, true)); }
__device__ __forceinline__ float red8_sum(float v)  { v += dppf<0xB1>(v); v += dppf<0x4E>(v); v += dppf<0x141>(v); return v; }
__device__ __forceinline__ float red16_sum(float v) { v += dppf<0xB1>(v); v += dppf<0x4E>(v); v += dppf<0x141>(v); v += dppf<0x128>(v); return v; }
__device__ __forceinline__ float red8_max(float v)  { v = fmaxf(v, dppf<0xB1>(v)); v = fmaxf(v, dppf<0x4E>(v)); v = fmaxf(v, dppf<0x141>(v)); return v; }
__device__ __forceinline__ float red16_max(float v) { v = fmaxf(v, dppf<0xB1>(v)); v = fmaxf(v, dppf<0x4E>(v)); v = fmaxf(v, dppf<0x141>(v)); v = fmaxf(v, dppf<0x128>(v)); return v; }
__device__ __forceinline__ float wave_sum(float v) {
#pragma unroll
    for (int o = 1; o < 64; o <<= 1) v += __shfl_xor(v, o);
    return v;
}
__device__ __forceinline__ float wave_max(float v) {
#pragma unroll
    for (int o = 1; o < 64; o <<= 1) v = fmaxf(v, __shfl_xor(v, o));
    return v;
}
__device__ __forceinline__ float sigmoidf_(float x) { return 1.0f / (1.0f + __expf(-x)); }

constexpr int BK = 64, HALF = 128, HTB = HALF * BK * 2;
__device__ __forceinline__ int lds_byte(int r, int c) {
    int st = (r >> 4) * 2 + (c >> 5), rr = r & 15, cc = c & 31, ob = rr * 64 + cc * 2;
    return st * 1024 + (ob ^ (((ob >> 9) & 1) << 5));
}
__device__ __forceinline__ void stage_rc(int b, int& R, int& C) {
    int st = b / 1024, sb = b % 1024, swz = sb ^ (((sb >> 9) & 1) << 5);
    R = (st >> 1) * 16 + swz / 64; C = (st & 1) * 32 + (swz % 64) / 2;
}

#define G_SA(b, h) (((b) * 4 + (h)) * HTB)
#define G_SB(b, h) (((b) * 4 + 2 + (h)) * HTB)
#define G_STAGE(bufoff, gbase, v0, v1) do { \
    __builtin_amdgcn_global_load_lds((const unsigned*)((const char*)(gbase) + (v0)), (LAS unsigned*)(lds + (bufoff) + ldsw), 16, 0, 0); \
    __builtin_amdgcn_global_load_lds((const unsigned*)((const char*)(gbase) + (v1)), (LAS unsigned*)(lds + (bufoff) + ldsw + 8192), 16, 0, 0); } while (0)
#define G_STAGE_A(b, h, kt) G_STAGE(G_SA(b, h), Ab + (size_t)(kt) * (BK * 2), va[(h) * 2], va[(h) * 2 + 1])
#define G_STAGE_B(b, h, kt) G_STAGE(G_SB(b, h), Bb + (size_t)(h) * hstep + (size_t)(kt) * (BK * 2), vb0, vb1)
#define G_LD8(base) __builtin_shufflevector(*(const LAS i32x4*)(lds + (base)), *(const LAS i32x4*)(lds + (base) + 1024), 0, 1, 2, 3, 4, 5, 6, 7)
#define G_LDA(dst, b, h) do { _Pragma("unroll") for (int m = 0; m < 4; ++m) dst[m] = G_LD8(G_SA(b, h) + laoff + m * 2048); } while (0)
#define G_LDB(dst, b, h) do { _Pragma("unroll") for (int n = 0; n < 2; ++n) dst[n] = G_LD8(G_SB(b, h) + lboff + n * 2048); } while (0)
#define G_LO(v) __builtin_bit_cast(bf16x8, __builtin_shufflevector(v, v, 0, 1, 2, 3))
#define G_HI(v) __builtin_bit_cast(bf16x8, __builtin_shufflevector(v, v, 4, 5, 6, 7))
#define G_MMA(ai, bj, Af, Bf) do { __builtin_amdgcn_s_setprio(1); \
    if (FP8) { \
      _Pragma("unroll") for (int m = 0; m < 4; ++m) _Pragma("unroll") for (int n = 0; n < 2; ++n) \
        asm volatile("v_mfma_f32_16x16x128_f8f6f4 %0, %1, %2, %0" : "+v"(acc[ai][bj][m][n]) : "v"(Bf[n]), "v"(Af[m])); \
    } else { \
      _Pragma("unroll") for (int m = 0; m < 4; ++m) _Pragma("unroll") for (int n = 0; n < 2; ++n) { \
        acc[ai][bj][m][n] = __builtin_amdgcn_mfma_f32_16x16x32_bf16(G_LO(Bf[n]), G_LO(Af[m]), acc[ai][bj][m][n], 0, 0, 0); \
        acc[ai][bj][m][n] = __builtin_amdgcn_mfma_f32_16x16x32_bf16(G_HI(Bf[n]), G_HI(Af[m]), acc[ai][bj][m][n], 0, 0, 0); } } \
    __builtin_amdgcn_s_setprio(0); } while (0)
#define G_WAIT_V(n) asm volatile("s_waitcnt vmcnt(" #n ")" ::: "memory")
#define G_WAIT_L(n) asm volatile("s_waitcnt lgkmcnt(" #n ")" ::: "memory")
#define G_BAR __builtin_amdgcn_s_barrier()
#define G_SCHED __builtin_amdgcn_sched_barrier(0)

__device__ __forceinline__ int gemm_stage_row(int tid, int i) { int R, C; stage_rc(tid * 16 + i * 8192, R, C); return R; }
__device__ __forceinline__ int gemm_stage_col(int tid, int i) { int R, C; stage_rc(tid * 16 + i * 8192, R, C); return C; }

template <bool FP8, class Epi>
__device__ __forceinline__ void gemm_unit(const void* __restrict__ A, const unsigned (&aoffb)[4], const void* __restrict__ Bt, const int PITCH, const Epi& epi, const int NT = 0) {
    LAS unsigned char* lds = (LAS unsigned char*)dynlds;
    const int tid = opaque_tid();
    const int wid = __builtin_amdgcn_readfirstlane(tid >> 6), lane = tid & 63, wr = wid >> 2, wc = wid & 3, fr = lane & 15, fq = lane >> 4;
    const unsigned va[4] = {aoffb[0], aoffb[1], aoffb[2], aoffb[3]};
    unsigned vb0, vb1;
    { int R0, C0, R1, C1; stage_rc(tid * 16, R0, C0); stage_rc(tid * 16 + 8192, R1, C1); vb0 = (unsigned)(R0 * PITCH + C0 * 2); vb1 = (unsigned)(R1 * PITCH + C1 * 2); }
    const char* Ab = (const char*)A; const char* Bb = (const char*)Bt;
    const size_t hstep = (size_t)HALF * PITCH;
    const unsigned ldsw = (unsigned)wid * 1024u;
    const int laoff = lds_byte(wr * 64 + fr, fq * 8), lboff = lds_byte(wc * 32 + fr, fq * 8);
    f32x4 acc[2][2][4][2];
#pragma unroll
    for (int a = 0; a < 2; ++a)
#pragma unroll
        for (int b = 0; b < 2; ++b)
#pragma unroll
            for (int m = 0; m < 4; ++m)
#pragma unroll
                for (int n = 0; n < 2; ++n) acc[a][b][m][n] = (f32x4){0.f, 0.f, 0.f, 0.f};
    i32x8 At[4], B0[2], B1[2];
    const int nt = NT ? NT : PITCH / (BK * 2);
    __syncthreads();
    G_STAGE_B(0, 0, 0); G_STAGE_A(0, 0, 0); G_STAGE_B(0, 1, 0); G_STAGE_A(0, 1, 0);
    if (wr == 1) G_BAR;
    G_WAIT_V(4); G_BAR;
    G_STAGE_B(1, 0, 1); G_STAGE_A(1, 0, 1); G_STAGE_B(1, 1, 1);
    G_WAIT_V(6); G_BAR;
    for (int t = 0; t < nt - 2; t += 2) {
        G_LDB(B0, 0, 0); G_SCHED; G_LDA(At, 0, 0); G_STAGE_A(1, 1, t + 1);
        G_WAIT_L(8); G_BAR; G_WAIT_L(0); G_MMA(0, 0, At, B0); G_BAR; G_SCHED;
        G_LDB(B1, 0, 1); G_STAGE_B(0, 0, t + 2);
        G_BAR; G_WAIT_L(0); G_MMA(0, 1, At, B1); G_BAR;
        G_LDA(At, 0, 1); G_STAGE_A(0, 0, t + 2);
        G_BAR; G_WAIT_L(0); G_MMA(1, 0, At, B0); G_BAR; G_SCHED;
        G_STAGE_B(0, 1, t + 2);
        G_WAIT_V(6); G_BAR; G_MMA(1, 1, At, B1); G_BAR;
        G_LDB(B0, 1, 0); G_SCHED; G_LDA(At, 1, 0); G_STAGE_A(0, 1, t + 2);
        G_WAIT_L(8); G_BAR; G_WAIT_L(0); G_MMA(0, 0, At, B0); G_BAR; G_SCHED;
        G_LDB(B1, 1, 1); G_STAGE_B(1, 0, t + 3);
        G_BAR; G_WAIT_L(0); G_MMA(0, 1, At, B1); G_BAR;
        G_LDA(At, 1, 1); G_STAGE_A(1, 0, t + 3);
        G_BAR; G_WAIT_L(0); G_MMA(1, 0, At, B0); G_BAR; G_SCHED;
        G_STAGE_B(1, 1, t + 3);
        G_WAIT_V(6); G_BAR; G_MMA(1, 1, At, B1); G_BAR;
    }
    { G_LDB(B0, 0, 0); G_WAIT_V(0); G_LDA(At, 0, 0); G_STAGE_A(1, 1, nt - 1);
      G_BAR; G_WAIT_L(0); G_MMA(0, 0, At, B0); G_BAR;
      G_LDB(B1, 0, 1); G_BAR; G_WAIT_L(0); G_MMA(0, 1, At, B1); G_BAR;
      G_LDA(At, 0, 1); G_WAIT_V(4); G_BAR; G_WAIT_L(0); G_MMA(1, 0, At, B0); G_MMA(1, 1, At, B1); G_BAR; }
    { G_LDB(B0, 1, 0); G_LDA(At, 1, 0); G_WAIT_V(2); G_BAR; G_WAIT_L(0); G_MMA(0, 0, At, B0); G_BAR;
      G_LDB(B1, 1, 1); G_WAIT_V(0); G_BAR; G_WAIT_L(0); G_MMA(0, 1, At, B1); G_BAR;
      G_LDA(At, 1, 1); G_BAR; G_WAIT_L(0); G_MMA(1, 0, At, B0); G_MMA(1, 1, At, B1); G_BAR; }
    if (wr == 0) G_BAR;
    if (FP8) asm volatile("s_nop 15\n\ts_nop 15" ::: "memory");
    {
        int tz = threadIdx.x; asm volatile("" : "+v"(tz));
        const int wid2 = tz >> 6, lane2 = tz & 63;
        epi(acc, wid2 >> 2, wid2 & 3, lane2 & 15, lane2 >> 4);
    }
    __syncthreads();
}

template <bool FP8, int EPI_STORES, class Epi>
__device__ __forceinline__ void gemm_unit_pre(const void* __restrict__ A, const unsigned (&aoffb)[4], const void* __restrict__ Bt, const int PITCH, const Epi& epi,
                                              const bool staged, const bool has_next, const void* __restrict__ nA, const void* __restrict__ nB) {
    constexpr int NT = 0;
    LAS unsigned char* lds = (LAS unsigned char*)dynlds;
    const int tid = opaque_tid();
    const int wid = __builtin_amdgcn_readfirstlane(tid >> 6), lane = tid & 63, wr = wid >> 2, wc = wid & 3, fr = lane & 15, fq = lane >> 4;
    const unsigned va[4] = {aoffb[0], aoffb[1], aoffb[2], aoffb[3]};
    unsigned vb0, vb1;
    { int R0, C0, R1, C1; stage_rc(tid * 16, R0, C0); stage_rc(tid * 16 + 8192, R1, C1); vb0 = (unsigned)(R0 * PITCH + C0 * 2); vb1 = (unsigned)(R1 * PITCH + C1 * 2); }
    const char* Ab = (const char*)A; const char* Bb = (const char*)Bt;
    const size_t hstep = (size_t)HALF * PITCH;
    const unsigned ldsw = (unsigned)wid * 1024u;
    const int laoff = lds_byte(wr * 64 + fr, fq * 8), lboff = lds_byte(wc * 32 + fr, fq * 8);
    f32x4 acc[2][2][4][2];
#pragma unroll
    for (int a = 0; a < 2; ++a)
#pragma unroll
        for (int b = 0; b < 2; ++b)
#pragma unroll
            for (int m = 0; m < 4; ++m)
#pragma unroll
                for (int n = 0; n < 2; ++n) acc[a][b][m][n] = (f32x4){0.f, 0.f, 0.f, 0.f};
    i32x8 At[4], B0[2], B1[2];
    const int nt = NT ? NT : PITCH / (BK * 2);
    if (!staged) {
        __syncthreads();
        G_STAGE_B(0, 0, 0); G_STAGE_A(0, 0, 0); G_STAGE_B(0, 1, 0); G_STAGE_A(0, 1, 0);
        if (wr == 1) G_BAR;
        G_WAIT_V(4); G_BAR;
    } else {
        static_assert(EPI_STORES == 8, "the counted wait below is written for 8 stores");
        if (wr == 1) G_BAR;
        G_WAIT_V(8); G_BAR;
    }
    G_STAGE_B(1, 0, 1); G_STAGE_A(1, 0, 1); G_STAGE_B(1, 1, 1);
    G_WAIT_V(6); G_BAR;
    for (int t = 0; t < nt - 2; t += 2) {
        G_LDB(B0, 0, 0); G_SCHED; G_LDA(At, 0, 0); G_STAGE_A(1, 1, t + 1);
        G_WAIT_L(8); G_BAR; G_WAIT_L(0); G_MMA(0, 0, At, B0); G_BAR; G_SCHED;
        G_LDB(B1, 0, 1); G_STAGE_B(0, 0, t + 2);
        G_BAR; G_WAIT_L(0); G_MMA(0, 1, At, B1); G_BAR;
        G_LDA(At, 0, 1); G_STAGE_A(0, 0, t + 2);
        G_BAR; G_WAIT_L(0); G_MMA(1, 0, At, B0); G_BAR; G_SCHED;
        G_STAGE_B(0, 1, t + 2);
        G_WAIT_V(6); G_BAR; G_MMA(1, 1, At, B1); G_BAR;
        G_LDB(B0, 1, 0); G_SCHED; G_LDA(At, 1, 0); G_STAGE_A(0, 1, t + 2);
        G_WAIT_L(8); G_BAR; G_WAIT_L(0); G_MMA(0, 0, At, B0); G_BAR; G_SCHED;
        G_LDB(B1, 1, 1); G_STAGE_B(1, 0, t + 3);
        G_BAR; G_WAIT_L(0); G_MMA(0, 1, At, B1); G_BAR;
        G_LDA(At, 1, 1); G_STAGE_A(1, 0, t + 3);
        G_BAR; G_WAIT_L(0); G_MMA(1, 0, At, B0); G_BAR; G_SCHED;
        G_STAGE_B(1, 1, t + 3);
        G_WAIT_V(6); G_BAR; G_MMA(1, 1, At, B1); G_BAR;
    }
    { G_LDB(B0, 0, 0); G_WAIT_V(0); G_LDA(At, 0, 0); G_STAGE_A(1, 1, nt - 1);
      G_BAR; G_WAIT_L(0); G_MMA(0, 0, At, B0); G_BAR;
      G_LDB(B1, 0, 1); G_BAR; G_WAIT_L(0); G_MMA(0, 1, At, B1); G_BAR;
      G_LDA(At, 0, 1); G_WAIT_V(4); G_BAR; G_WAIT_L(0); G_MMA(1, 0, At, B0); G_MMA(1, 1, At, B1); G_BAR; }
    { G_LDB(B0, 1, 0); G_LDA(At, 1, 0); G_WAIT_V(2); G_BAR; G_WAIT_L(0); G_MMA(0, 0, At, B0); G_BAR;
      G_LDB(B1, 1, 1); G_WAIT_V(0); G_BAR; G_WAIT_L(0); G_MMA(0, 1, At, B1); G_BAR;
      G_LDA(At, 1, 1); G_BAR; G_WAIT_L(0); G_MMA(1, 0, At, B0); G_MMA(1, 1, At, B1); G_BAR; }
    if (wr == 0) G_BAR;
    if (FP8) asm volatile("s_nop 15\n\ts_nop 15" ::: "memory");
    {
        int tz = threadIdx.x; asm volatile("" : "+v"(tz));
        const int wid2 = tz >> 6, lane2 = tz & 63;
        epi.stage(acc, wid2 >> 2, wid2 & 3, lane2 & 15, lane2 >> 4);
    }
    if (has_next) {
        const char* nAb = (const char*)nA; const char* nBb = (const char*)nB;
        int tz2 = threadIdx.x; asm volatile("" : "+v"(tz2));
        int R0, C0, R1, C1; stage_rc(tz2 * 16, R0, C0); stage_rc(tz2 * 16 + 8192, R1, C1);
        const unsigned o0 = (unsigned)(R0 * PITCH + C0 * 2), o1 = (unsigned)(R1 * PITCH + C1 * 2);
        const size_t hs = (size_t)HALF * PITCH;
        {
            const unsigned ldsw = (unsigned)(tz2 >> 6) * 1024u;
            G_STAGE(G_SB(0, 0), nBb, o0, o1); G_STAGE(G_SA(0, 0), nAb, o0, o1); G_STAGE(G_SB(0, 1), nBb + hs, o0, o1); G_STAGE(G_SA(0, 1), nAb + hs, o0, o1);
        }
    }
    epi.store();
    G_WAIT_L(0); G_BAR;
}


struct GUnit { const char* A; const char* B; int u0, u1, u2, u3; };
template <bool FP8, bool GATHER, class Sc>
__device__ __forceinline__ void gemm_stream(Sc& sc, const int PITCH, const int nt) {
    LAS unsigned char* lds = (LAS unsigned char*)dynlds;
    const int tid = opaque_tid();
    const int wid = __builtin_amdgcn_readfirstlane(tid >> 6), lane = tid & 63, wr = wid >> 2, wc = wid & 3, fr = lane & 15, fq = lane >> 4;
    unsigned vb0, vb1, vac[4], van[4];
    { int R0, C0, R1, C1; stage_rc(tid * 16, R0, C0); stage_rc(tid * 16 + 8192, R1, C1); vb0 = (unsigned)(R0 * PITCH + C0 * 2); vb1 = (unsigned)(R1 * PITCH + C1 * 2); }
    const size_t hstep = (size_t)HALF * PITCH, kstep = (size_t)(BK * 2);
    vac[0] = vb0; vac[1] = vb1; vac[2] = vb0 + (unsigned)hstep; vac[3] = vb1 + (unsigned)hstep;
    const unsigned ldsw = (unsigned)wid * 1024u;
    const int laoff = lds_byte(wr * 64 + fr, fq * 8), lboff = lds_byte(wc * 32 + fr, fq * 8);
    GUnit cur, nxt;
    if (!sc.next(0, cur, vac)) return;
    f32x4 acc[2][2][4][2];
#pragma unroll
    for (int a = 0; a < 2; ++a)
#pragma unroll
        for (int b = 0; b < 2; ++b)
#pragma unroll
            for (int m = 0; m < 4; ++m)
#pragma unroll
                for (int n = 0; n < 2; ++n) acc[a][b][m][n] = (f32x4){0.f, 0.f, 0.f, 0.f};
    i32x8 At[4], B0[2], B1[2];
    const char* cA = cur.A; const char* cB = cur.B;
#define S_STA(b, h, base, V) G_STAGE(G_SA(b, h), base, V[(h) * 2], V[(h) * 2 + 1])
#define S_STB(b, h, base) G_STAGE(G_SB(b, h), (base) + (size_t)(h) * hstep, vb0, vb1)
    __syncthreads();
    S_STB(0, 0, cB); S_STA(0, 0, cA, vac); S_STB(0, 1, cB); S_STA(0, 1, cA, vac);
    if (wr == 1) G_BAR;
    G_WAIT_V(4); G_BAR;
    S_STB(1, 0, cB + kstep); S_STA(1, 0, cA + kstep, vac); S_STB(1, 1, cB + kstep);
    G_WAIT_V(6); G_BAR;
    for (int ui = 0;; ++ui) {
        bool has_next;
        if (GATHER) has_next = sc.next(ui + 1, nxt, van); else { unsigned dummy[4]; has_next = sc.next(ui + 1, nxt, dummy); }
        const char* nA = has_next ? nxt.A : cA; const char* nB = has_next ? nxt.B : cB;
        if (GATHER && !has_next) { van[0] = vac[0]; van[1] = vac[1]; van[2] = vac[2]; van[3] = vac[3]; }
        for (int t = 0; t < nt; t += 2) {
            const bool last = (t == nt - 2);
            const char* a1 = cA + (size_t)(t + 1) * kstep;
            const char* a2 = last ? nA : cA + (size_t)(t + 2) * kstep; const char* b2 = last ? nB : cB + (size_t)(t + 2) * kstep;
            const char* a3 = a2 + kstep; const char* b3 = b2 + kstep;
            unsigned vx[4];
            if (GATHER) { vx[0] = last ? van[0] : vac[0]; vx[1] = last ? van[1] : vac[1]; vx[2] = last ? van[2] : vac[2]; vx[3] = last ? van[3] : vac[3]; }
            else { vx[0] = vac[0]; vx[1] = vac[1]; vx[2] = vac[2]; vx[3] = vac[3]; }
            G_LDB(B0, 0, 0); G_SCHED; G_LDA(At, 0, 0); S_STA(1, 1, a1, vac);
            G_WAIT_L(8); G_BAR; G_WAIT_L(0); G_MMA(0, 0, At, B0); G_BAR; G_SCHED;
            G_LDB(B1, 0, 1); S_STB(0, 0, b2);
            G_BAR; G_WAIT_L(0); G_MMA(0, 1, At, B1); G_BAR;
            G_LDA(At, 0, 1); S_STA(0, 0, a2, vx);
            G_BAR; G_WAIT_L(0); G_MMA(1, 0, At, B0); G_BAR; G_SCHED;
            S_STB(0, 1, b2);
            G_WAIT_V(6); G_BAR; G_MMA(1, 1, At, B1); G_BAR;
            G_LDB(B0, 1, 0); G_SCHED; G_LDA(At, 1, 0); S_STA(0, 1, a2, vx);
            G_WAIT_L(8); G_BAR; G_WAIT_L(0); G_MMA(0, 0, At, B0); G_BAR; G_SCHED;
            G_LDB(B1, 1, 1); S_STB(1, 0, b3);
            G_BAR; G_WAIT_L(0); G_MMA(0, 1, At, B1); G_BAR;
            G_LDA(At, 1, 1); S_STA(1, 0, a3, vx);
            G_BAR; G_WAIT_L(0); G_MMA(1, 0, At, B0); G_BAR; G_SCHED;
            S_STB(1, 1, b3);
            G_WAIT_V(6); G_BAR; G_MMA(1, 1, At, B1); G_BAR;
        }
        if (FP8) asm volatile("s_nop 15\n\ts_nop 15" ::: "memory");
        {
            int tz = threadIdx.x; asm volatile("" : "+v"(tz));
            const int wid2 = tz >> 6, lane2 = tz & 63;
            sc.epilogue(acc, cur, wid2 >> 2, wid2 & 3, lane2 & 15, lane2 >> 4);
        }
        if (!has_next) break;
#pragma unroll
        for (int a = 0; a < 2; ++a)
#pragma unroll
            for (int b = 0; b < 2; ++b)
#pragma unroll
                for (int m = 0; m < 4; ++m)
#pragma unroll
                    for (int n = 0; n < 2; ++n) acc[a][b][m][n] = (f32x4){0.f, 0.f, 0.f, 0.f};
        cur = nxt; cA = nA; cB = nB;
        if (GATHER) { vac[0] = van[0]; vac[1] = van[1]; vac[2] = van[2]; vac[3] = van[3]; }
    }
    G_WAIT_V(0);
    if (wr == 0) G_BAR;
    __syncthreads();
#undef S_STA
#undef S_STB
}

__device__ __forceinline__ bool dense_order(int i, int c, int G, int nM, int nN, int& pm, int& pn) {
    const int nwg = nM * nN; const long L = (long)i * G + c; if (L >= nwg) return false;
    int wgid = (int)L; { const int q = nwg / 8, r = nwg % 8, xcd = wgid % 8, off = wgid / 8; wgid = (xcd < r ? xcd * (q + 1) : r * (q + 1) + (xcd - r) * q) + off; }
    const int nig = 8 * nN, gid = wgid / nig, fm = gid * 8, gsz = (nM - fm) < 8 ? (nM - fm) : 8;
    pm = fm + ((wgid % nig) % gsz); pn = (wgid % nig) / gsz; return true;
}

typedef f32x4 AccT[2][2][4][2];

constexpr unsigned TPB = 528;
__device__ __forceinline__ void stage_tile_bf16(const AccT& acc, int wr, int wc, int fr, int fq, float scale) {
    LAS unsigned char* L8 = (LAS unsigned char*)dynlds;
#pragma unroll
    for (int ai = 0; ai < 2; ++ai)
#pragma unroll
        for (int m = 0; m < 4; ++m) {
            const unsigned ro = (unsigned)(ai * 128 + wr * 64 + m * 16 + fr) * TPB + (wc * 32 + fq * 4) * 2;
#pragma unroll
            for (int bj = 0; bj < 2; ++bj)
#pragma unroll
                for (int n = 0; n < 2; ++n) { const f32x4 v = acc[ai][bj][m][n] * scale; u32x2 w; w.x = pk2(v[0], v[1]); w.y = pk2(v[2], v[3]); *(LAS u32x2*)(L8 + ro + (bj * 128 + n * 16) * 2) = w; }
        }
}

struct EpiProj {
    bf16_t* C; int ldc; int row0, col0;
    __device__ __forceinline__ void operator()(const AccT& acc, int wr, int wc, int fr, int fq) const {
        stage_tile_bf16(acc, wr, wc, fr, fq, 1.0f);
        __syncthreads();
        const int tid = opaque_tid(), wave = tid >> 6, lane = tid & 63;
        LAS unsigned char* L8 = (LAS unsigned char*)dynlds;
#pragma unroll 8
        for (int i = 0; i < 32; ++i) {
            const int r = wave * 32 + i;
            *(u32x2*)(C + (size_t)(row0 + r) * ldc + col0 + lane * 4) = *(const LAS u32x2*)(L8 + (unsigned)r * TPB + lane * 8);
        }
    }
};

struct EpiLora {
    bf16_t* LO; const float* lbias; int row0, col0;
    __device__ __forceinline__ void operator()(const AccT& acc, int wr, int wc, int fr, int fq) const {
        const int seg = col0 >> 10, cbase = (col0 & 1023) + wc * 32 + fq * 4;
        const float* bias = lbias + (seg & 3) * DR_;
        LAS unsigned char* L8 = (LAS unsigned char*)dynlds;
#pragma unroll
        for (int bj = 0; bj < 2; ++bj)
#pragma unroll
            for (int n = 0; n < 2; ++n) {
                const int c = cbase + bj * 128 + n * 16;
                f32x4 bv = (f32x4){0.f, 0.f, 0.f, 0.f};
                if (seg < 4) bv = *(const f32x4*)(bias + c);
#pragma unroll
                for (int ai = 0; ai < 2; ++ai)
#pragma unroll
                    for (int m = 0; m < 4; ++m) {
                        const f32x4 v = acc[ai][bj][m][n] + bv; float o[4];
#pragma unroll
                        for (int j = 0; j < 4; ++j) {
                            const float xx = v[j];
                            if (seg < 2) o[j] = 1.0f - __expf(-0.60653066f * sigmoidf_(xx));
                            else if (seg < 4) o[j] = sigmoidf_(xx);
                            else o[j] = xx;
                        }
                        u32x2 w; w.x = pk2(o[0], o[1]); w.y = pk2(o[2], o[3]);
                        *(LAS u32x2*)(L8 + (unsigned)(ai * 128 + wr * 64 + m * 16 + fr) * TPB + (bj * 128 + wc * 32 + n * 16 + fq * 4) * 2) = w;
                    }
            }
        __syncthreads();
        const int tid = opaque_tid(), wave = tid >> 6, lane = tid & 63;
        bf16_t* outp = LO + (size_t)seg * T_ * DR_ + (col0 & 1023);
#pragma unroll 8
        for (int i = 0; i < 32; ++i) {
            const int r = wave * 32 + i;
            *(u32x2*)(outp + (size_t)(row0 + r) * DR_ + lane * 4) = *(const LAS u32x2*)(L8 + (unsigned)r * TPB + lane * 8);
        }
    }
};

struct EpiWout {
    const float* x; const float* gate; float* out; float* ssq; int row0, col0;
    __device__ __forceinline__ void operator()(const AccT& acc, int wr, int wc, int fr, int fq) const {
        float ss[2][4];
#pragma unroll
        for (int ai = 0; ai < 2; ++ai)
#pragma unroll
            for (int m = 0; m < 4; ++m) ss[ai][m] = 0.f;
#pragma unroll
        for (int bj = 0; bj < 2; ++bj)
#pragma unroll
            for (int n = 0; n < 2; ++n) {
                const int c = col0 + bj * 128 + wc * 32 + n * 16 + fq * 4;
                const f32x4 g = *(const f32x4*)(gate + c);
#pragma unroll
                for (int ai = 0; ai < 2; ++ai)
#pragma unroll
                    for (int m = 0; m < 4; ++m) {
                        const size_t o = (size_t)(row0 + ai * 128 + wr * 64 + m * 16 + fr) * D_ + c;
                        const f32x4 xv = *(const f32x4*)(x + o);
                        const f32x4 r = xv + g * acc[ai][bj][m][n];
                        *(f32x4*)(out + o) = r;
                        ss[ai][m] += r[0] * r[0] + r[1] * r[1] + r[2] * r[2] + r[3] * r[3];
                    }
            }
#pragma unroll
        for (int ai = 0; ai < 2; ++ai)
#pragma unroll
            for (int m = 0; m < 4; ++m) {
                float v = ss[ai][m];
                v += __shfl_xor(v, 16); v += __shfl_xor(v, 32);
                if (fq == 0) ssq[(size_t)(row0 + ai * 128 + wr * 64 + m * 16 + fr) * 32 + (col0 >> 8) * 4 + wc] = v;
            }
    }
};

struct EpiGateUp {
    fp8_t* act; size_t arow0; int ncol0;
    __device__ __forceinline__ void operator()(const AccT& acc, int wr, int wc, int fr, int fq) const {
        LAS unsigned char* L8 = (LAS unsigned char*)dynlds;
        constexpr unsigned TP8 = 144;
#pragma unroll
        for (int ai = 0; ai < 2; ++ai)
#pragma unroll
            for (int m = 0; m < 4; ++m) {
#pragma unroll
                for (int n = 0; n < 2; ++n) {
                    const f32x4 g = acc[ai][0][m][n] * (1.0f / 64.0f), u = acc[ai][1][m][n] * (1.0f / 64.0f); float o[4];
#pragma unroll
                    for (int j = 0; j < 4; ++j) o[j] = g[j] * sigmoidf_(g[j]) * u[j];
                    *(LAS unsigned*)(L8 + (unsigned)(ai * 128 + wr * 64 + m * 16 + fr) * TP8 + wc * 32 + n * 16 + fq * 4) = pk4_fp8(o[0], o[1], o[2], o[3]);
                }
            }
        __syncthreads();
        const int tid = opaque_tid(), wave = tid >> 6, lane = tid & 63;
#pragma unroll
        for (int i = 0; i < 4; ++i) {
            const int r = wave * 32 + i * 8 + (lane >> 3);
            *(u32x4*)(act + (arow0 + r) * EFF + ncol0 + (lane & 7) * 16) = *(const LAS u32x4*)(L8 + (unsigned)r * TP8 + (lane & 7) * 16);
        }
    }
};

constexpr float SLOT_SCALE = 16.0f;
constexpr unsigned DR_STAGE = 65536;
constexpr unsigned DUMP_ROW = T_ * NSLOT;
template <bool ROUTED>
struct EpiDownRouted {
    fp8_t* slot; const unsigned* list; const float* gw; int r0, cnt, col0;
    static constexpr unsigned TQ = 272;
    __device__ __forceinline__ void stage(const AccT& acc, int wr, int wc, int fr, int fq) const {
        LAS unsigned char* L8 = (LAS unsigned char*)dynlds + DR_STAGE;
        LAS unsigned* rowslot = (LAS unsigned*)(L8 + 256 * TQ);
        unsigned sl[8]; float gg[8];
#pragma unroll
        for (int q = 0; q < 8; ++q) {
            const int lr = (q >> 2) * 128 + wr * 64 + (q & 3) * 16 + fr, rr = r0 + lr;
            if (ROUTED) { const int rc = rr < LIST_CAP ? rr : LIST_CAP - 1; const unsigned v = list[rc]; gg[q] = gw[rc] * (SLOT_SCALE / 32.0f); sl[q] = (rr < cnt) ? v : 0xffffffffu; }
            else { sl[q] = (unsigned)rr * NSLOT + TOPK; gg[q] = SLOT_SCALE / 32.0f; }
        }
#pragma unroll
        for (int ai = 0; ai < 2; ++ai)
#pragma unroll
            for (int m = 0; m < 4; ++m) {
                const int q = ai * 4 + m, lr = ai * 128 + wr * 64 + m * 16 + fr;
                if (wc == 0 && fq == 0) rowslot[lr] = (sl[q] != 0xffffffffu) ? sl[q] : DUMP_ROW;
                const unsigned ro = (unsigned)lr * TQ + wc * 32 + fq * 4;
#pragma unroll
                for (int bj = 0; bj < 2; ++bj)
#pragma unroll
                    for (int n = 0; n < 2; ++n) { const f32x4 v = acc[ai][bj][m][n] * gg[q]; *(LAS unsigned*)(L8 + ro + bj * 128 + n * 16) = pk4_fp8(v[0], v[1], v[2], v[3]); }
            }
        __syncthreads();
    }
    __device__ __forceinline__ void store() const {
        LAS unsigned char* L8 = (LAS unsigned char*)dynlds + DR_STAGE;
        LAS unsigned* rowslot = (LAS unsigned*)(L8 + 256 * TQ);
        const int tid = opaque_tid(), wave = tid >> 6, lane = tid & 63;
#pragma unroll
        for (int i = 0; i < 8; ++i) {
            const int r = wave * 32 + i * 4 + (lane >> 4);
            const unsigned sr = rowslot[r];
            *(u32x4*)(slot + (size_t)sr * D_ + col0 + (lane & 15) * 16) = *(const LAS u32x4*)(L8 + (unsigned)r * TQ + (lane & 15) * 16);
        }
    }
};

__device__ __forceinline__ int map_row(int mode, int n) {
    if (mode == 1) return ((n >> 7) << 8) + (n & 127);
    if (mode == 2) return ((n >> 7) << 8) + 128 + (n & 127);
    if (mode == 3) return n < RWKV_IN_ ? n : n + 96;
    return n;
}
__device__ __forceinline__ void cvt_wave_tile(const float* __restrict__ W, int N, int Kv, int k0, int n0, bf16_t* __restrict__ dst, int dld, int mode, int dcol0, float* scr, int lane) {
#pragma unroll 8
    for (int i = 0; i < 32; ++i) {
        const int kk = 2 * i + (lane >> 5);
        float v = 0.f;
        if (k0 + kk < Kv) v = W[(size_t)(k0 + kk) * N + n0 + (lane & 31)];
        scr[kk * 33 + (lane & 31)] = v;
    }
    asm volatile("s_waitcnt lgkmcnt(0)" ::: "memory");
    const int c = lane & 7;
#pragma unroll
    for (int j = 0; j < 4; ++j) {
        const int n = (lane >> 3) + 8 * j; const float* sp = scr + (8 * c) * 33 + n;
        uint4 o; o.x = pk2(sp[0 * 33], sp[1 * 33]); o.y = pk2(sp[2 * 33], sp[3 * 33]); o.z = pk2(sp[4 * 33], sp[5 * 33]); o.w = pk2(sp[6 * 33], sp[7 * 33]);
        *(uint4*)(dst + (size_t)map_row(mode, n0 + n) * dld + dcol0 + k0 + 8 * c) = o;
    }
    asm volatile("s_waitcnt lgkmcnt(0)" ::: "memory");
}
__device__ __forceinline__ void cvt_f8_load(const float* __restrict__ W, int N, int k0, int n0, float (&tv)[32], int lane) {
#pragma unroll
    for (int i = 0; i < 8; ++i) {
        const float* Wi = W + (size_t)(k0 + 16 * i) * N + n0;
        const f32x4 v = *(const f32x4*)(Wi + (unsigned)((lane >> 2) * N + (lane & 3) * 4));
        tv[4 * i] = v[0]; tv[4 * i + 1] = v[1]; tv[4 * i + 2] = v[2]; tv[4 * i + 3] = v[3];
    }
}
__device__ __forceinline__ void cvt_f8_finish(const float (&tv)[32], int k0, int n0, fp8_t* __restrict__ dst, int dld, int mode, float scl, float* scr, int lane) {
#pragma unroll
    for (int i = 0; i < 8; ++i)
#pragma unroll
        for (int j = 0; j < 4; ++j) scr[(16 * i + (lane >> 2)) * 17 + (lane & 3) * 4 + j] = tv[4 * i + j];
    asm volatile("s_waitcnt lgkmcnt(0)" ::: "memory");
#pragma unroll
    for (int q = 0; q < 2; ++q) {
        const int pr = lane + 64 * q, n = pr >> 3, ck = pr & 7; const float* sp = scr + (ck * 16) * 17 + n;
        uint4 o;
        o.x = pk4_fp8(sp[0 * 17] * scl, sp[1 * 17] * scl, sp[2 * 17] * scl, sp[3 * 17] * scl);
        o.y = pk4_fp8(sp[4 * 17] * scl, sp[5 * 17] * scl, sp[6 * 17] * scl, sp[7 * 17] * scl);
        o.z = pk4_fp8(sp[8 * 17] * scl, sp[9 * 17] * scl, sp[10 * 17] * scl, sp[11 * 17] * scl);
        o.w = pk4_fp8(sp[12 * 17] * scl, sp[13 * 17] * scl, sp[14 * 17] * scl, sp[15 * 17] * scl);
        *(uint4*)(dst + (size_t)map_row(mode, n0 + n) * dld + k0 + ck * 16) = o;
    }
    asm volatile("s_waitcnt lgkmcnt(0)" ::: "memory");
}
__device__ __forceinline__ void cvt_wave_tile_f8(const float* __restrict__ W, int N, int k0, int n0, fp8_t* __restrict__ dst, int dld, int mode, float scl, float* scr, int lane) {
    float tv[32]; cvt_f8_load(W, N, k0, n0, tv, lane); cvt_f8_finish(tv, k0, n0, dst, dld, mode, scl, scr, lane);
}
__device__ __forceinline__ void cvt_expert_load(const Params& p, int wt, float (&tv)[32], int lane) {
    const int mtx = wt >> 15, r = wt & 32767, e = r >> 9, rr = r & 511;
    if (mtx < 2) cvt_f8_load((mtx ? p.w_up_e : p.w_gate_e) + (size_t)e * 2048 * 512, 512, (rr >> 5) * 128, (rr & 31) * 16, tv, lane);
    else cvt_f8_load(p.w_down_e + (size_t)e * 512 * 2048, 2048, (rr >> 7) * 128, (rr & 127) * 16, tv, lane);
}
__device__ __forceinline__ void cvt_expert_finish(const Params& p, int wt, const float (&tv)[32], float* scr, int lane) {
    const int mtx = wt >> 15, r = wt & 32767, e = r >> 9, rr = r & 511;
    if (mtx < 2) cvt_f8_finish(tv, (rr >> 5) * 128, (rr & 31) * 16, p.We1q + (size_t)e * 1024 * 2048, 2048, 1 + mtx, 64.0f, scr, lane);
    else cvt_f8_finish(tv, (rr >> 7) * 128, (rr & 127) * 16, p.We2q + (size_t)e * 2048 * 512, 512, 0, 32.0f, scr, lane);
}
__device__ __forceinline__ void cvt_expert_tile(const Params& p, int wt, float* scr, int lane) {
    float tv[32]; cvt_expert_load(p, wt, tv, lane); cvt_expert_finish(p, wt, tv, scr, lane);
}

constexpr int W_IN = 32 * 205, W_OUT = 32 * 64, W_S = 32 * 16, W_SD = 8 * 64, W_L = 32, W_G = 3 * 32;
constexpr int W_DEFER = W_OUT + 2 * W_S + W_SD, W_TOTAL = W_IN + W_DEFER + 4 * W_L + W_G;
__device__ __forceinline__ void small_tile(const Params& p, int r, float* scr, int lane) {
    if (r < W_IN) { cvt_wave_tile(p.w_in, 6560, 2048, (r / 205) * 64, (r % 205) * 32, p.Win, 2048, 3, 0, scr, lane); return; } r -= W_IN;
    if (r < W_OUT) { cvt_wave_tile(p.w_out, 2048, 2048, (r >> 6) * 64, (r & 63) * 32, p.Wout, 2048, 0, 0, scr, lane); return; } r -= W_OUT;
    if (r < W_S) { cvt_wave_tile_f8(p.w_gate_s, 512, (r >> 5) * 128, (r & 31) * 16, p.Ws1q, 2048, 1, 64.0f, scr, lane); return; } r -= W_S;
    if (r < W_S) { cvt_wave_tile_f8(p.w_up_s, 512, (r >> 5) * 128, (r & 31) * 16, p.Ws1q, 2048, 2, 64.0f, scr, lane); return; } r -= W_S;
    if (r < W_SD) { cvt_wave_tile_f8(p.w_down_s, 2048, (r >> 7) * 128, (r & 127) * 16, p.Ws2q, 512, 0, 32.0f, scr, lane); return; } r -= W_SD;
    if (r < W_L) { cvt_wave_tile(p.w_up_f, 1024, 64, 0, r * 32, p.Wlora, 512, 0, 0, scr, lane); return; } r -= W_L;
    if (r < W_L) { cvt_wave_tile(p.w_up_b, 1024, 64, 0, r * 32, p.Wlora + (size_t)1024 * 512, 512, 0, 64, scr, lane); return; } r -= W_L;
    if (r < W_L) { cvt_wave_tile(p.a_up_f, 1024, 64, 0, r * 32, p.Wlora + (size_t)2048 * 512, 512, 0, 128, scr, lane); return; } r -= W_L;
    if (r < W_L) { cvt_wave_tile(p.a_up_b, 1024, 64, 0, r * 32, p.Wlora + (size_t)3072 * 512, 512, 0, 192, scr, lane); return; } r -= W_L;
    cvt_wave_tile(p.g_up, 1024, 160, (r >> 5) * 64, (r & 31) * 32, p.Wlora + (size_t)4096 * 512, 512, 0, 256, scr, lane);
}
constexpr int CVT_ITEMS = 3 * 32768 / 32, PRE_PER_WG = 0;
__device__ __forceinline__ void tail_split(int G, int& first_idle, int& n_idle) {
    const int rem = ((T_ / 256) * (NPROJ / 256)) % G;
    first_idle = rem == 0 ? G : rem; n_idle = G - first_idle;
}
__device__ __forceinline__ int conv_prefilled(int G) { int f, n; tail_split(G, f, n); const int v = n * PRE_PER_WG; return v < CVT_ITEMS ? v : CVT_ITEMS; }

__device__ __forceinline__ void phase_prologue(const Params& p) {
    const int tid = opaque_tid(), wave = tid >> 6, lane = tid & 63, bid = blockIdx.x, nb = gridDim.x;
    for (int u = bid; u < 192; u += nb) {
        float* sc = (float*)dynlds; float* red = sc + 4 * D_;
        __syncthreads();
        for (int i = tid; i < 4 * D_; i += NTHREADS) { const float cv = p.c[i]; sc[i] = cv * sigmoidf_(cv); }
        __syncthreads();
        float acc[4][4];
#pragma unroll
        for (int b = 0; b < 4; ++b)
#pragma unroll
            for (int j = 0; j < 4; ++j) acc[b][j] = 0.f;
        const int rg = lane >> 4, c4 = (lane & 15) * 4;
        const float* wp = p.w_ada + (size_t)(wave * 256 + rg) * 12288 + u * 64 + c4;
#pragma unroll 16
        for (int it = 0; it < 64; ++it) {
            const float4 wv = *(const float4*)(wp + (size_t)it * 4 * 12288);
            const int k = wave * 256 + it * 4 + rg;
#pragma unroll
            for (int b = 0; b < 4; ++b) { const float sv = sc[b * D_ + k]; acc[b][0] += sv * wv.x; acc[b][1] += sv * wv.y; acc[b][2] += sv * wv.z; acc[b][3] += sv * wv.w; }
        }
#pragma unroll
        for (int b = 0; b < 4; ++b)
#pragma unroll
            for (int j = 0; j < 4; ++j) red[(wave * 16 + b * 4 + j) * 64 + lane] = acc[b][j];
        __syncthreads();
        if (tid < 256) {
            const int b = tid >> 6, col = tid & 63, cl = col >> 2, j = col & 3;
            float sm = 0.f;
#pragma unroll
            for (int w = 0; w < 8; ++w)
#pragma unroll
                for (int g = 0; g < 4; ++g) sm += red[(w * 16 + b * 4 + j) * 64 + g * 16 + cl];
            p.mod[b * 12288 + u * 64 + col] = sm + p.b_ada[u * 64 + col];
        }
        __syncthreads();
    }
    for (int i = bid * NTHREADS + tid; i < 4 * DR_; i += nb * NTHREADS) {
        const int sg = i >> 10, c = i & 1023;
        float v = p.w0_f[c]; if (sg == 1) v = p.w0_b[c]; if (sg == 2) v = p.a0_f[c]; if (sg == 3) v = p.a0_b[c];
        p.lbias[i] = v;
    }
    for (int i = bid * NTHREADS + tid; i < 96 * D_ / 8; i += nb * NTHREADS) *(uint4*)(p.Win + (size_t)RWKV_IN_ * D_ + (size_t)i * 8) = make_uint4(0u, 0u, 0u, 0u);
    {
        float* scr = (float*)dynlds + wave * 2176;
        int fi, ni; tail_split(nb, fi, ni);
        const bool defer = ni > 0;
        __syncthreads();
        for (int it = bid * 8 + wave; it < (defer ? W_TOTAL - W_DEFER : W_TOTAL); it += nb * 8) {
            int r = it; if (defer && r >= W_IN) r += W_DEFER;
            small_tile(p, r, scr, lane);
        }
        __syncthreads();
    }
}

__device__ __forceinline__ void phase_norm1(const Params& p) {
    const int tid = opaque_tid(), wave = tid >> 6, lane = tid & 63;
    for (int row = blockIdx.x * 8 + wave; row < T_; row += gridDim.x * 8) {
        const int b = row >> 12;
        const float4* xr = (const float4*)(p.x + (size_t)row * D_) + lane;
        float4 v[8]; float ss = 0.f;
#pragma unroll
        for (int i = 0; i < 8; ++i) { v[i] = xr[i * 64]; ss += v[i].x * v[i].x + v[i].y * v[i].y + v[i].z * v[i].z + v[i].w * v[i].w; }
        ss = wave_sum(ss);
        const float rstd = rsqrtf(ss * (1.0f / D_) + 1e-6f);
        const float* modb = p.mod + b * 12288;
        bf16_t* hr = p.H + (size_t)row * D_;
#pragma unroll
        for (int i = 0; i < 8; ++i) {
            const int c = i * 256 + lane * 4;
            const float4 nw = *(const float4*)(p.norm1_w + c), sh = *(const float4*)(modb + c), sc = *(const float4*)(modb + 2048 + c);
            u32x2 w;
            w.x = pk2(v[i].x * rstd * nw.x * (1.f + sc.x) + sh.x, v[i].y * rstd * nw.y * (1.f + sc.y) + sh.y);
            w.y = pk2(v[i].z * rstd * nw.z * (1.f + sc.z) + sh.z, v[i].w * rstd * nw.w * (1.f + sc.w) + sh.w);
            *(u32x2*)(hr + c) = w;
        }
    }
}

__device__ __forceinline__ void dense_aoff(unsigned (&aoff)[4], int row0, int pitch) {
    const int tid = opaque_tid();
    int R0, C0, R1, C1; stage_rc(tid * 16, R0, C0); stage_rc(tid * 16 + 8192, R1, C1);
    aoff[0] = (unsigned)(row0 + R0) * pitch + C0 * 2; aoff[1] = (unsigned)(row0 + R1) * pitch + C1 * 2;
    aoff[2] = (unsigned)(row0 + 128 + R0) * pitch + C0 * 2; aoff[3] = (unsigned)(row0 + 128 + R1) * pitch + C1 * 2;
}

__device__ __forceinline__ void phase_gemm_in(const Params& p) {
    for (int i = 0;; ++i) {
        int pm, pn; if (!dense_order(i, blockIdx.x, gridDim.x, T_ / 256, NPROJ / 256, pm, pn)) break;
        unsigned aoff[4]; dense_aoff(aoff, pm * 256, D_ * 2);
        EpiProj epi{p.proj, NPROJ, pm * 256, pn * 256};
        gemm_unit<false>(p.H, aoff, p.Win + (size_t)pn * 256 * D_, D_ * 2, epi);
    }
    int fi, ni; tail_split(gridDim.x, fi, ni);
    if ((int)blockIdx.x >= fi) {
        const int tid = opaque_tid(), wave = tid >> 6, lane = tid & 63, j = blockIdx.x - fi;
        float* scr = (float*)dynlds + wave * 2176;
        for (int it = j * 8 + wave; it < W_DEFER; it += ni * 8) small_tile(p, W_IN + it, scr, lane);
#pragma unroll 1
        for (int k = 0; k < PRE_PER_WG; ++k) {
            const int item = j * PRE_PER_WG + k;
            if (item < CVT_ITEMS) {
#pragma unroll 1
                for (int q = 0; q < 4; ++q) cvt_expert_tile(p, item * 32 + wave * 4 + q, scr, lane);
            }
        }
        __syncthreads();
    }
}
__device__ __forceinline__ void phase_gemm_lora(const Params& p) {
    for (int i = 0;; ++i) {
        int pm, pn; if (!dense_order(i, blockIdx.x, gridDim.x, T_ / 256, 4096 / 256, pm, pn)) break;
        const int koff = 0;
        unsigned aoff[4]; dense_aoff(aoff, pm * 256, 512 * 2);
        EpiLora epi{p.LO, p.lbias, pm * 256, pn * 256};
        gemm_unit<false>((const char*)p.Alora + koff, aoff, (const char*)(p.Wlora + (size_t)pn * 256 * 512) + koff, 512 * 2, epi, 4);
    }
}
__device__ __forceinline__ void phase_gemm_out(const Params& p) {
    for (int i = 0;; ++i) {
        int pm, pn; if (!dense_order(i, blockIdx.x, gridDim.x, T_ / 256, D_ / 256, pm, pn)) break;
        unsigned aoff[4]; dense_aoff(aoff, pm * 256, D_ * 2);
        EpiWout epi{p.x, p.mod + ((pm * 256) >> 12) * 12288 + 4096, p.out, p.ssq, pm * 256, pn * 256};
        gemm_unit<false>(p.ycat, aoff, p.Wout + (size_t)pn * 256 * D_, D_ * 2, epi);
    }
}

__device__ __forceinline__ void shifted8(const Params& p, int t, int ch, float (&z)[8]) {
    const int s = t & (SEQ_ - 1);
    const bf16_t* pr = p.proj + (size_t)t * NPROJ + ch;
    const uint4 cur = *(const uint4*)pr;
    uint4 prv = make_uint4(0u, 0u, 0u, 0u), nxt = make_uint4(0u, 0u, 0u, 0u);
    if (s > 0) prv = *(const uint4*)(pr - NPROJ);
    if (s < SEQ_ - 1) nxt = *(const uint4*)(pr + NPROJ);
    float a[8], b[8], c[8]; unpack8(prv, a); unpack8(cur, b); unpack8(nxt, c);
    const float* sw = p.rwkv_shift + ch;
#pragma unroll
    for (int j = 0; j < 8; ++j) z[j] = sw[j] * a[j] + sw[RWKV_IN_ + j] * b[j] + sw[2 * RWKV_IN_ + j] * c[j];
}

__device__ __forceinline__ void phase_prep(const Params& p) {
    const int tid = opaque_tid();
    for (int u = blockIdx.x; u < T_ / 64; u += gridDim.x) {
        const int t0 = u * 64;
        {
            const int gl = tid & 127, tq = tid >> 7;
#pragma unroll 1
            for (int seg = 0; seg < 3; ++seg) {
                const int ch = gl * 8, pc = seg * 1024 + ch;
                float w0[8], w1[8], w2[8], kkw[8];
#pragma unroll
                for (int j = 0; j < 8; ++j) { w0[j] = p.rwkv_shift[pc + j]; w1[j] = p.rwkv_shift[RWKV_IN_ + pc + j]; w2[j] = p.rwkv_shift[2 * RWKV_IN_ + pc + j]; kkw[j] = p.k_k[ch + j]; }
                const int tb = t0 + tq * 16;
                const bf16_t* pr = p.proj + (size_t)tb * NPROJ + pc;
                float a[8], b[8], c[8];
                { uint4 prv = make_uint4(0u, 0u, 0u, 0u); if ((tb & (SEQ_ - 1)) > 0) prv = *(const uint4*)(pr - NPROJ); unpack8(prv, a); unpack8(*(const uint4*)pr, b); }
#pragma unroll 8
                for (int j16 = 0; j16 < 16; ++j16) {
                    const int t = tb + j16;
                    uint4 nxt = make_uint4(0u, 0u, 0u, 0u);
                    if ((t & (SEQ_ - 1)) < SEQ_ - 1) nxt = *(const uint4*)(pr + (size_t)(j16 + 1) * NPROJ);
                    unpack8(nxt, c);
                    float z[8], kkv[8]; float ss = 0.f;
#pragma unroll
                    for (int j = 0; j < 8; ++j) { z[j] = w0[j] * a[j] + w1[j] * b[j] + w2[j] * c[j]; kkv[j] = z[j] * kkw[j]; ss += kkv[j] * kkv[j]; a[j] = b[j]; b[j] = c[j]; }
                    ss = red8_sum(ss);
                    const size_t o = (size_t)t * DR_ + ch;
                    if (seg == 0) *(uint4*)(p.rb + o) = pack8(z);
                    else if (seg == 2) *(uint4*)(p.vb + o) = pack8(z);
                    else {
                        *(uint4*)(p.kb + o) = pack8(z);
                        const float sc = rsqrtf(fmaxf(ss, 1e-12f));
#pragma unroll
                        for (int j = 0; j < 8; ++j) kkv[j] *= sc;
                        *(uint4*)(p.kkb + o) = pack8(kkv);
                    }
                }
            }
        }
#pragma unroll 4
        for (int it = tid; it < 64 * 64; it += NTHREADS) {
            const int tl = it >> 6, g = it & 63, t = t0 + tl;
            float z[8];
            if (g < 52) {
                shifted8(p, t, PC_L + g * 8, z);
                if (g < 16) {
#pragma unroll
                    for (int j = 0; j < 8; ++j) z[j] = tanhf(z[j]);
                } else if (g >= 32) {
#pragma unroll
                    for (int j = 0; j < 8; ++j) z[j] = sigmoidf_(z[j]);
                }
            } else {
#pragma unroll
                for (int j = 0; j < 8; ++j) z[j] = 0.f;
            }
            *(uint4*)(p.Alora + (size_t)t * 512 + g * 8) = pack8(z);
        }
    }
}

__device__ __forceinline__ void prep_na_tile(const Params& p, const int t0) {
    const int tid = opaque_tid();
    {
#pragma unroll 8
        for (int it = tid; it < 64 * 256; it += NTHREADS) {
            const int tl = it >> 8, g = it & 255, t = t0 + tl, isk = g >> 7, ch = (g & 127) * 8;
            const uint4 raw = *(const uint4*)(p.proj + (size_t)t * NPROJ + (isk ? PC_KN : PC_Q) + ch);
            float v[8]; unpack8(raw, v);
            float ss = 0.f;
#pragma unroll
            for (int j = 0; j < 8; ++j) ss += v[j] * v[j];
            ss = red8_sum(ss);
            const float rs = rsqrtf(ss * (1.0f / 64.0f) + 1e-6f) * (isk ? 1.0f : 0.125f);
            const float* nw = (isk ? p.kn_w : p.qn_w) + (ch & 63);
#pragma unroll
            for (int j = 0; j < 8; ++j) v[j] = v[j] * rs * nw[j];
            *(uint4*)((isk ? p.KN : p.QN) + ((size_t)((t >> 12) * 16 + (ch >> 6)) * SEQ_ + (t & (SEQ_ - 1))) * 64 + (ch & 63)) = pack8(v);
        }
        bf16_t* sT = (bf16_t*)dynlds;
        __syncthreads();
#pragma unroll 8
        for (int it = tid; it < 128 * 64; it += NTHREADS) {
            const int tl = it & 63, g = it >> 6;
            const uint4 raw = *(const uint4*)(p.proj + (size_t)(t0 + tl) * NPROJ + PC_VN + g * 8);
            const unsigned w[4] = {raw.x, raw.y, raw.z, raw.w};
#pragma unroll
            for (int j = 0; j < 4; ++j) { sT[(g * 8 + 2 * j) * 64 + tl] = (bf16_t)(w[j] & 0xffffu); sT[(g * 8 + 2 * j + 1) * 64 + tl] = (bf16_t)(w[j] >> 16); }
        }
        __syncthreads();
        {
            const int b = t0 >> 12, s0 = t0 & (SEQ_ - 1);
#pragma unroll 8
            for (int it = tid; it < 1024 * 8; it += NTHREADS) {
                const int ch = ((it >> 9) << 6) | (it & 63), t8 = (it >> 6) & 7;
                const uint4 v = *(const uint4*)(sT + ch * 64 + t8 * 8);
                *(uint4*)(p.VT + (((size_t)(b * 16 + (ch >> 6)) * (SEQ_ / 8) + (s0 >> 3) + t8) * 64 + (ch & 63)) * 8) = v;
            }
        }
        __syncthreads();
    }
}

typedef short s16x4 __attribute__((ext_vector_type(4)));
constexpr int CVT_TILES = 3 * 32768;
constexpr unsigned SLOT = 9216, SPITCH = 144;
__device__ __forceinline__ bf16x8 lds16(unsigned off) { return *(const LAS bf16x8*)((LAS unsigned char*)dynlds + off); }
template <bool SWAP>
__device__ __forceinline__ void mm_acc(f32x4 (&acc)[2], unsigned X, unsigned Y, int tm, int tn0, int fr, int fq) {
#pragma unroll
    for (int ks = 0; ks < 2; ++ks) {
        const bf16x8 xa = lds16(X + (unsigned)(tm * 16 + fr) * SPITCH + ks * 64 + fq * 16);
#pragma unroll
        for (int q = 0; q < 2; ++q) {
            const bf16x8 yb = lds16(Y + (unsigned)((tn0 + q) * 16 + fr) * SPITCH + ks * 64 + fq * 16);
            acc[q] = SWAP ? __builtin_amdgcn_mfma_f32_16x16x32_bf16(yb, xa, acc[q], 0, 0, 0) : __builtin_amdgcn_mfma_f32_16x16x32_bf16(xa, yb, acc[q], 0, 0, 0);
        }
    }
}
__device__ __forceinline__ void st_rows(unsigned D, const f32x4& v, int tm, int tn, int fr, int fq) {
    u32x2 w; w.x = pk2(v[0], v[1]); w.y = pk2(v[2], v[3]);
    *(LAS u32x2*)((LAS unsigned char*)dynlds + D + (unsigned)(tm * 16 + fr) * SPITCH + (tn * 16 + fq * 4) * 2) = w;
}
__device__ __forceinline__ void st_tr(unsigned DT, const f32x4& v, int tm, int tn, int fr, int fq, bool diag) {
    const int m = tm * 16 + fr;
    const int n0 = tn * 16 + fq * 4;
    float d[4];
#pragma unroll
    for (int e = 0; e < 4; ++e) d[e] = diag ? __uint_as_float(0x3f800000u & (unsigned)((((n0 + e) ^ m) - 1) >> 31)) : 0.f;
    const unsigned w0 = pk2(v[0] + d[0], v[1] + d[1]);
    const unsigned w1 = pk2(v[2] + d[2], v[3] + d[3]);
    LAS bf16_t* base = (LAS bf16_t*)((LAS unsigned char*)dynlds + DT) + (unsigned)(tn * 16 + fq * 4) * (SPITCH / 2) + m;
    base[0] = (bf16_t)(w0 & 0xffffu); base[SPITCH / 2] = (bf16_t)(w0 >> 16); base[SPITCH] = (bf16_t)(w1 & 0xffffu); base[3 * (SPITCH / 2)] = (bf16_t)(w1 >> 16);
}
__device__ __forceinline__ f32x4 ld_rows(unsigned D, int tm, int tn, int fr, int fq) {
    const u32x2 w = *(const LAS u32x2*)((LAS unsigned char*)dynlds + D + (unsigned)(tm * 16 + fr) * SPITCH + (tn * 16 + fq * 4) * 2);
    return (f32x4){bflo(w.x), bfhi(w.x), bflo(w.y), bfhi(w.y)};
}

template <bool REV>
__device__ __forceinline__ void scan_unit(const Params& p, int b, int h) {
    const int tid = opaque_tid(), wave = tid >> 6, lane = tid & 63, fr = lane & 15, fq = lane >> 4, tm = wave >> 1, tn0 = (wave & 1) * 2;
    constexpr unsigned O_SB = 0 * SLOT, O_VT = 1 * SLOT, O_BHT = 2 * SLOT, O_KHT = 3 * SLOT, O_RT = 4 * SLOT, O_MBRT = 5 * SLOT, O_MKRT = 6 * SLOT, O_MKA = 7 * SLOT,
                       O_ATT = 8 * SLOT, O_AT = 9 * SLOT, O_BT = 10 * SLOT, O_KT = 11 * SLOT, O_NA = 12 * SLOT, O_LA = 13 * SLOT, O_NB = 14 * SLOT, O_LB = 15 * SLOT,
                       O_PA = O_AT, O_PB = O_BT, O_U = O_KT, O_M1 = O_KT, O_M2 = 16 * SLOT, O_X2T = O_NA, O_X1T = O_LA, O_CUM = O_NA  ;
    LAS unsigned char* L8 = (LAS unsigned char*)dynlds;
    LAS float* cum = (LAS float*)(L8 + O_CUM); LAS float* btot = (LAS float*)(L8 + O_M2);
    const bf16_t* omd = p.LO + (size_t)(REV ? 1 : 0) * T_ * DR_;
    const bf16_t* asg = p.LO + (size_t)(REV ? 3 : 2) * T_ * DR_;
    bf16_t* yout = p.H + (size_t)(REV ? 1 : 0) * T_ * DR_;
    f32x4 Sf[2];
    Sf[0] = (f32x4){0.f, 0.f, 0.f, 0.f}; Sf[1] = Sf[0];
    __syncthreads();
    st_rows(O_SB, Sf[0], tm, tn0, fr, fq); st_rows(O_SB, Sf[1], tm, tn0 + 1, fr, fq);
    const int pj = tid & 63, ptg = tid >> 6;
    const int ptl = tid >> 3, pcg = tid & 7;
    const float ka1 = p.k_a[h * 64 + pj];
    float ka8[8];
#pragma unroll
    for (int e = 0; e < 8; ++e) ka8[e] = p.k_a[h * 64 + pcg * 8 + e];
    unsigned r_om[8], r_kk[8], r_as[8], r_k[8], r_v[8];
    uint4 q_kk, q_as, q_om, q_k, q_r;
    auto load_chunk = [&](int c) {
#pragma unroll
        for (int e = 0; e < 8; ++e) {
            const int u = c * 64 + ptg * 8 + e; const int t = REV ? (SEQ_ - 1 - u) : u;
            const size_t tb = (size_t)(b * SEQ_ + t) * DR_ + h * 64 + pj;
            r_om[e] = omd[tb]; r_kk[e] = p.kkb[tb]; r_as[e] = asg[tb]; r_k[e] = p.kb[tb]; r_v[e] = p.vb[tb];
        }
        const int u2 = c * 64 + ptl; const int t2 = REV ? (SEQ_ - 1 - u2) : u2;
        const size_t base = (size_t)(b * SEQ_ + t2) * DR_ + h * 64 + pcg * 8;
        q_kk = *(const uint4*)(p.kkb + base); q_as = *(const uint4*)(asg + base); q_om = *(const uint4*)(omd + base);
        q_k = *(const uint4*)(p.kb + base); q_r = *(const uint4*)(p.rb + base);
    };
    load_chunk(0);
#pragma unroll 1
    for (int c = 0; c < SEQ_ / 64; ++c) {
        float cp[8];
        cp[0] = 1.0f - bflo(r_om[0]);
#pragma unroll
        for (int e = 1; e < 8; ++e) cp[e] = cp[e - 1] * (1.0f - bflo(r_om[e]));
        btot[ptg * 64 + pj] = cp[7];
        __syncthreads();
        float pre = 1.f, tot = 1.f;
#pragma unroll
        for (int g = 0; g < 8; ++g) { const float v = btot[g * 64 + pj]; pre *= (g < ptg) ? v : 1.f; tot *= v; }
        {
            float o0[8], o1[8], o2[8], o3[8];
#pragma unroll
            for (int e = 0; e < 8; ++e) {
                const float W = pre * cp[e], wm = (e == 0) ? pre : pre * cp[e > 0 ? e - 1 : 0];
                cum[(ptg * 8 + e) * 64 + pj] = W;
                const float kkv = bflo(r_kk[e]), av = bflo(r_as[e]), kv = bflo(r_k[e]), vv = bflo(r_v[e]);
                const float rat = tot * __builtin_amdgcn_rcpf(W);
                o0[e] = -kkv * wm; o1[e] = kkv * av * rat; o2[e] = kv * (1.0f + (av - 1.0f) * ka1) * rat; o3[e] = vv;
            }
            const unsigned ro = (unsigned)pj * SPITCH + ptg * 16;
            *(LAS u32x4*)(L8 + O_ATT + ro) = pack8v(o0); *(LAS u32x4*)(L8 + O_BHT + ro) = pack8v(o1); *(LAS u32x4*)(L8 + O_KHT + ro) = pack8v(o2); *(LAS u32x4*)(L8 + O_VT + ro) = pack8v(o3);
        }
        __syncthreads();
        float wl[2][4];
        {
            float kk[8], av[8], om[8], kv[8], rv[8];
            unpack8(q_kk, kk); unpack8(q_as, av); unpack8(q_om, om); unpack8(q_k, kv); unpack8(q_r, rv);
            const f32x4 c0 = *(const LAS f32x4*)(cum + ptl * 64 + pcg * 8), c1 = *(const LAS f32x4*)(cum + ptl * 64 + pcg * 8 + 4);
            const int pl = ptl > 0 ? ptl - 1 : 0;
            f32x4 d0 = *(const LAS f32x4*)(cum + pl * 64 + pcg * 8), d1 = *(const LAS f32x4*)(cum + pl * 64 + pcg * 8 + 4);
            if (ptl == 0) { d0 = (f32x4){1.f, 1.f, 1.f, 1.f}; d1 = d0; }
            const float cu[8] = {c0.x, c0.y, c0.z, c0.w, c1.x, c1.y, c1.z, c1.w}, cm[8] = {d0.x, d0.y, d0.z, d0.w, d1.x, d1.y, d1.z, d1.w};
            float o0[8], o1[8], o2[8], o3[8];
#pragma unroll
            for (int e = 0; e < 8; ++e) {
                const float wm = cm[e], iw = __builtin_amdgcn_rcpf(cu[e]);
                o0[e] = -kk[e] * wm; o1[e] = kk[e] * av[e] * iw; o2[e] = kv[e] * (1.0f + (av[e] - 1.0f) * ka8[e]) * iw;
                o3[e] = rv[e] * (REV ? wm : cu[e]);
            }
            const unsigned ro = (unsigned)ptl * SPITCH + pcg * 16;
            *(LAS u32x4*)(L8 + O_AT + ro) = pack8v(o0); *(LAS u32x4*)(L8 + O_BT + ro) = pack8v(o1); *(LAS u32x4*)(L8 + O_KT + ro) = pack8v(o2); *(LAS u32x4*)(L8 + O_RT + ro) = pack8v(o3);
#pragma unroll
            for (int q = 0; q < 2; ++q) {
                const f32x4 cw = *(const LAS f32x4*)(cum + 63 * 64 + (tn0 + q) * 16 + fq * 4);
                wl[q][0] = cw.x; wl[q][1] = cw.y; wl[q][2] = cw.z; wl[q][3] = cw.w;
            }
        }
        if (c + 1 < SEQ_ / 64) load_chunk(c + 1);
        __builtin_amdgcn_sched_barrier(0);
        __syncthreads();
        {
            f32x4 a0[2] = {{0.f, 0.f, 0.f, 0.f}, {0.f, 0.f, 0.f, 0.f}}, a1[2] = {a0[0], a0[0]}, a2[2] = {a0[0], a0[0]}, a3[2] = {a0[0], a0[0]};
            mm_acc<true>(a0, O_BT, O_AT, tm, tn0, fr, fq); mm_acc<true>(a1, O_KT, O_AT, tm, tn0, fr, fq);
            mm_acc<true>(a2, O_RT, O_BT, tm, tn0, fr, fq); mm_acc<true>(a3, O_RT, O_KT, tm, tn0, fr, fq);
            const int m = tm * 16 + fr;
            f32x4 dd[2], m1[2], m2[2];
#pragma unroll
            for (int q = 0; q < 2; ++q) {
#pragma unroll
                for (int e = 0; e < 4; ++e) {
                    const int n = (tn0 + q) * 16 + fq * 4 + e;
                    const unsigned up = (unsigned)((m - n) >> 31), lo = (unsigned)((REV ? (n - m) : (n - m - 1)) >> 31);
                    const unsigned s16 = (unsigned)((((n ^ m) >> 4) - 1) >> 31), s32 = (unsigned)((((n ^ m) >> 5) - 1) >> 31);
                    const unsigned v0 = __float_as_uint(a0[q][e]) & up;
                    dd[q][e] = __uint_as_float(v0 & s16); m1[q][e] = __uint_as_float(v0 & s32 & ~s16); m2[q][e] = __uint_as_float(v0 & ~s32);
                    a1[q][e] = __uint_as_float(__float_as_uint(a1[q][e]) & up); a2[q][e] = __uint_as_float(__float_as_uint(a2[q][e]) & lo); a3[q][e] = __uint_as_float(__float_as_uint(a3[q][e]) & lo);
                }
            }
            const int dq = tm - tn0;
            const bool own = (dq == 0) || (dq == 1);
            f32x4 e1 = {0.f, 0.f, 0.f, 0.f};
            if (own) {
#pragma unroll
                for (int ks = 0; ks < 2; ++ks) {
                    const bf16x8 xa = lds16(O_BT + (unsigned)(tm * 16 + fr) * SPITCH + ks * 64 + fq * 16), yb = lds16(O_AT + (unsigned)(tm * 16 + fr) * SPITCH + ks * 64 + fq * 16);
                    e1 = __builtin_amdgcn_mfma_f32_16x16x32_bf16(xa, yb, e1, 0, 0, 0);
                }
            }
            __syncthreads();
            f32x4 qi = {0.f, 0.f, 0.f, 0.f}, qti = qi;
            if (own) {
                f32x4 E, ET = dq ? dd[1] : dd[0], Q, QT;
#pragma unroll
                for (int e = 0; e < 4; ++e) {
                    const int cc = fq * 4 + e;
                    E[e] = __uint_as_float(__float_as_uint(e1[e]) & (unsigned)((cc - fr) >> 31));
                    const float idn = __uint_as_float(0x3f800000u & (unsigned)(((cc ^ fr) - 1) >> 31));
                    Q[e] = E[e] + idn; QT[e] = ET[e] + idn;
                }
#define PK4S(v) __builtin_bit_cast(s16x4, (u32x2){pk2((v)[0], (v)[1]), pk2((v)[2], (v)[3])})
#define MM16(Xb, Yb, C) __builtin_amdgcn_mfma_f32_16x16x16bf16_1k(Yb, Xb, C, 0, 0, 0)
#pragma unroll
                for (int lv = 0; lv < 3; ++lv) {
                    const s16x4 Eb = PK4S(E), ETb = PK4S(ET), Qb = PK4S(Q);
                    const f32x4 zz = {0.f, 0.f, 0.f, 0.f};
                    const f32x4 E2 = MM16(Eb, ETb, zz), ET2 = MM16(ETb, Eb, zz);
                    const s16x4 ET2b = PK4S(ET2);
                    Q = MM16(Qb, ET2b, Q);
                    QT = MM16(ET2b, Qb, QT);
                    E = E2; ET = ET2;
                }
#undef MM16
#undef PK4S
                qi = Q; qti = QT;
            }
#pragma unroll
            for (int q = 0; q < 2; ++q) {
                const bool dg = own && (q == dq);
                const f32x4 zz = {0.f, 0.f, 0.f, 0.f};
                st_rows(O_PB, dg ? qi : zz, tm, tn0 + q, fr, fq); st_rows(O_LA, dg ? qti : zz, tm, tn0 + q, fr, fq);
                st_tr(O_M1, m1[q], tm, tn0 + q, fr, fq, false); st_tr(O_M2, m2[q], tm, tn0 + q, fr, fq, false);
                st_rows(O_MKA, a1[q], tm, tn0 + q, fr, fq); st_rows(O_MBRT, a2[q], tm, tn0 + q, fr, fq); st_rows(O_MKRT, a3[q], tm, tn0 + q, fr, fq);
            }
        }
        __syncthreads();
        {
            constexpr unsigned O_DINV = O_PB, O_DINVT = O_LA, O_Z1T = O_NA, O_Z2P = O_NB, O_G1 = O_LB, O_WT = O_LA, O_P = O_PA;
            { f32x4 z[2] = {{0.f, 0.f, 0.f, 0.f}, {0.f, 0.f, 0.f, 0.f}}, y[2] = {z[0], z[0]};
              mm_acc<true>(z, O_M1, O_DINVT, tm, tn0, fr, fq); mm_acc<true>(y, O_M2, O_DINVT, tm, tn0, fr, fq);
#pragma unroll
              for (int q = 0; q < 2; ++q) { st_tr(O_Z1T, z[q], tm, tn0 + q, fr, fq, false); st_rows(O_Z2P, y[q], tm, tn0 + q, fr, fq); } }
            __syncthreads();
            { f32x4 g[2], w[2];
              g[0] = ld_rows(O_DINV, tm, tn0, fr, fq); g[1] = ld_rows(O_DINV, tm, tn0 + 1, fr, fq); mm_acc<true>(g, O_DINV, O_Z1T, tm, tn0, fr, fq);
              w[0] = ld_rows(O_Z2P, tm, tn0, fr, fq); w[1] = ld_rows(O_Z2P, tm, tn0 + 1, fr, fq); mm_acc<true>(w, O_Z2P, O_Z1T, tm, tn0, fr, fq);
#pragma unroll
              for (int q = 0; q < 2; ++q) { st_rows(O_G1, g[q], tm, tn0 + q, fr, fq); st_tr(O_WT, w[q], tm, tn0 + q, fr, fq, false); } }
            __syncthreads();
            { f32x4 g[2]; g[0] = ld_rows(O_G1, tm, tn0, fr, fq); g[1] = ld_rows(O_G1, tm, tn0 + 1, fr, fq); mm_acc<true>(g, O_G1, O_WT, tm, tn0, fr, fq);
              st_rows(O_P, g[0], tm, tn0, fr, fq); st_rows(O_P, g[1], tm, tn0 + 1, fr, fq); }
            __syncthreads();
            f32x4 x2[2] = {{0.f, 0.f, 0.f, 0.f}, {0.f, 0.f, 0.f, 0.f}}, x1[2] = {x2[0], x2[0]};
            mm_acc<true>(x2, O_P, O_ATT, tm, tn0, fr, fq); mm_acc<true>(x1, O_P, O_MKA, tm, tn0, fr, fq);
#pragma unroll
            for (int q = 0; q < 2; ++q) { st_rows(O_X2T, x2[q], tm, tn0 + q, fr, fq); st_rows(O_X1T, x1[q], tm, tn0 + q, fr, fq); }
        }
        __syncthreads();
        f32x4 yv[2] = {{0.f, 0.f, 0.f, 0.f}, {0.f, 0.f, 0.f, 0.f}};
        {
            f32x4 uu[2] = {{0.f, 0.f, 0.f, 0.f}, {0.f, 0.f, 0.f, 0.f}};
            mm_acc<true>(uu, O_SB, O_X2T, tm, tn0, fr, fq); mm_acc<true>(uu, O_VT, O_X1T, tm, tn0, fr, fq);
            st_rows(O_U, uu[0], tm, tn0, fr, fq); st_rows(O_U, uu[1], tm, tn0 + 1, fr, fq);
            mm_acc<false>(yv, O_SB, O_RT, tm, tn0, fr, fq); mm_acc<false>(yv, O_VT, O_MKRT, tm, tn0, fr, fq);
        }
        __syncthreads();
        {
#pragma unroll
            for (int q = 0; q < 2; ++q)
#pragma unroll
                for (int e = 0; e < 4; ++e) Sf[q][e] *= wl[q][e];
            mm_acc<true>(Sf, O_U, O_BHT, tm, tn0, fr, fq); mm_acc<true>(Sf, O_VT, O_KHT, tm, tn0, fr, fq);
            st_rows(O_SB, Sf[0], tm, tn0, fr, fq); st_rows(O_SB, Sf[1], tm, tn0 + 1, fr, fq);
            mm_acc<false>(yv, O_U, O_MBRT, tm, tn0, fr, fq);
#pragma unroll
            for (int q = 0; q < 2; ++q) {
                const int u = c * 64 + (tn0 + q) * 16 + fr; const int t = REV ? (SEQ_ - 1 - u) : u;
                u32x2 w; w.x = pk2(yv[q][0], yv[q][1]); w.y = pk2(yv[q][2], yv[q][3]);
                *(u32x2*)(yout + (size_t)(b * SEQ_ + t) * DR_ + h * 64 + tm * 16 + fq * 4) = w;
            }
        }
    }
    __syncthreads();
}

constexpr int NA_KP = 144, NA_P_OFF = 576 * NA_KP  , NA_BIAS_OFF = NA_P_OFF + 8 * 8448  ;
__device__ __forceinline__ void na_unit(const Params& p, int bu) {
    const int tid = opaque_tid(), wave = tid >> 6, lane = tid & 63, fr = lane & 15, fq = lane >> 4;
    const int b = bu >> 9, h = (bu >> 5) & 15, ip = bu & 31;
    LAS unsigned char* L8 = (LAS unsigned char*)dynlds;
    LAS float* rbias = (LAS float*)(L8 + NA_BIAS_OFF);
    LAS bf16_t* Pb = (LAS bf16_t*)(L8 + NA_P_OFF) + wave * (16 * 264);
    const int i0 = ip * 2, rs0 = min(max(i0 - 4, 0), 56);
    const bf16_t* qh = p.QN + (size_t)(b * 16 + h) * SEQ_ * 64; const bf16_t* kh = p.KN + (size_t)(b * 16 + h) * SEQ_ * 64; const bf16_t* vh = p.VT + (size_t)(b * 16 + h) * SEQ_ * 64;
    uint4 vreg[9];
#pragma unroll
    for (int j = 0; j < 9; ++j) {
        const int c = tid + j * NTHREADS;
        const int krow = min(rs0 + (c >> 9), 63), tok = krow * 64 + ((c >> 3) & 63), pc = c & 7;
        const uint4 kv = *(const uint4*)(kh + (size_t)tok * 64 + pc * 8);
        *(LAS u32x4*)(L8 + (unsigned)((c >> 3) * NA_KP + pc * 16)) = (u32x4){kv.x, kv.y, kv.z, kv.w};
        const int vrow = min(rs0 + (c >> 9), 63);
        vreg[j] = *(const uint4*)(vh + ((size_t)(vrow * 8 + ((c >> 6) & 7)) * 64 + (c & 63)) * 8);
    }
    for (int i = tid; i < 465; i += NTHREADS) rbias[i] = p.rel_bias[h * 465 + i];
    __syncthreads();
    const int i = i0 + (wave >> 2), cb = wave & 3;
    const int rs = min(max(i - 4, 0), 56), kc0 = min(max(cb * 16 - 8, 0), 32), lrow = rs - rs0;
    const bf16x8 aq0 = *(const bf16x8*)(qh + (size_t)(i * 64 + cb * 16 + fr) * 64 + fq * 8), aq1 = *(const bf16x8*)(qh + (size_t)(i * 64 + cb * 16 + fr) * 64 + 32 + fq * 8);
    float s[8][2][4];
#pragma unroll
    for (int kr = 0; kr < 8; ++kr)
#pragma unroll
        for (int hh = 0; hh < 2; ++hh) {
            const unsigned ko = (unsigned)(((lrow + kr) * 64 + kc0 + hh * 16 + fr) * NA_KP + fq * 16);
            const bf16x8 bk0 = *(const LAS bf16x8*)(L8 + ko), bk1 = *(const LAS bf16x8*)(L8 + ko + 64);
            f32x4 acc = (f32x4){0.f, 0.f, 0.f, 0.f};
            acc = __builtin_amdgcn_mfma_f32_16x16x32_bf16(aq0, bk0, acc, 0, 0, 0);
            acc = __builtin_amdgcn_mfma_f32_16x16x32_bf16(aq1, bk1, acc, 0, 0, 0);
            const int kc = kc0 + hh * 16 + fr;
#pragma unroll
            for (int jj = 0; jj < 4; ++jj) {
                const int qc = cb * 16 + fq * 4 + jj, wc0 = min(max(qc - 8, 0), 48);
                const unsigned vm = (unsigned)(((wc0 - kc - 1) >> 31) & ((kc - wc0 - 16) >> 31));
                const int bi = (rs + kr - i + 7) * 31 + min(max(kc - qc + 15, 0), 30);
                const float sv = acc[jj] + rbias[bi];
                s[kr][hh][jj] = __uint_as_float((__float_as_uint(sv) & vm) | (0xff800000u & ~vm));
            }
        }
    float mx[4], sm[4];
#pragma unroll
    for (int jj = 0; jj < 4; ++jj) {
        float m = -INFINITY;
#pragma unroll
        for (int kr = 0; kr < 8; ++kr) m = fmaxf(m, fmaxf(s[kr][0][jj], s[kr][1][jj]));
        mx[jj] = red16_max(m);
        float t = 0.f;
#pragma unroll
        for (int kr = 0; kr < 8; ++kr)
#pragma unroll
            for (int hh = 0; hh < 2; ++hh) { const float e = __expf(s[kr][hh][jj] - mx[jj]); s[kr][hh][jj] = e; t += e; }
        sm[jj] = red16_sum(t);
    }
#pragma unroll
    for (int kr = 0; kr < 8; ++kr)
#pragma unroll
        for (int hh = 0; hh < 2; ++hh)
#pragma unroll
            for (int jj = 0; jj < 4; jj += 2) {
                const unsigned w = pk2(s[kr][hh][jj], s[kr][hh][jj + 1]);
                Pb[(fq * 4 + jj) * 264 + kr * 32 + hh * 16 + fr] = (bf16_t)(w & 0xffffu);
                Pb[(fq * 4 + jj + 1) * 264 + kr * 32 + hh * 16 + fr] = (bf16_t)(w >> 16);
            }
    __syncthreads();
#pragma unroll
    for (int j = 0; j < 9; ++j) { const int c = tid + j * NTHREADS; *(LAS u32x4*)(L8 + (unsigned)c * 16) = (u32x4){vreg[j].x, vreg[j].y, vreg[j].z, vreg[j].w}; }
    __syncthreads();
    f32x4 o[4];
#pragma unroll
    for (int dt = 0; dt < 4; ++dt) o[dt] = (f32x4){0.f, 0.f, 0.f, 0.f};
#pragma unroll
    for (int kr = 0; kr < 8; ++kr) {
        const bf16x8 ap = *(const LAS bf16x8*)(Pb + fr * 264 + kr * 32 + fq * 8);
#pragma unroll
        for (int dt = 0; dt < 4; ++dt) {
            const bf16x8 bv = *(const LAS bf16x8*)(L8 + (unsigned)((((lrow + kr) * 8 + (kc0 >> 3) + fq) * 64 + dt * 16 + fr) * 16));
            o[dt] = __builtin_amdgcn_mfma_f32_16x16x32_bf16(ap, bv, o[dt], 0, 0, 0);
        }
    }
#pragma unroll
    for (int jj = 0; jj < 4; ++jj) {
        const float inv = 1.0f / sm[jj];
        bf16_t* orow = p.ycat + ((size_t)b * SEQ_ + i * 64 + cb * 16 + fq * 4 + jj) * D_ + DR_ + h * 64 + fr;
#pragma unroll
        for (int dt = 0; dt < 4; ++dt) orow[dt * 16] = (bf16_t)(pk2(o[dt][jj] * inv, 0.f) & 0xffffu);
    }
    __syncthreads();
}

constexpr int Q_PREP = T_ / 64;
__device__ __forceinline__ void phase_mix(const Params& p) {
    const int G = gridDim.x, bid = blockIdx.x;
    const bool split = (G % 16) == 0;
    if (!split || ((bid >> 3) & 1) == 0) {
        const int sidx = split ? ((bid >> 4) * 8 + (bid & 7)) : bid, nscan = split ? G / 2 : G;
        for (int u = sidx; u < 128; u += nscan) {
            const int b = u >> 5, h = (u >> 1) & 15;
            if (u & 1) scan_unit<true>(p, b, h); else scan_unit<false>(p, b, h);
        }
    }
    const int tid = opaque_tid(), wave = tid >> 6, lane = tid & 63;
    int* qslot = (int*)(dynlds + CTRL_OFF + 512);
    float* scr = (float*)dynlds + wave * 2176;
    __syncthreads();
    if (tid == 0) *qslot = (int)atomicAdd(p.qctr, 1u);
    __syncthreads();
    int it = __builtin_amdgcn_readfirstlane(*qslot);
    bool na_ready = false;
    const int npre = conv_prefilled(G);
    const int C = CVT_ITEMS - npre, n_alt = C < 2048 ? C : 2048, c_lead = C - n_alt;
    const int Q_GL = Q_PREP + 256, Q_LEAD = Q_GL + c_lead, Q_ALT = Q_LEAD + 2 * n_alt, Q_TOTAL = Q_ALT + (2048 - n_alt);
    while (it < Q_TOTAL) {
        __syncthreads();
        unsigned nxt = 0u;
        if (tid == 0) nxt = atomicAdd(p.qctr, 1u);
        int kind, idx;
        if (it < Q_PREP) { kind = 0; idx = it; }
        else if (it < Q_GL) { kind = 3; idx = it - Q_PREP; }
        else if (it < Q_LEAD) { kind = 1; idx = it - Q_GL; }
        else if (it < Q_ALT) { const int k2 = it - Q_LEAD; kind = 1 + (k2 & 1); idx = (k2 & 1) ? (k2 >> 1) : c_lead + (k2 >> 1); }
        else { kind = 2; idx = n_alt + (it - Q_ALT); }
        if (kind == 0) {
            prep_na_tile(p, idx * 64);
            asm volatile("s_waitcnt vmcnt(0)" ::: "memory");
            __syncthreads();
            if (tid == 0) { __builtin_amdgcn_fence(__ATOMIC_RELEASE, "agent"); asm volatile("s_waitcnt vmcnt(0)" ::: "memory"); (void)xb_add(p.qctr + 32, 1u); }
        } else if (kind == 1) {
            const int wt = (idx + npre) * 32 + __builtin_amdgcn_readfirstlane(wave) * 4;
            float tv0[32], tv1[32];
            cvt_expert_load(p, wt, tv0, lane); cvt_expert_load(p, wt + 1, tv1, lane);
            cvt_expert_finish(p, wt, tv0, scr, lane); cvt_expert_load(p, wt + 2, tv0, lane);
            cvt_expert_finish(p, wt + 1, tv1, scr, lane); cvt_expert_load(p, wt + 3, tv1, lane);
            cvt_expert_finish(p, wt + 2, tv0, scr, lane); cvt_expert_finish(p, wt + 3, tv1, scr, lane);
        } else if (kind == 3) {
            const int j = idx, pm = j >> 2, pn = 16 + (j & 3);
            unsigned aoff[4]; dense_aoff(aoff, pm * 256, 512 * 2);
            EpiLora epi{p.LO, p.lbias, pm * 256, pn * 256};
            gemm_unit<false>((const char*)p.Alora + 4 * BK * 2, aoff, (const char*)(p.Wlora + (size_t)pn * 256 * 512) + 4 * BK * 2, 512 * 2, epi, 4);
        } else {
            if (!na_ready) {
                if (tid == 0) {
                    unsigned sp = 0u;
                    while (xb_ld(p.qctr + 32) < (unsigned)Q_PREP) { __builtin_amdgcn_s_sleep(2); if (++sp > (1u << 22)) break; }
                    __builtin_amdgcn_fence(__ATOMIC_ACQUIRE, "agent");
                    asm volatile("s_waitcnt vmcnt(0)" ::: "memory");
                }
                __syncthreads();
                na_ready = true;
            }
            na_unit(p, idx);
        }
        if (tid == 0) *qslot = (int)nxt;
        __syncthreads();
        it = __builtin_amdgcn_readfirstlane(*qslot);
    }
    __syncthreads();
}

__device__ __forceinline__ void phase_combine(const Params& p) {
    const bf16_t* yf = p.H; const bf16_t* yb = p.H + (size_t)T_ * DR_;
    const bf16_t* af = p.LO + (size_t)2 * T_ * DR_; const bf16_t* gg = p.LO + (size_t)4 * T_ * DR_;
    for (int it = blockIdx.x * NTHREADS + threadIdx.x; it < T_ * 128; it += gridDim.x * NTHREADS) {
        const int t = it >> 7, ch = (it & 127) * 8, h = ch >> 6;
        const size_t o = (size_t)t * DR_ + ch;
        float a[8], b[8], r[8], k[8], av[8], v[8], g[8], y[8];
        unpack8(*(const uint4*)(yf + o), a); unpack8(*(const uint4*)(yb + o), b);
        unpack8(*(const uint4*)(p.rb + o), r); unpack8(*(const uint4*)(p.kb + o), k); unpack8(*(const uint4*)(af + o), av);
        unpack8(*(const uint4*)(p.vb + o), v); unpack8(*(const uint4*)(gg + o), g);
        float s1 = 0.f, bs = 0.f;
#pragma unroll
        for (int j = 0; j < 8; ++j) {
            y[j] = a[j] + b[j]; s1 += y[j];
            const float kf = k[j] * (1.0f + (av[j] - 1.0f) * p.k_a[ch + j]);
            bs += r[j] * kf * p.r_k[ch + j];
        }
        s1 = red8_sum(s1); bs = red8_sum(bs);
        const float mu = s1 * (1.0f / 64.0f);
        float s2 = 0.f;
#pragma unroll
        for (int j = 0; j < 8; ++j) { const float d = y[j] - mu; s2 += d * d; }
        s2 = red8_sum(s2);
        const float rstd = rsqrtf(s2 * (1.0f / 64.0f) + 64e-5f);
        float outv[8];
#pragma unroll
        for (int j = 0; j < 8; ++j) outv[j] = ((y[j] - mu) * rstd * p.ln_w[ch + j] + p.ln_b[ch + j] + bs * v[j]) * g[j];
        (void)h;
        *(uint4*)(p.ycat + (size_t)t * D_ + ch) = pack8(outv);
    }
}

__device__ __forceinline__ unsigned long long route_row(float logit, float rbias, int lane, float* gwv) {
    const float score = sigmoidf_(logit);
    const float bsd = score + rbias;
    const float m1 = red8_max(bsd);
    const unsigned long long eq = __ballot(bsd == m1);
    const unsigned gm = (unsigned)(eq >> (lane & 56)) & 0xffu;
    const int first = __ffs(gm) - 1;
    const float ex = ((lane & 7) == first) ? -INFINITY : bsd;
    const float m2 = red8_max(ex);
    const float gs = m1 + m2;
    const int g = lane >> 3; int rank = 0;
#pragma unroll
    for (int gp = 0; gp < 8; ++gp) { const float o = __shfl(gs, gp * 8); rank += ((o > gs) || (o == gs && gp < g)) ? 1 : 0; }
    float cur = (rank < 4) ? bsd : -INFINITY;
    unsigned long long sel = 0ull;
#pragma unroll 1
    for (int itk = 0; itk < TOPK; ++itk) {
        const float mxv = wave_max(cur);
        const unsigned long long em = __ballot(cur == mxv);
        const int idx = __ffsll((long long)em) - 1;
        sel |= 1ull << idx;
        if (lane == idx) cur = -INFINITY;
    }
    const bool me = (sel >> lane) & 1ull;
    const float ssum = wave_sum(me ? score : 0.f);
    *gwv = score / ssum * 2.5f;
    return sel;
}

__device__ __forceinline__ void phase_norm2_router(const Params& p) {
    const int tid = opaque_tid(), wave = tid >> 6, lane = tid & 63, fr = lane & 15, fq = lane >> 4;
    constexpr int HP = 260;
    float* hsl = (float*)dynlds;
    float* lg = hsl + 64 * HP;
    const float rbias = p.router_bias[lane];
    const int rt = wave >> 1, eh = wave & 1;
    for (int u = blockIdx.x; u < T_ / 64; u += gridDim.x) {
        const int row0 = u * 64 + wave * 8, b = row0 >> 12;
        const float* modb = p.mod + b * 12288;
        float rstd[8];
#pragma unroll
        for (int r = 0; r < 8; ++r) {
            const float v = (lane < 32) ? p.ssq[(size_t)(row0 + r) * 32 + lane] : 0.f;
            rstd[r] = rsqrtf(wave_sum(v) * (1.0f / D_) + 1e-6f);
        }
        f32x4 lacc[2]; lacc[0] = (f32x4){0.f, 0.f, 0.f, 0.f}; lacc[1] = lacc[0];
        float* Bs = lg + 64 * 65;
        const int bk0 = tid >> 4, bq4 = (tid & 15) * 4, bdq = bq4 ^ ((bk0 & 3) * 16);
        f32x4 xq[8], bq[8]; float4 nwq, shq, scq;
#define P8_PREFETCH(slv) { const int kbp = (slv) * 256 + lane * 4; \
            nwq = *(const float4*)(p.norm2_w + kbp); shq = *(const float4*)(modb + 6144 + kbp); scq = *(const float4*)(modb + 8192 + kbp); \
            _Pragma("unroll") for (int r = 0; r < 8; ++r) xq[r] = *(const f32x4*)(p.out + (size_t)(row0 + r) * D_ + kbp); \
            _Pragma("unroll") for (int j = 0; j < 8; ++j) bq[j] = *(const f32x4*)(p.w_router + (size_t)((slv) * 256 + bk0 + j * 32) * NEXP + bq4); }
        P8_PREFETCH(0)
#pragma unroll 1
        for (int sl = 0; sl < 8; ++sl) {
            const int kb = sl * 256 + lane * 4;
            const float4 g4 = make_float4(nwq.x * (1.f + scq.x), nwq.y * (1.f + scq.y), nwq.z * (1.f + scq.z), nwq.w * (1.f + scq.w)), sh = shq;
            __syncthreads();
#pragma unroll
            for (int r = 0; r < 8; ++r) {
                const f32x4 xv = xq[r];
                float4 hv; hv.x = xv.x * rstd[r] * g4.x + sh.x; hv.y = xv.y * rstd[r] * g4.y + sh.y; hv.z = xv.z * rstd[r] * g4.z + sh.z; hv.w = xv.w * rstd[r] * g4.w + sh.w;
                *(unsigned*)(p.H8 + (size_t)(row0 + r) * D_ + kb) = pk4_fp8(hv.x, hv.y, hv.z, hv.w);
                *(float4*)(hsl + (wave * 8 + r) * HP + lane * 4) = hv;
            }
#pragma unroll
            for (int j = 0; j < 8; ++j) *(f32x4*)(Bs + (bk0 + j * 32) * NEXP + bdq) = bq[j];
            if (sl + 1 < 8) P8_PREFETCH(sl + 1)
            __syncthreads();
            const float* ap = hsl + (rt * 16 + fr) * HP + fq;
            const float* b0p = Bs + fq * NEXP + ((eh * 32 + fr) ^ (fq * 16));
            const float* b1p = Bs + fq * NEXP + ((eh * 32 + 16 + fr) ^ (fq * 16));
#pragma unroll 16
            for (int k4 = 0; k4 < 64; ++k4) {
                const float av = ap[k4 * 4];
                const float b0 = b0p[k4 * 4 * NEXP], b1 = b1p[k4 * 4 * NEXP];
                lacc[0] = __builtin_amdgcn_mfma_f32_16x16x4f32(av, b0, lacc[0], 0, 0, 0);
                lacc[1] = __builtin_amdgcn_mfma_f32_16x16x4f32(av, b1, lacc[1], 0, 0, 0);
            }
        }
#pragma unroll
        for (int nt = 0; nt < 2; ++nt)
#pragma unroll
            for (int jj = 0; jj < 4; ++jj) lg[(rt * 16 + fq * 4 + jj) * 65 + eh * 32 + nt * 16 + fr] = lacc[nt][jj];
        int* lcnt = (int*)(dynlds + CTRL_OFF + 64); int* lbase = lcnt + 64;
        __syncthreads();
        if (tid < 64) lcnt[tid] = 0;
        __syncthreads();
        unsigned long long selm[8]; int lrank[8]; float gwr[8];
#pragma unroll
        for (int r = 0; r < 8; ++r) {
            selm[r] = route_row(lg[(wave * 8 + r) * 65 + lane], rbias, lane, &gwr[r]);
            lrank[r] = 0;
            if ((selm[r] >> lane) & 1ull) lrank[r] = atomicAdd(lcnt + lane, 1);
        }
        __syncthreads();
        if (tid < 64) lbase[tid] = (int)atomicAdd(p.cnt + tid * 64, (unsigned)lcnt[tid]);
        __syncthreads();
        const int mybase = lbase[lane];
#pragma unroll
        for (int r = 0; r < 8; ++r) {
            if ((selm[r] >> lane) & 1ull) {
                const int kidx = __popcll(selm[r] & ((1ull << lane) - 1ull));
                const unsigned slot = (unsigned)(row0 + r) * NSLOT + kidx;
                p.list[(size_t)lane * LIST_CAP + mybase + lrank[r]] = slot;
                p.gw[(size_t)lane * LIST_CAP + mybase + lrank[r]] = gwr[r];
            }
        }
    }
}

__device__ __forceinline__ int build_tile_table(const Params& p, int* tstart) {
    __syncthreads();
    if (threadIdx.x == 0) {
        int s = 0;
        for (int e = 0; e < NEXP; ++e) { tstart[e] = s; s += ((int)p.cnt[e * 64] + 255) >> 8; }
        tstart[NEXP] = s;
    }
    __syncthreads();
    return tstart[NEXP];
}

__device__ __forceinline__ void phase_moe_up(const Params& p) {
    int* s_tstart = (int*)(dynlds + CTRL_OFF + 64);
    const int R = build_tile_table(p, s_tstart);
    const int nunits = (R + T_ / 256) * 4;
    const int tid = opaque_tid();
    int R0, C0, R1, C1; stage_rc(tid * 16, R0, C0); stage_rc(tid * 16 + 8192, R1, C1);
    int e = 0;
    for (int u = blockIdx.x; u < nunits; u += gridDim.x) {
        const int mt = u >> 2, nt = u & 3;
        unsigned aoff[4]; const fp8_t* Bt;
        if (mt < R) {
            while (s_tstart[e + 1] <= mt) ++e;
            const int r0 = (mt - s_tstart[e]) * 256, cnt = (int)p.cnt[e * 64];
            const unsigned* lst = p.list + (size_t)e * LIST_CAP;
            const int lr[4] = {R0, R1, 128 + R0, 128 + R1}; const int lc[4] = {C0, C1, C0, C1};
#pragma unroll
            for (int q = 0; q < 4; ++q) { const int rr = r0 + lr[q]; const unsigned v = lst[rr < LIST_CAP ? rr : LIST_CAP - 1]; const unsigned tok = rr < cnt ? v / NSLOT : 0u; aoff[q] = tok * D_ + lc[q] * 2; }
            Bt = p.We1q + (size_t)e * 1024 * D_ + (size_t)nt * 256 * D_;
        } else {
            dense_aoff(aoff, (mt - R) * 256, D_);
            Bt = p.Ws1q + (size_t)nt * 256 * D_;
        }
        EpiGateUp epi{p.actq, (size_t)mt * 256, nt * 128};
        gemm_unit<true>(p.H8, aoff, Bt, D_, epi);
    }
}

__device__ __forceinline__ void phase_moe_down(const Params& p) {
    int* s_tstart2 = (int*)(dynlds + CTRL_OFF + 64);
    const int R = build_tile_table(p, s_tstart2);
    const int nunits = (R + T_ / 256) * 8;
    int e = 0;
    bool staged = false;
    for (int u = blockIdx.x; u < nunits; u += gridDim.x) {
        const int mt = u >> 3, nt = u & 7;
        unsigned aoff[4]; dense_aoff(aoff, 0, EFF);
        if (mt < R) { while (s_tstart2[e + 1] <= mt) ++e; }
        const int un = u + gridDim.x, mtn = un >> 3, ntn = un & 7; const bool has_next = un < nunits;
        int en = e;
        if (has_next && mtn < R) { while (s_tstart2[en + 1] <= mtn) ++en; }
        const fp8_t* nA = p.actq + (size_t)mtn * 256 * EFF;
        const fp8_t* nB = (mtn < R) ? p.We2q + (size_t)en * D_ * EFF + (size_t)ntn * 256 * EFF : p.Ws2q + (size_t)ntn * 256 * EFF;
        const fp8_t* cA = p.actq + (size_t)mt * 256 * EFF;
        if (mt < R) {
            const int r0 = (mt - s_tstart2[e]) * 256;
            EpiDownRouted<true> epi{p.slot, p.list + (size_t)e * LIST_CAP, p.gw + (size_t)e * LIST_CAP, r0, (int)p.cnt[e * 64], nt * 256};
            gemm_unit_pre<true, 8>(cA, aoff, p.We2q + (size_t)e * D_ * EFF + (size_t)nt * 256 * EFF, EFF, epi, staged, has_next, nA, nB);
        } else {
            EpiDownRouted<false> epi{p.slot, nullptr, p.gw, (mt - R) * 256, T_, nt * 256};
            gemm_unit_pre<true, 8>(cA, aoff, p.Ws2q + (size_t)nt * 256 * EFF, EFF, epi, staged, has_next, nA, nB);
        }
        staged = has_next;
    }
}

__device__ __forceinline__ void phase_final(const Params& p) {
    for (int it = blockIdx.x * NTHREADS + opaque_tid(); it < T_ * (D_ / 8); it += gridDim.x * NTHREADS) {
        const int t = it >> 8, c = (it & 255) * 8;
        float acc[8];
#pragma unroll
        for (int j = 0; j < 8; ++j) acc[j] = 0.f;
#pragma unroll
        for (int k = 0; k < NSLOT; ++k) {
            const u32x2 w = *(const u32x2*)(p.slot + ((size_t)t * NSLOT + k) * D_ + c);
            const f32x2 a0 = __builtin_amdgcn_cvt_pk_f32_fp8(w.x, false), a1 = __builtin_amdgcn_cvt_pk_f32_fp8(w.x, true), a2 = __builtin_amdgcn_cvt_pk_f32_fp8(w.y, false), a3 = __builtin_amdgcn_cvt_pk_f32_fp8(w.y, true);
            acc[0] += a0.x; acc[1] += a0.y; acc[2] += a1.x; acc[3] += a1.y; acc[4] += a2.x; acc[5] += a2.y; acc[6] += a3.x; acc[7] += a3.y;
        }
#pragma unroll
        for (int j = 0; j < 8; ++j) acc[j] *= (1.0f / SLOT_SCALE);
        const float* gate = p.mod + (t >> 12) * 12288 + 10240 + c;
        const f32x4 g0 = *(const f32x4*)gate, g1 = *(const f32x4*)(gate + 4);
        float* op = p.out + (size_t)t * D_ + c;
        const f32x4 x0 = *(const f32x4*)op, x1 = *(const f32x4*)(op + 4);
        *(f32x4*)op = x0 + g0 * (f32x4){acc[0], acc[1], acc[2], acc[3]};
        *(f32x4*)(op + 4) = x1 + g1 * (f32x4){acc[4], acc[5], acc[6], acc[7]};
    }
}

constexpr int N_PHASES = 12;
__global__ void __launch_bounds__(NTHREADS, 2) fwd_kernel(Params p) {
    LAS unsigned* xbw = (LAS unsigned*)(dynlds + CTRL_OFF);
    if (threadIdx.x == 0) { xbw[0] = 0u; xbw[1] = 0u; xbw[2] = 0u; xbw[3] = 0u; }
    __syncthreads();
    const int lo = (int)p.ph_lo, hi = (int)p.ph_hi;
    const bool multi = (hi - lo) > 1;
    XcdBarrier bar; bar.bar = p.bar; bar.x = 0; bar.st = (volatile LAS unsigned*)xbw;
    if (multi) bar = xcd_barrier_post(p.bar, (volatile LAS unsigned*)xbw);
#ifdef ONLY_PHASE
#define PHASE(k, call) if ((k) == ONLY_PHASE) { if (lo <= (k) && (k) < hi) { call; if ((k) + 1 < hi) xcd_barrier(bar); } }
#else
#define PHASE(k, call) if (lo <= (k) && (k) < hi) { call; if (DUP_PHASE == (k)) { xcd_barrier(bar); call; } if ((k) + 1 < hi) xcd_barrier(bar); }
#endif
    PHASE(0, phase_prologue(p))
    PHASE(1, phase_norm1(p))
    PHASE(2, phase_gemm_in(p))
    PHASE(3, phase_prep(p))
    PHASE(4, phase_gemm_lora(p))
    PHASE(5, phase_mix(p))
    PHASE(6, phase_combine(p))
    PHASE(7, phase_gemm_out(p))
    PHASE(8, phase_norm2_router(p))
    PHASE(9, phase_moe_up(p))
    PHASE(10, phase_moe_down(p))
    PHASE(11, phase_final(p))
#undef PHASE
}

static inline size_t al256(size_t x) { return (x + 255) & ~(size_t)255; }

extern "C" void kernel_launch(void* const* d_in, const int* in_sizes, int n_in, void* d_out, int out_size, void* d_ws, size_t ws_size, hipStream_t stream) {
    static int grid = 0;
    size_t off = 0;
    const size_t o_bar = off;   off = al256(off + XCD_BAR_WORDS * 4);
    const size_t o_mod = off;   off = al256(off + (size_t)NB_ * 12288 * 4);
    const size_t o_cnt = off;   off = al256(off + NEXP * 256 + 256);
    const size_t o_lbias = off; off = al256(off + 4 * DR_ * 4);
    const size_t o_wlora = off; off = al256(off + (size_t)5120 * 512 * 2);
    const size_t zero_end = off;
    const size_t o_we1 = off;   off = al256(off + (size_t)NEXP * 1024 * D_ * 2);
    const size_t o_we2 = off;   off = al256(off + (size_t)NEXP * D_ * EFF * 2);
    const size_t o_ws1 = off;   off = al256(off + (size_t)1024 * D_ * 2);
    const size_t o_ws2 = off;   off = al256(off + (size_t)D_ * EFF * 2);
    const size_t o_h = off;     off = al256(off + (size_t)T_ * D_ * 2);
    const size_t o_ssq = off;   off = al256(off + (size_t)T_ * 32 * 4);
    const size_t arena = off;
    size_t m = arena;
    const size_t o_win = m;   m = al256(m + (size_t)NPROJ * D_ * 2);
    const size_t o_wout = m;  m = al256(m + (size_t)D_ * D_ * 2);
    const size_t o_proj = m;  m = al256(m + (size_t)T_ * NPROJ * 2);
    const size_t o_alora = m; m = al256(m + (size_t)T_ * 512 * 2);
    const size_t o_qn = m;    m = al256(m + (size_t)T_ * DR_ * 2);
    const size_t o_kn = m;    m = al256(m + (size_t)T_ * DR_ * 2);
    const size_t o_vt = m;    m = al256(m + (size_t)T_ * DR_ * 2);
    const size_t o_ycat = m;  m = al256(m + (size_t)T_ * D_ * 2);
    const size_t o_lo = m;    m = al256(m + (size_t)5 * T_ * DR_ * 2);
    size_t f = arena;
    const size_t o_slot = f;  f = al256(f + (size_t)T_ * NSLOT * D_ * 2);
    const size_t o_act = f;   f = al256(f + (size_t)(T_ * TOPK + NEXP * 256 + T_) * EFF * 2);
    const size_t o_list = f;  f = al256(f + (size_t)NEXP * LIST_CAP * 4);
    const size_t o_gw = f;    f = al256(f + (size_t)NEXP * LIST_CAP * 4);
    const size_t ws_need = m > f ? m : f;

    if (grid == 0) {
        if (n_in != 34 || out_size != T_ * D_ || ws_size < ws_need) { fprintf(stderr, "kernel_launch: unexpected problem (n_in %d, out %d, ws %zu, need %zu)\n", n_in, out_size, ws_size, ws_need); grid = -1; return; }
        int dev = 0, cus = 0;
        if (hipGetDevice(&dev) != hipSuccess || hipDeviceGetAttribute(&cus, hipDeviceAttributeMultiprocessorCount, dev) != hipSuccess) { grid = -1; return; }
        if (hipFuncSetAttribute((const void*)fwd_kernel, hipFuncAttributeMaxDynamicSharedMemorySize, DYN_LDS) != hipSuccess) { fprintf(stderr, "kernel_launch: hipFuncSetAttribute failed\n"); grid = -1; return; }
        int per_cu = 0;
        (void)hipOccupancyMaxActiveBlocksPerMultiprocessor(&per_cu, (const void*)fwd_kernel, NTHREADS, DYN_LDS);
        (void)hipGetLastError();
        if (per_cu < 1) fprintf(stderr, "kernel_launch: occupancy query reports %d blocks per CU\n", per_cu);
        grid = cus;
    }
    if (grid < 0) return;
    char* ws = (char*)d_ws;
    hipMemsetAsync(ws, 0, zero_end, stream);
    Params p{};
    const float* const* in = (const float* const*)d_in;
    p.x = in[0]; p.c = in[1]; p.w_ada = in[2]; p.b_ada = in[3]; p.norm1_w = in[4]; p.w_in = in[5]; p.rwkv_shift = in[6]; p.w0_f = in[7]; p.w_up_f = in[8];
    p.w0_b = in[9]; p.w_up_b = in[10]; p.a0_f = in[11]; p.a_up_f = in[12]; p.a0_b = in[13]; p.a_up_b = in[14]; p.g_up = in[15]; p.k_k = in[16]; p.k_a = in[17];
    p.r_k = in[18]; p.ln_w = in[19]; p.ln_b = in[20]; p.qn_w = in[21]; p.kn_w = in[22]; p.rel_bias = in[23]; p.w_out = in[24]; p.norm2_w = in[25];
    p.w_router = in[26]; p.router_bias = in[27]; p.w_gate_e = in[28]; p.w_up_e = in[29]; p.w_down_e = in[30]; p.w_gate_s = in[31]; p.w_up_s = in[32]; p.w_down_s = in[33];
    p.out = (float*)d_out;
    p.bar = (unsigned*)(ws + o_bar); p.mod = (float*)(ws + o_mod); p.cnt = (unsigned*)(ws + o_cnt); p.qctr = p.cnt + NEXP * 64; p.lbias = (float*)(ws + o_lbias);
    p.Wlora = (bf16_t*)(ws + o_wlora); p.We1q = (fp8_t*)(ws + o_we1); p.We2q = (fp8_t*)(ws + o_we2); p.Ws1q = (fp8_t*)(ws + o_ws1); p.Ws2q = (fp8_t*)(ws + o_ws2); p.H8 = (fp8_t*)(ws + o_h);
    p.H = (bf16_t*)(ws + o_h); p.Win = (bf16_t*)(ws + o_win); p.Wout = (bf16_t*)(ws + o_wout); p.proj = (bf16_t*)(ws + o_proj); p.LO = (bf16_t*)(ws + o_lo);
    p.Alora = (bf16_t*)(ws + o_alora); p.QN = (bf16_t*)(ws + o_qn); p.KN = (bf16_t*)(ws + o_kn); p.VT = (bf16_t*)(ws + o_vt); p.ycat = (bf16_t*)(ws + o_ycat);
    p.rb = (bf16_t*)d_out; p.kb = p.rb + (size_t)T_ * DR_; p.vb = p.kb + (size_t)T_ * DR_; p.kkb = p.vb + (size_t)T_ * DR_;
    p.slot = (fp8_t*)(ws + o_slot); p.actq = (fp8_t*)(ws + o_act); p.list = (unsigned*)(ws + o_list); p.gw = (float*)(ws + o_gw);
    p.ssq = (float*)(ws + o_ssq);
#if N_LAUNCH_SPLIT
    for (int k = 0; k < N_PHASES; ++k) {
        p.ph_lo = k; p.ph_hi = k + 1;
        hipLaunchKernelGGL(fwd_kernel, dim3(grid), dim3(NTHREADS), DYN_LDS, stream, p);
    }
#else
    p.ph_lo = 0; p.ph_hi = N_PHASES;
    hipLaunchKernelGGL(fwd_kernel, dim3(grid), dim3(NTHREADS), DYN_LDS, stream, p);
#endif
    (void)in_sizes;
}
```

```cpp
#include <hip/hip_runtime.h>
#include <stdint.h>
#include <stdio.h>

#ifndef DUP_PHASE
#define DUP_PHASE -1
#endif
#ifndef N_LAUNCH_SPLIT
#define N_LAUNCH_SPLIT 0
#endif

typedef unsigned short bf16_t;
typedef short bf16x8 __attribute__((ext_vector_type(8)));
typedef float f32x4 __attribute__((ext_vector_type(4)));
typedef unsigned u32x2 __attribute__((ext_vector_type(2)));
typedef int i32x4 __attribute__((ext_vector_type(4)));
typedef unsigned u32x4 __attribute__((ext_vector_type(4)));
typedef int i32x8 __attribute__((ext_vector_type(8)));
typedef unsigned char fp8_t;
typedef float f32x2 __attribute__((ext_vector_type(2)));
#define LAS __attribute__((address_space(3)))

constexpr int T_ = 16384, SEQ_ = 4096, NB_ = 4, D_ = 2048, DR_ = 1024;
constexpr int NPROJ = 6656;
constexpr int RWKV_IN_ = 3488;
constexpr int PC_R = 0, PC_K = 1024, PC_V = 2048, PC_L = 3072, PC_Q = 3584, PC_KN = 4608, PC_VN = 5632;
constexpr int NEXP = 64, TOPK = 6, EFF = 512, NSLOT = 7;
constexpr int LIST_CAP = 16384;
constexpr int NTHREADS = 512;
constexpr int GEMM_LDS = 131072;
constexpr int CTRL_OFF = 17 * 9216;
constexpr int DYN_LDS = CTRL_OFF + 1024;

#define XB_TMO      128
#define XB_XCNT(j)  (256  + 64 * (j))
#define XB_XSUB(j)  (1280 + 64 * (j))
#define XB_XGEN(j)  (2304 + 64 * (j))
#define XB_TOP      3328
#define XB_TOPGEN   3392
#define XCD_BAR_WORDS 3456
#define XB_SPIN_CAP (1u << 18)

__device__ __forceinline__ unsigned xb_ld(unsigned* p)              { return __hip_atomic_load(p, __ATOMIC_RELAXED, __HIP_MEMORY_SCOPE_AGENT); }
__device__ __forceinline__ unsigned xb_add(unsigned* p, unsigned v) { return __hip_atomic_fetch_add(p, v, __ATOMIC_RELAXED, __HIP_MEMORY_SCOPE_AGENT); }
__device__ __forceinline__ unsigned xb_xcc_id() { return (unsigned)__builtin_amdgcn_s_getreg((3 << 11) | 20) & 0xFu; }
#define XB_SPIN(cond, bar) do { unsigned _sp = 0; while (cond) { __builtin_amdgcn_s_sleep(1); \
    if ((++_sp & 255u) == 0u) { if (xb_ld(&(bar)[XB_TMO])) break; if (_sp > XB_SPIN_CAP) { atomicAdd(&(bar)[XB_TMO], 1u); break; } } } } while (0)

struct XcdBarrier { unsigned* bar; unsigned x; volatile LAS unsigned* st; };

__device__ __forceinline__ XcdBarrier xcd_barrier_post(unsigned* bar, volatile LAS unsigned* st) {
    XcdBarrier b; b.bar = bar; b.x = xb_xcc_id(); b.st = st;
    if (threadIdx.x == 0) (void)xb_add(&bar[XB_XCNT(b.x)], 1u);
    return b;
}
__device__ __forceinline__ void xcd_barrier_complete(unsigned* bar, unsigned x, unsigned& nloc, unsigned& nx) {
    const unsigned G = gridDim.x * gridDim.y * gridDim.z;
    unsigned sum, cnt, mine, sp = 0u;
    for (;;) {
        sum = 0u; cnt = 0u; mine = 0u;
#pragma unroll
        for (unsigned j = 0; j < 16; ++j) { const unsigned c = xb_ld(&bar[XB_XCNT(j)]); sum += c; cnt += (c > 0u) ? 1u : 0u; mine = (j == x) ? c : mine; }
        if (sum == G) break;
        __builtin_amdgcn_s_sleep(1);
        if ((++sp & 255u) == 0u) { if (xb_ld(&bar[XB_TMO])) break; if (sp > XB_SPIN_CAP) { atomicAdd(&bar[XB_TMO], 1u); break; } }
    }
    nloc = mine > 0u ? mine : 1u; nx = cnt > 0u ? cnt : 1u;
}
__device__ __forceinline__ void xcd_barrier(const XcdBarrier& b) {
    asm volatile("s_waitcnt vmcnt(0)" ::: "memory");
    __syncthreads();
    if (threadIdx.x == 0) {
        unsigned* bar = b.bar;
        __builtin_amdgcn_s_waitcnt(0);
        unsigned nloc = b.st[0], nx = b.st[1];
        if (nloc == 0u) { xcd_barrier_complete(bar, b.x, nloc, nx); b.st[0] = nloc; b.st[1] = nx; }
        const unsigned old = xb_add(&bar[XB_XSUB(b.x)], 1u);
        const unsigned gen = old / nloc;
        if (old + 1u == (gen + 1u) * nloc) {
            __builtin_amdgcn_fence(__ATOMIC_RELEASE, "agent");
            asm volatile("s_waitcnt vmcnt(0)" ::: "memory");
            const unsigned og = xb_add(&bar[XB_TOP], 1u);
            const unsigned tg = og / nx;
            if (og + 1u == (tg + 1u) * nx) xb_add(&bar[XB_TOPGEN], 1u);
            else XB_SPIN(xb_ld(&bar[XB_TOPGEN]) == tg, bar);
            __builtin_amdgcn_fence(__ATOMIC_ACQUIRE, "agent");
            xb_add(&bar[XB_XGEN(b.x)], 1u);
            asm volatile("s_waitcnt vmcnt(0)" ::: "memory");
        } else {
            XB_SPIN(xb_ld(&bar[XB_XGEN(b.x)]) == gen, bar);
            __builtin_amdgcn_fence(__ATOMIC_ACQUIRE, "agent");
            asm volatile("s_waitcnt vmcnt(0)" ::: "memory");
        }
    }
    __syncthreads();
}

struct Params {
    const float *x, *c, *w_ada, *b_ada, *norm1_w, *w_in, *rwkv_shift, *w0_f, *w_up_f, *w0_b, *w_up_b, *a0_f, *a_up_f, *a0_b, *a_up_b,
                *g_up, *k_k, *k_a, *r_k, *ln_w, *ln_b, *qn_w, *kn_w, *rel_bias, *w_out, *norm2_w, *w_router, *router_bias,
                *w_gate_e, *w_up_e, *w_down_e, *w_gate_s, *w_up_s, *w_down_s;
    float* out;
    unsigned* bar; float* mod; unsigned* cnt; float* lbias; unsigned* qctr;
    bf16_t *Wlora, *H, *Win, *Wout, *proj, *Alora, *QN, *KN, *VT, *ycat, *LO;
    fp8_t *We1q, *We2q, *Ws1q, *Ws2q, *H8, *actq;
    bf16_t *rb, *kb, *vb, *kkb;
    fp8_t *slot; unsigned* list; float* gw;
    float* ssq;
    long long ph_lo, ph_hi;
};

extern __shared__ __attribute__((aligned(16))) char dynlds[];

__device__ __forceinline__ int opaque_tid() { int t = threadIdx.x; asm volatile("" : "+v"(t)); return t; }
typedef __bf16 bf16x2_t __attribute__((ext_vector_type(2)));
__device__ __forceinline__ unsigned pk2(float lo, float hi) { bf16x2_t v = {(__bf16)lo, (__bf16)hi}; return __builtin_bit_cast(unsigned, v); }
__device__ __forceinline__ float bflo(unsigned u) { return __uint_as_float(u << 16); }
__device__ __forceinline__ float bfhi(unsigned u) { return __uint_as_float(u & 0xffff0000u); }
__device__ __forceinline__ void unpack8(const uint4& u, float (&f)[8]) {
    f[0] = bflo(u.x); f[1] = bfhi(u.x); f[2] = bflo(u.y); f[3] = bfhi(u.y); f[4] = bflo(u.z); f[5] = bfhi(u.z); f[6] = bflo(u.w); f[7] = bfhi(u.w);
}
__device__ __forceinline__ u32x4 pack8v(const float (&f)[8]) { u32x4 r; r.x = pk2(f[0], f[1]); r.y = pk2(f[2], f[3]); r.z = pk2(f[4], f[5]); r.w = pk2(f[6], f[7]); return r; }
__device__ __forceinline__ uint4 pack8(const float (&f)[8]) { uint4 r; r.x = pk2(f[0], f[1]); r.y = pk2(f[2], f[3]); r.z = pk2(f[4], f[5]); r.w = pk2(f[6], f[7]); return r; }
__device__ __forceinline__ float clamp448(float x) { return fminf(fmaxf(x, -448.0f), 448.0f); }
__device__ __forceinline__ unsigned pk4_fp8(float a, float b, float c, float d) {
    int w = 0;
    w = __builtin_amdgcn_cvt_pk_fp8_f32(clamp448(a), clamp448(b), w, false);
    w = __builtin_amdgcn_cvt_pk_fp8_f32(clamp448(c), clamp448(d), w, true);
    return (unsigned)w;
}
template <int CTRL> __device__ __forceinline__ float dppf(float x) { return __builtin_bit_cast(float, __builtin_amdgcn_mov_dpp(__builtin_bit_cast(int, x), CTRL, 0xf, 0xf, true)); }
__device__ __forceinline__ float red8_sum(float v)  { v += dppf<0xB1>(v); v += dppf<0x4E>(v); v += dppf<0x141>(v); return v; }
__device__ __forceinline__ float red16_sum(float v) { v += dppf<0xB1>(v); v += dppf<0x4E>(v); v += dppf<0x141>(v); v += dppf<0x128>(v); return v; }
__device__ __forceinline__ float red8_max(float v)  { v = fmaxf(v, dppf<0xB1>(v)); v = fmaxf(v, dppf<0x4E>(v)); v = fmaxf(v, dppf<0x141>(v)); return v; }
__device__ __forceinline__ float red16_max(float v) { v = fmaxf(v, dppf<0xB1>(v)); v = fmaxf(v, dppf<0x4E>(v)); v = fmaxf(v, dppf<0x141>(v)); v = fmaxf(v, dppf<0x128>(v)); return v; }
__device__ __forceinline__ float wave_sum(float v) {
#pragma unroll
    for (int o = 1; o < 64; o <<= 1) v += __shfl_xor(v, o);
    return v;
}
__device__ __forceinline__ float wave_max(float v) {
#pragma unroll
    for (int o = 1; o < 64; o <<= 1) v = fmaxf(v, __shfl_xor(v, o));
    return v;
}
__device__ __forceinline__ float sigmoidf_(float x) { return 1.0f / (1.0f + __expf(-x)); }

constexpr int BK = 64, HALF = 128, HTB = HALF * BK * 2;
__device__ __forceinline__ int lds_byte(int r, int c) {
    int st = (r >> 4) * 2 + (c >> 5), rr = r & 15, cc = c & 31, ob = rr * 64 + cc * 2;
    return st * 1024 + (ob ^ (((ob >> 9) & 1) << 5));
}
__device__ __forceinline__ void stage_rc(int b, int& R, int& C) {
    int st = b / 1024, sb = b % 1024, swz = sb ^ (((sb >> 9) & 1) << 5);
    R = (st >> 1) * 16 + swz / 64; C = (st & 1) * 32 + (swz % 64) / 2;
}

#define G_SA(b, h) (((b) * 4 + (h)) * HTB)
#define G_SB(b, h) (((b) * 4 + 2 + (h)) * HTB)
#define G_STAGE(bufoff, gbase, v0, v1) do { \
    __builtin_amdgcn_global_load_lds((const unsigned*)((const char*)(gbase) + (v0)), (LAS unsigned*)(lds + (bufoff) + ldsw), 16, 0, 0); \
    __builtin_amdgcn_global_load_lds((const unsigned*)((const char*)(gbase) + (v1)), (LAS unsigned*)(lds + (bufoff) + ldsw + 8192), 16, 0, 0); } while (0)
#define G_STAGE_A(b, h, kt) G_STAGE(G_SA(b, h), Ab + (size_t)(kt) * (BK * 2), va[(h) * 2], va[(h) * 2 + 1])
#define G_STAGE_B(b, h, kt) G_STAGE(G_SB(b, h), Bb + (size_t)(h) * hstep + (size_t)(kt) * (BK * 2), vb0, vb1)
#define G_LD8(base) __builtin_shufflevector(*(const LAS i32x4*)(lds + (base)), *(const LAS i32x4*)(lds + (base) + 1024), 0, 1, 2, 3, 4, 5, 6, 7)
#define G_LDA(dst, b, h) do { _Pragma("unroll") for (int m = 0; m < 4; ++m) dst[m] = G_LD8(G_SA(b, h) + laoff + m * 2048); } while (0)
#define G_LDB(dst, b, h) do { _Pragma("unroll") for (int n = 0; n < 2; ++n) dst[n] = G_LD8(G_SB(b, h) + lboff + n * 2048); } while (0)
#define G_LO(v) __builtin_bit_cast(bf16x8, __builtin_shufflevector(v, v, 0, 1, 2, 3))
#define G_HI(v) __builtin_bit_cast(bf16x8, __builtin_shufflevector(v, v, 4, 5, 6, 7))
#define G_MMA(ai, bj, Af, Bf) do { __builtin_amdgcn_s_setprio(1); \
    if (FP8) { \
      _Pragma("unroll") for (int m = 0; m < 4; ++m) _Pragma("unroll") for (int n = 0; n < 2; ++n) \
        asm volatile("v_mfma_f32_16x16x128_f8f6f4 %0, %1, %2, %0" : "+v"(acc[ai][bj][m][n]) : "v"(Bf[n]), "v"(Af[m])); \
    } else { \
      _Pragma("unroll") for (int m = 0; m < 4; ++m) _Pragma("unroll") for (int n = 0; n < 2; ++n) { \
        acc[ai][bj][m][n] = __builtin_amdgcn_mfma_f32_16x16x32_bf16(G_LO(Bf[n]), G_LO(Af[m]), acc[ai][bj][m][n], 0, 0, 0); \
        acc[ai][bj][m][n] = __builtin_amdgcn_mfma_f32_16x16x32_bf16(G_HI(Bf[n]), G_HI(Af[m]), acc[ai][bj][m][n], 0, 0, 0); } } \
    __builtin_amdgcn_s_setprio(0); } while (0)
#define G_WAIT_V(n) asm volatile("s_waitcnt vmcnt(" #n ")" ::: "memory")
#define G_WAIT_L(n) asm volatile("s_waitcnt lgkmcnt(" #n ")" ::: "memory")
#define G_BAR __builtin_amdgcn_s_barrier()
#define G_SCHED __builtin_amdgcn_sched_barrier(0)

__device__ __forceinline__ int gemm_stage_row(int tid, int i) { int R, C; stage_rc(tid * 16 + i * 8192, R, C); return R; }
__device__ __forceinline__ int gemm_stage_col(int tid, int i) { int R, C; stage_rc(tid * 16 + i * 8192, R, C); return C; }

template <bool FP8, class Epi>
__device__ __forceinline__ void gemm_unit(const void* __restrict__ A, const unsigned (&aoffb)[4], const void* __restrict__ Bt, const int PITCH, const Epi& epi, const int NT = 0) {
    LAS unsigned char* lds = (LAS unsigned char*)dynlds;
    const int tid = opaque_tid();
    const int wid = __builtin_amdgcn_readfirstlane(tid >> 6), lane = tid & 63, wr = wid >> 2, wc = wid & 3, fr = lane & 15, fq = lane >> 4;
    const unsigned va[4] = {aoffb[0], aoffb[1], aoffb[2], aoffb[3]};
    unsigned vb0, vb1;
    { int R0, C0, R1, C1; stage_rc(tid * 16, R0, C0); stage_rc(tid * 16 + 8192, R1, C1); vb0 = (unsigned)(R0 * PITCH + C0 * 2); vb1 = (unsigned)(R1 * PITCH + C1 * 2); }
    const char* Ab = (const char*)A; const char* Bb = (const char*)Bt;
    const size_t hstep = (size_t)HALF * PITCH;
    const unsigned ldsw = (unsigned)wid * 1024u;
    const int laoff = lds_byte(wr * 64 + fr, fq * 8), lboff = lds_byte(wc * 32 + fr, fq * 8);
    f32x4 acc[2][2][4][2];
#pragma unroll
    for (int a = 0; a < 2; ++a)
#pragma unroll
        for (int b = 0; b < 2; ++b)
#pragma unroll
            for (int m = 0; m < 4; ++m)
#pragma unroll
                for (int n = 0; n < 2; ++n) acc[a][b][m][n] = (f32x4){0.f, 0.f, 0.f, 0.f};
    i32x8 At[4], B0[2], B1[2];
    const int nt = NT ? NT : PITCH / (BK * 2);
    __syncthreads();
    G_STAGE_B(0, 0, 0); G_STAGE_A(0, 0, 0); G_STAGE_B(0, 1, 0); G_STAGE_A(0, 1, 0);
    if (wr == 1) G_BAR;
    G_WAIT_V(4); G_BAR;
    G_STAGE_B(1, 0, 1); G_STAGE_A(1, 0, 1); G_STAGE_B(1, 1, 1);
    G_WAIT_V(6); G_BAR;
    for (int t = 0; t < nt - 2; t += 2) {
        G_LDB(B0, 0, 0); G_SCHED; G_LDA(At, 0, 0); G_STAGE_A(1, 1, t + 1);
        G_WAIT_L(8); G_BAR; G_WAIT_L(0); G_MMA(0, 0, At, B0); G_BAR; G_SCHED;
        G_LDB(B1, 0, 1); G_STAGE_B(0, 0, t + 2);
        G_BAR; G_WAIT_L(0); G_MMA(0, 1, At, B1); G_BAR;
        G_LDA(At, 0, 1); G_STAGE_A(0, 0, t + 2);
        G_BAR; G_WAIT_L(0); G_MMA(1, 0, At, B0); G_BAR; G_SCHED;
        G_STAGE_B(0, 1, t + 2);
        G_WAIT_V(6); G_BAR; G_MMA(1, 1, At, B1); G_BAR;
        G_LDB(B0, 1, 0); G_SCHED; G_LDA(At, 1, 0); G_STAGE_A(0, 1, t + 2);
        G_WAIT_L(8); G_BAR; G_WAIT_L(0); G_MMA(0, 0, At, B0); G_BAR; G_SCHED;
        G_LDB(B1, 1, 1); G_STAGE_B(1, 0, t + 3);
        G_BAR; G_WAIT_L(0); G_MMA(0, 1, At, B1); G_BAR;
        G_LDA(At, 1, 1); G_STAGE_A(1, 0, t + 3);
        G_BAR; G_WAIT_L(0); G_MMA(1, 0, At, B0); G_BAR; G_SCHED;
        G_STAGE_B(1, 1, t + 3);
        G_WAIT_V(6); G_BAR; G_MMA(1, 1, At, B1); G_BAR;
    }
    { G_LDB(B0, 0, 0); G_WAIT_V(0); G_LDA(At, 0, 0); G_STAGE_A(1, 1, nt - 1);
      G_BAR; G_WAIT_L(0); G_MMA(0, 0, At, B0); G_BAR;
      G_LDB(B1, 0, 1); G_BAR; G_WAIT_L(0); G_MMA(0, 1, At, B1); G_BAR;
      G_LDA(At, 0, 1); G_WAIT_V(4); G_BAR; G_WAIT_L(0); G_MMA(1, 0, At, B0); G_MMA(1, 1, At, B1); G_BAR; }
    { G_LDB(B0, 1, 0); G_LDA(At, 1, 0); G_WAIT_V(2); G_BAR; G_WAIT_L(0); G_MMA(0, 0, At, B0); G_BAR;
      G_LDB(B1, 1, 1); G_WAIT_V(0); G_BAR; G_WAIT_L(0); G_MMA(0, 1, At, B1); G_BAR;
      G_LDA(At, 1, 1); G_BAR; G_WAIT_L(0); G_MMA(1, 0, At, B0); G_MMA(1, 1, At, B1); G_BAR; }
    if (wr == 0) G_BAR;
    if (FP8) asm volatile("s_nop 15\n\ts_nop 15" ::: "memory");
    {
        int tz = threadIdx.x; asm volatile("" : "+v"(tz));
        const int wid2 = tz >> 6, lane2 = tz & 63;
        epi(acc, wid2 >> 2, wid2 & 3, lane2 & 15, lane2 >> 4);
    }
    __syncthreads();
}

template <bool FP8, int EPI_STORES, class Epi>
__device__ __forceinline__ void gemm_unit_pre(const void* __restrict__ A, const unsigned (&aoffb)[4], const void* __restrict__ Bt, const int PITCH, const Epi& epi,
                                              const bool staged, const bool has_next, const void* __restrict__ nA, const void* __restrict__ nB) {
    constexpr int NT = 0;
    LAS unsigned char* lds = (LAS unsigned char*)dynlds;
    const int tid = opaque_tid();
    const int wid = __builtin_amdgcn_readfirstlane(tid >> 6), lane = tid & 63, wr = wid >> 2, wc = wid & 3, fr = lane & 15, fq = lane >> 4;
    const unsigned va[4] = {aoffb[0], aoffb[1], aoffb[2], aoffb[3]};
    unsigned vb0, vb1;
    { int R0, C0, R1, C1; stage_rc(tid * 16, R0, C0); stage_rc(tid * 16 + 8192, R1, C1); vb0 = (unsigned)(R0 * PITCH + C0 * 2); vb1 = (unsigned)(R1 * PITCH + C1 * 2); }
    const char* Ab = (const char*)A; const char* Bb = (const char*)Bt;
    const size_t hstep = (size_t)HALF * PITCH;
    const unsigned ldsw = (unsigned)wid * 1024u;
    const int laoff = lds_byte(wr * 64 + fr, fq * 8), lboff = lds_byte(wc * 32 + fr, fq * 8);
    f32x4 acc[2][2][4][2];
#pragma unroll
    for (int a = 0; a < 2; ++a)
#pragma unroll
        for (int b = 0; b < 2; ++b)
#pragma unroll
            for (int m = 0; m < 4; ++m)
#pragma unroll
                for (int n = 0; n < 2; ++n) acc[a][b][m][n] = (f32x4){0.f, 0.f, 0.f, 0.f};
    i32x8 At[4], B0[2], B1[2];
    const int nt = NT ? NT : PITCH / (BK * 2);
    if (!staged) {
        __syncthreads();
        G_STAGE_B(0, 0, 0); G_STAGE_A(0, 0, 0); G_STAGE_B(0, 1, 0); G_STAGE_A(0, 1, 0);
        if (wr == 1) G_BAR;
        G_WAIT_V(4); G_BAR;
    } else {
        static_assert(EPI_STORES == 8, "the counted wait below is written for 8 stores");
        if (wr == 1) G_BAR;
        G_WAIT_V(8); G_BAR;
    }
    G_STAGE_B(1, 0, 1); G_STAGE_A(1, 0, 1); G_STAGE_B(1, 1, 1);
    G_WAIT_V(6); G_BAR;
    for (int t = 0; t < nt - 2; t += 2) {
        G_LDB(B0, 0, 0); G_SCHED; G_LDA(At, 0, 0); G_STAGE_A(1, 1, t + 1);
        G_WAIT_L(8); G_BAR; G_WAIT_L(0); G_MMA(0, 0, At, B0); G_BAR; G_SCHED;
        G_LDB(B1, 0, 1); G_STAGE_B(0, 0, t + 2);
        G_BAR; G_WAIT_L(0); G_MMA(0, 1, At, B1); G_BAR;
        G_LDA(At, 0, 1); G_STAGE_A(0, 0, t + 2);
        G_BAR; G_WAIT_L(0); G_MMA(1, 0, At, B0); G_BAR; G_SCHED;
        G_STAGE_B(0, 1, t + 2);
        G_WAIT_V(6); G_BAR; G_MMA(1, 1, At, B1); G_BAR;
        G_LDB(B0, 1, 0); G_SCHED; G_LDA(At, 1, 0); G_STAGE_A(0, 1, t + 2);
        G_WAIT_L(8); G_BAR; G_WAIT_L(0); G_MMA(0, 0, At, B0); G_BAR; G_SCHED;
        G_LDB(B1, 1, 1); G_STAGE_B(1, 0, t + 3);
        G_BAR; G_WAIT_L(0); G_MMA(0, 1, At, B1); G_BAR;
        G_LDA(At, 1, 1); G_STAGE_A(1, 0, t + 3);
        G_BAR; G_WAIT_L(0); G_MMA(1, 0, At, B0); G_BAR; G_SCHED;
        G_STAGE_B(1, 1, t + 3);
        G_WAIT_V(6); G_BAR; G_MMA(1, 1, At, B1); G_BAR;
    }
    { G_LDB(B0, 0, 0); G_WAIT_V(0); G_LDA(At, 0, 0); G_STAGE_A(1, 1, nt - 1);
      G_BAR; G_WAIT_L(0); G_MMA(0, 0, At, B0); G_BAR;
      G_LDB(B1, 0, 1); G_BAR; G_WAIT_L(0); G_MMA(0, 1, At, B1); G_BAR;
      G_LDA(At, 0, 1); G_WAIT_V(4); G_BAR; G_WAIT_L(0); G_MMA(1, 0, At, B0); G_MMA(1, 1, At, B1); G_BAR; }
    { G_LDB(B0, 1, 0); G_LDA(At, 1, 0); G_WAIT_V(2); G_BAR; G_WAIT_L(0); G_MMA(0, 0, At, B0); G_BAR;
      G_LDB(B1, 1, 1); G_WAIT_V(0); G_BAR; G_WAIT_L(0); G_MMA(0, 1, At, B1); G_BAR;
      G_LDA(At, 1, 1); G_BAR; G_WAIT_L(0); G_MMA(1, 0, At, B0); G_MMA(1, 1, At, B1); G_BAR; }
    if (wr == 0) G_BAR;
    if (FP8) asm volatile("s_nop 15\n\ts_nop 15" ::: "memory");
    {
        int tz = threadIdx.x; asm volatile("" : "+v"(tz));
        const int wid2 = tz >> 6, lane2 = tz & 63;
        epi.stage(acc, wid2 >> 2, wid2 & 3, lane2 & 15, lane2 >> 4);
    }
    if (has_next) {
        const char* nAb = (const char*)nA; const char* nBb = (const char*)nB;
        int tz2 = threadIdx.x; asm volatile("" : "+v"(tz2));
        int R0, C0, R1, C1; stage_rc(tz2 * 16, R0, C0); stage_rc(tz2 * 16 + 8192, R1, C1);
        const unsigned o0 = (unsigned)(R0 * PITCH + C0 * 2), o1 = (unsigned)(R1 * PITCH + C1 * 2);
        const size_t hs = (size_t)HALF * PITCH;
        {
            const unsigned ldsw = (unsigned)(tz2 >> 6) * 1024u;
            G_STAGE(G_SB(0, 0), nBb, o0, o1); G_STAGE(G_SA(0, 0), nAb, o0, o1); G_STAGE(G_SB(0, 1), nBb + hs, o0, o1); G_STAGE(G_SA(0, 1), nAb + hs, o0, o1);
        }
    }
    epi.store();
    G_WAIT_L(0); G_BAR;
}


struct GUnit { const char* A; const char* B; int u0, u1, u2, u3; };
template <bool FP8, bool GATHER, class Sc>
__device__ __forceinline__ void gemm_stream(Sc& sc, const int PITCH, const int nt) {
    LAS unsigned char* lds = (LAS unsigned char*)dynlds;
    const int tid = opaque_tid();
    const int wid = __builtin_amdgcn_readfirstlane(tid >> 6), lane = tid & 63, wr = wid >> 2, wc = wid & 3, fr = lane & 15, fq = lane >> 4;
    unsigned vb0, vb1, vac[4], van[4];
    { int R0, C0, R1, C1; stage_rc(tid * 16, R0, C0); stage_rc(tid * 16 + 8192, R1, C1); vb0 = (unsigned)(R0 * PITCH + C0 * 2); vb1 = (unsigned)(R1 * PITCH + C1 * 2); }
    const size_t hstep = (size_t)HALF * PITCH, kstep = (size_t)(BK * 2);
    vac[0] = vb0; vac[1] = vb1; vac[2] = vb0 + (unsigned)hstep; vac[3] = vb1 + (unsigned)hstep;
    const unsigned ldsw = (unsigned)wid * 1024u;
    const int laoff = lds_byte(wr * 64 + fr, fq * 8), lboff = lds_byte(wc * 32 + fr, fq * 8);
    GUnit cur, nxt;
    if (!sc.next(0, cur, vac)) return;
    f32x4 acc[2][2][4][2];
#pragma unroll
    for (int a = 0; a < 2; ++a)
#pragma unroll
        for (int b = 0; b < 2; ++b)
#pragma unroll
            for (int m = 0; m < 4; ++m)
#pragma unroll
                for (int n = 0; n < 2; ++n) acc[a][b][m][n] = (f32x4){0.f, 0.f, 0.f, 0.f};
    i32x8 At[4], B0[2], B1[2];
    const char* cA = cur.A; const char* cB = cur.B;
#define S_STA(b, h, base, V) G_STAGE(G_SA(b, h), base, V[(h) * 2], V[(h) * 2 + 1])
#define S_STB(b, h, base) G_STAGE(G_SB(b, h), (base) + (size_t)(h) * hstep, vb0, vb1)
    __syncthreads();
    S_STB(0, 0, cB); S_STA(0, 0, cA, vac); S_STB(0, 1, cB); S_STA(0, 1, cA, vac);
    if (wr == 1) G_BAR;
    G_WAIT_V(4); G_BAR;
    S_STB(1, 0, cB + kstep); S_STA(1, 0, cA + kstep, vac); S_STB(1, 1, cB + kstep);
    G_WAIT_V(6); G_BAR;
    for (int ui = 0;; ++ui) {
        bool has_next;
        if (GATHER) has_next = sc.next(ui + 1, nxt, van); else { unsigned dummy[4]; has_next = sc.next(ui + 1, nxt, dummy); }
        const char* nA = has_next ? nxt.A : cA; const char* nB = has_next ? nxt.B : cB;
        if (GATHER && !has_next) { van[0] = vac[0]; van[1] = vac[1]; van[2] = vac[2]; van[3] = vac[3]; }
        for (int t = 0; t < nt; t += 2) {
            const bool last = (t == nt - 2);
            const char* a1 = cA + (size_t)(t + 1) * kstep;
            const char* a2 = last ? nA : cA + (size_t)(t + 2) * kstep; const char* b2 = last ? nB : cB + (size_t)(t + 2) * kstep;
            const char* a3 = a2 + kstep; const char* b3 = b2 + kstep;
            unsigned vx[4];
            if (GATHER) { vx[0] = last ? van[0] : vac[0]; vx[1] = last ? van[1] : vac[1]; vx[2] = last ? van[2] : vac[2]; vx[3] = last ? van[3] : vac[3]; }
            else { vx[0] = vac[0]; vx[1] = vac[1]; vx[2] = vac[2]; vx[3] = vac[3]; }
            G_LDB(B0, 0, 0); G_SCHED; G_LDA(At, 0, 0); S_STA(1, 1, a1, vac);
            G_WAIT_L(8); G_BAR; G_WAIT_L(0); G_MMA(0, 0, At, B0); G_BAR; G_SCHED;
            G_LDB(B1, 0, 1); S_STB(0, 0, b2);
            G_BAR; G_WAIT_L(0); G_MMA(0, 1, At, B1); G_BAR;
            G_LDA(At, 0, 1); S_STA(0, 0, a2, vx);
            G_BAR; G_WAIT_L(0); G_MMA(1, 0, At, B0); G_BAR; G_SCHED;
            S_STB(0, 1, b2);
            G_WAIT_V(6); G_BAR; G_MMA(1, 1, At, B1); G_BAR;
            G_LDB(B0, 1, 0); G_SCHED; G_LDA(At, 1, 0); S_STA(0, 1, a2, vx);
            G_WAIT_L(8); G_BAR; G_WAIT_L(0); G_MMA(0, 0, At, B0); G_BAR; G_SCHED;
            G_LDB(B1, 1, 1); S_STB(1, 0, b3);
            G_BAR; G_WAIT_L(0); G_MMA(0, 1, At, B1); G_BAR;
            G_LDA(At, 1, 1); S_STA(1, 0, a3, vx);
            G_BAR; G_WAIT_L(0); G_MMA(1, 0, At, B0); G_BAR; G_SCHED;
            S_STB(1, 1, b3);
            G_WAIT_V(6); G_BAR; G_MMA(1, 1, At, B1); G_BAR;
        }
        if (FP8) asm volatile("s_nop 15\n\ts_nop 15" ::: "memory");
        {
            int tz = threadIdx.x; asm volatile("" : "+v"(tz));
            const int wid2 = tz >> 6, lane2 = tz & 63;
            sc.epilogue(acc, cur, wid2 >> 2, wid2 & 3, lane2 & 15, lane2 >> 4);
        }
        if (!has_next) break;
#pragma unroll
        for (int a = 0; a < 2; ++a)
#pragma unroll
            for (int b = 0; b < 2; ++b)
#pragma unroll
                for (int m = 0; m < 4; ++m)
#pragma unroll
                    for (int n = 0; n < 2; ++n) acc[a][b][m][n] = (f32x4){0.f, 0.f, 0.f, 0.f};
        cur = nxt; cA = nA; cB = nB;
        if (GATHER) { vac[0] = van[0]; vac[1] = van[1]; vac[2] = van[2]; vac[3] = van[3]; }
    }
    G_WAIT_V(0);
    if (wr == 0) G_BAR;
    __syncthreads();
#undef S_STA
#undef S_STB
}

__device__ __forceinline__ bool dense_order(int i, int c, int G, int nM, int nN, int& pm, int& pn) {
    const int nwg = nM * nN; const long L = (long)i * G + c; if (L >= nwg) return false;
    int wgid = (int)L; { const int q = nwg / 8, r = nwg % 8, xcd = wgid % 8, off = wgid / 8; wgid = (xcd < r ? xcd * (q + 1) : r * (q + 1) + (xcd - r) * q) + off; }
    const int nig = 8 * nN, gid = wgid / nig, fm = gid * 8, gsz = (nM - fm) < 8 ? (nM - fm) : 8;
    pm = fm + ((wgid % nig) % gsz); pn = (wgid % nig) / gsz; return true;
}

typedef f32x4 AccT[2][2][4][2];

constexpr unsigned TPB = 528;
__device__ __forceinline__ void stage_tile_bf16(const AccT& acc, int wr, int wc, int fr, int fq, float scale) {
    LAS unsigned char* L8 = (LAS unsigned char*)dynlds;
#pragma unroll
    for (int ai = 0; ai < 2; ++ai)
#pragma unroll
        for (int m = 0; m < 4; ++m) {
            const unsigned ro = (unsigned)(ai * 128 + wr * 64 + m * 16 + fr) * TPB + (wc * 32 + fq * 4) * 2;
#pragma unroll
            for (int bj = 0; bj < 2; ++bj)
#pragma unroll
                for (int n = 0; n < 2; ++n) { const f32x4 v = acc[ai][bj][m][n] * scale; u32x2 w; w.x = pk2(v[0], v[1]); w.y = pk2(v[2], v[3]); *(LAS u32x2*)(L8 + ro + (bj * 128 + n * 16) * 2) = w; }
        }
}

struct EpiProj {
    bf16_t* C; int ldc; int row0, col0;
    __device__ __forceinline__ void operator()(const AccT& acc, int wr, int wc, int fr, int fq) const {
        stage_tile_bf16(acc, wr, wc, fr, fq, 1.0f);
        __syncthreads();
        const int tid = opaque_tid(), wave = tid >> 6, lane = tid & 63;
        LAS unsigned char* L8 = (LAS unsigned char*)dynlds;
#pragma unroll 8
        for (int i = 0; i < 32; ++i) {
            const int r = wave * 32 + i;
            *(u32x2*)(C + (size_t)(row0 + r) * ldc + col0 + lane * 4) = *(const LAS u32x2*)(L8 + (unsigned)r * TPB + lane * 8);
        }
    }
};

struct EpiLora {
    bf16_t* LO; const float* lbias; int row0, col0;
    __device__ __forceinline__ void operator()(const AccT& acc, int wr, int wc, int fr, int fq) const {
        const int seg = col0 >> 10, cbase = (col0 & 1023) + wc * 32 + fq * 4;
        const float* bias = lbias + (seg & 3) * DR_;
        LAS unsigned char* L8 = (LAS unsigned char*)dynlds;
#pragma unroll
        for (int bj = 0; bj < 2; ++bj)
#pragma unroll
            for (int n = 0; n < 2; ++n) {
                const int c = cbase + bj * 128 + n * 16;
                f32x4 bv = (f32x4){0.f, 0.f, 0.f, 0.f};
                if (seg < 4) bv = *(const f32x4*)(bias + c);
#pragma unroll
                for (int ai = 0; ai < 2; ++ai)
#pragma unroll
                    for (int m = 0; m < 4; ++m) {
                        const f32x4 v = acc[ai][bj][m][n] + bv; float o[4];
#pragma unroll
                        for (int j = 0; j < 4; ++j) {
                            const float xx = v[j];
                            if (seg < 2) o[j] = 1.0f - __expf(-0.60653066f * sigmoidf_(xx));
                            else if (seg < 4) o[j] = sigmoidf_(xx);
                            else o[j] = xx;
                        }
                        u32x2 w; w.x = pk2(o[0], o[1]); w.y = pk2(o[2], o[3]);
                        *(LAS u32x2*)(L8 + (unsigned)(ai * 128 + wr * 64 + m * 16 + fr) * TPB + (bj * 128 + wc * 32 + n * 16 + fq * 4) * 2) = w;
                    }
            }
        __syncthreads();
        const int tid = opaque_tid(), wave = tid >> 6, lane = tid & 63;
        bf16_t* outp = LO + (size_t)seg * T_ * DR_ + (col0 & 1023);
#pragma unroll 8
        for (int i = 0; i < 32; ++i) {
            const int r = wave * 32 + i;
            *(u32x2*)(outp + (size_t)(row0 + r) * DR_ + lane * 4) = *(const LAS u32x2*)(L8 + (unsigned)r * TPB + lane * 8);
        }
    }
};

struct EpiWout {
    const float* x; const float* gate; float* out; float* ssq; int row0, col0;
    __device__ __forceinline__ void operator()(const AccT& acc, int wr, int wc, int fr, int fq) const {
        float ss[2][4];
#pragma unroll
        for (int ai = 0; ai < 2; ++ai)
#pragma unroll
            for (int m = 0; m < 4; ++m) ss[ai][m] = 0.f;
#pragma unroll
        for (int bj = 0; bj < 2; ++bj)
#pragma unroll
            for (int n = 0; n < 2; ++n) {
                const int c = col0 + bj * 128 + wc * 32 + n * 16 + fq * 4;
                const f32x4 g = *(const f32x4*)(gate + c);
#pragma unroll
                for (int ai = 0; ai < 2; ++ai)
#pragma unroll
                    for (int m = 0; m < 4; ++m) {
                        const size_t o = (size_t)(row0 + ai * 128 + wr * 64 + m * 16 + fr) * D_ + c;
                        const f32x4 xv = *(const f32x4*)(x + o);
                        const f32x4 r = xv + g * acc[ai][bj][m][n];
                        *(f32x4*)(out + o) = r;
                        ss[ai][m] += r[0] * r[0] + r[1] * r[1] + r[2] * r[2] + r[3] * r[3];
                    }
            }
#pragma unroll
        for (int ai = 0; ai < 2; ++ai)
#pragma unroll
            for (int m = 0; m < 4; ++m) {
                float v = ss[ai][m];
                v += __shfl_xor(v, 16); v += __shfl_xor(v, 32);
                if (fq == 0) ssq[(size_t)(row0 + ai * 128 + wr * 64 + m * 16 + fr) * 32 + (col0 >> 8) * 4 + wc] = v;
            }
    }
};

struct EpiGateUp {
    fp8_t* act; size_t arow0; int ncol0;
    __device__ __forceinline__ void operator()(const AccT& acc, int wr, int wc, int fr, int fq) const {
        LAS unsigned char* L8 = (LAS unsigned char*)dynlds;
        constexpr unsigned TP8 = 144;
#pragma unroll
        for (int ai = 0; ai < 2; ++ai)
#pragma unroll
            for (int m = 0; m < 4; ++m) {
#pragma unroll
                for (int n = 0; n < 2; ++n) {
                    const f32x4 g = acc[ai][0][m][n] * (1.0f / 64.0f), u = acc[ai][1][m][n] * (1.0f / 64.0f); float o[4];
#pragma unroll
                    for (int j = 0; j < 4; ++j) o[j] = g[j] * sigmoidf_(g[j]) * u[j];
                    *(LAS unsigned*)(L8 + (unsigned)(ai * 128 + wr * 64 + m * 16 + fr) * TP8 + wc * 32 + n * 16 + fq * 4) = pk4_fp8(o[0], o[1], o[2], o[3]);
                }
            }
        __syncthreads();
        const int tid = opaque_tid(), wave = tid >> 6, lane = tid & 63;
#pragma unroll
        for (int i = 0; i < 4; ++i) {
            const int r = wave * 32 + i * 8 + (lane >> 3);
            *(u32x4*)(act + (arow0 + r) * EFF + ncol0 + (lane & 7) * 16) = *(const LAS u32x4*)(L8 + (unsigned)r * TP8 + (lane & 7) * 16);
        }
    }
};

constexpr float SLOT_SCALE = 16.0f;
constexpr unsigned DR_STAGE = 65536;
constexpr unsigned DUMP_ROW = T_ * NSLOT;
template <bool ROUTED>
struct EpiDownRouted {
    fp8_t* slot; const unsigned* list; const float* gw; int r0, cnt, col0;
    static constexpr unsigned TQ = 272;
    __device__ __forceinline__ void stage(const AccT& acc, int wr, int wc, int fr, int fq) const {
        LAS unsigned char* L8 = (LAS unsigned char*)dynlds + DR_STAGE;
        LAS unsigned* rowslot = (LAS unsigned*)(L8 + 256 * TQ);
        unsigned sl[8]; float gg[8];
#pragma unroll
        for (int q = 0; q < 8; ++q) {
            const int lr = (q >> 2) * 128 + wr * 64 + (q & 3) * 16 + fr, rr = r0 + lr;
            if (ROUTED) { const int rc = rr < LIST_CAP ? rr : LIST_CAP - 1; const unsigned v = list[rc]; gg[q] = gw[rc] * (SLOT_SCALE / 32.0f); sl[q] = (rr < cnt) ? v : 0xffffffffu; }
            else { sl[q] = (unsigned)rr * NSLOT + TOPK; gg[q] = SLOT_SCALE / 32.0f; }
        }
#pragma unroll
        for (int ai = 0; ai < 2; ++ai)
#pragma unroll
            for (int m = 0; m < 4; ++m) {
                const int q = ai * 4 + m, lr = ai * 128 + wr * 64 + m * 16 + fr;
                if (wc == 0 && fq == 0) rowslot[lr] = (sl[q] != 0xffffffffu) ? sl[q] : DUMP_ROW;
                const unsigned ro = (unsigned)lr * TQ + wc * 32 + fq * 4;
#pragma unroll
                for (int bj = 0; bj < 2; ++bj)
#pragma unroll
                    for (int n = 0; n < 2; ++n) { const f32x4 v = acc[ai][bj][m][n] * gg[q]; *(LAS unsigned*)(L8 + ro + bj * 128 + n * 16) = pk4_fp8(v[0], v[1], v[2], v[3]); }
            }
        __syncthreads();
    }
    __device__ __forceinline__ void store() const {
        LAS unsigned char* L8 = (LAS unsigned char*)dynlds + DR_STAGE;
        LAS unsigned* rowslot = (LAS unsigned*)(L8 + 256 * TQ);
        const int tid = opaque_tid(), wave = tid >> 6, lane = tid & 63;
#pragma unroll
        for (int i = 0; i < 8; ++i) {
            const int r = wave * 32 + i * 4 + (lane >> 4);
            const unsigned sr = rowslot[r];
            *(u32x4*)(slot + (size_t)sr * D_ + col0 + (lane & 15) * 16) = *(const LAS u32x4*)(L8 + (unsigned)r * TQ + (lane & 15) * 16);
        }
    }
};

__device__ __forceinline__ int map_row(int mode, int n) {
    if (mode == 1) return ((n >> 7) << 8) + (n & 127);
    if (mode == 2) return ((n >> 7) << 8) + 128 + (n & 127);
    if (mode == 3) return n < RWKV_IN_ ? n : n + 96;
    return n;
}
__device__ __forceinline__ void cvt_wave_tile(const float* __restrict__ W, int N, int Kv, int k0, int n0, bf16_t* __restrict__ dst, int dld, int mode, int dcol0, float* scr, int lane) {
    f32x4 tv[8];
#pragma unroll
    for (int i = 0; i < 8; ++i) {
        const int kk = 8 * i + (lane >> 3);
        tv[i] = (f32x4){0.f, 0.f, 0.f, 0.f};
        if (k0 + kk < Kv) tv[i] = *(const f32x4*)(W + (size_t)(k0 + kk) * N + n0 + (lane & 7) * 4);
    }
#pragma unroll
    for (int i = 0; i < 8; ++i) {
        const int kk = 8 * i + (lane >> 3);
#pragma unroll
        for (int j = 0; j < 4; ++j) scr[kk * 33 + (lane & 7) * 4 + j] = tv[i][j];
    }
    asm volatile("s_waitcnt lgkmcnt(0)" ::: "memory");
    const int c = lane & 7;
#pragma unroll
    for (int j = 0; j < 4; ++j) {
        const int n = (lane >> 3) + 8 * j; const float* sp = scr + (8 * c) * 33 + n;
        uint4 o; o.x = pk2(sp[0 * 33], sp[1 * 33]); o.y = pk2(sp[2 * 33], sp[3 * 33]); o.z = pk2(sp[4 * 33], sp[5 * 33]); o.w = pk2(sp[6 * 33], sp[7 * 33]);
        *(uint4*)(dst + (size_t)map_row(mode, n0 + n) * dld + dcol0 + k0 + 8 * c) = o;
    }
    asm volatile("s_waitcnt lgkmcnt(0)" ::: "memory");
}
__device__ __forceinline__ void cvt_f8_load(const float* __restrict__ W, int N, int k0, int n0, float (&tv)[32], int lane) {
#pragma unroll
    for (int i = 0; i < 8; ++i) {
        const float* Wi = W + (size_t)(k0 + 16 * i) * N + n0;
        const f32x4 v = *(const f32x4*)(Wi + (unsigned)((lane >> 2) * N + (lane & 3) * 4));
        tv[4 * i] = v[0]; tv[4 * i + 1] = v[1]; tv[4 * i + 2] = v[2]; tv[4 * i + 3] = v[3];
    }
}
__device__ __forceinline__ void cvt_f8_finish(const float (&tv)[32], int k0, int n0, fp8_t* __restrict__ dst, int dld, int mode, float scl, float* scr, int lane) {
#pragma unroll
    for (int i = 0; i < 8; ++i)
#pragma unroll
        for (int j = 0; j < 4; ++j) scr[(16 * i + (lane >> 2)) * 17 + (lane & 3) * 4 + j] = tv[4 * i + j];
    asm volatile("s_waitcnt lgkmcnt(0)" ::: "memory");
#pragma unroll
    for (int q = 0; q < 2; ++q) {
        const int pr = lane + 64 * q, n = pr >> 3, ck = pr & 7; const float* sp = scr + (ck * 16) * 17 + n;
        uint4 o;
        o.x = pk4_fp8(sp[0 * 17] * scl, sp[1 * 17] * scl, sp[2 * 17] * scl, sp[3 * 17] * scl);
        o.y = pk4_fp8(sp[4 * 17] * scl, sp[5 * 17] * scl, sp[6 * 17] * scl, sp[7 * 17] * scl);
        o.z = pk4_fp8(sp[8 * 17] * scl, sp[9 * 17] * scl, sp[10 * 17] * scl, sp[11 * 17] * scl);
        o.w = pk4_fp8(sp[12 * 17] * scl, sp[13 * 17] * scl, sp[14 * 17] * scl, sp[15 * 17] * scl);
        *(uint4*)(dst + (size_t)map_row(mode, n0 + n) * dld + k0 + ck * 16) = o;
    }
    asm volatile("s_waitcnt lgkmcnt(0)" ::: "memory");
}
__device__ __forceinline__ void cvt_wave_tile_f8(const float* __restrict__ W, int N, int k0, int n0, fp8_t* __restrict__ dst, int dld, int mode, float scl, float* scr, int lane) {
    float tv[32]; cvt_f8_load(W, N, k0, n0, tv, lane); cvt_f8_finish(tv, k0, n0, dst, dld, mode, scl, scr, lane);
}
__device__ __forceinline__ void cvt_expert_load(const Params& p, int wt, float (&tv)[32], int lane) {
    const int mtx = wt >> 15, r = wt & 32767, e = r >> 9, rr = r & 511;
    if (mtx < 2) cvt_f8_load((mtx ? p.w_up_e : p.w_gate_e) + (size_t)e * 2048 * 512, 512, (rr >> 5) * 128, (rr & 31) * 16, tv, lane);
    else cvt_f8_load(p.w_down_e + (size_t)e * 512 * 2048, 2048, (rr >> 7) * 128, (rr & 127) * 16, tv, lane);
}
__device__ __forceinline__ void cvt_expert_finish(const Params& p, int wt, const float (&tv)[32], float* scr, int lane) {
    const int mtx = wt >> 15, r = wt & 32767, e = r >> 9, rr = r & 511;
    if (mtx < 2) cvt_f8_finish(tv, (rr >> 5) * 128, (rr & 31) * 16, p.We1q + (size_t)e * 1024 * 2048, 2048, 1 + mtx, 64.0f, scr, lane);
    else cvt_f8_finish(tv, (rr >> 7) * 128, (rr & 127) * 16, p.We2q + (size_t)e * 2048 * 512, 512, 0, 32.0f, scr, lane);
}
__device__ __forceinline__ void cvt_expert_tile(const Params& p, int wt, float* scr, int lane) {
    float tv[32]; cvt_expert_load(p, wt, tv, lane); cvt_expert_finish(p, wt, tv, scr, lane);
}

constexpr int W_IN = 32 * 205, W_OUT = 32 * 64, W_S = 32 * 16, W_SD = 8 * 64, W_L = 32, W_G = 3 * 32;
constexpr int W_DEFER = W_OUT + 2 * W_S + W_SD, W_TOTAL = W_IN + W_DEFER + 4 * W_L + W_G;
__device__ __forceinline__ void small_tile(const Params& p, int r, float* scr, int lane) {
    if (r < W_IN) { cvt_wave_tile(p.w_in, 6560, 2048, (r / 205) * 64, (r % 205) * 32, p.Win, 2048, 3, 0, scr, lane); return; } r -= W_IN;
    if (r < W_OUT) { cvt_wave_tile(p.w_out, 2048, 2048, (r >> 6) * 64, (r & 63) * 32, p.Wout, 2048, 0, 0, scr, lane); return; } r -= W_OUT;
    if (r < W_S) { cvt_wave_tile_f8(p.w_gate_s, 512, (r >> 5) * 128, (r & 31) * 16, p.Ws1q, 2048, 1, 64.0f, scr, lane); return; } r -= W_S;
    if (r < W_S) { cvt_wave_tile_f8(p.w_up_s, 512, (r >> 5) * 128, (r & 31) * 16, p.Ws1q, 2048, 2, 64.0f, scr, lane); return; } r -= W_S;
    if (r < W_SD) { cvt_wave_tile_f8(p.w_down_s, 2048, (r >> 7) * 128, (r & 127) * 16, p.Ws2q, 512, 0, 32.0f, scr, lane); return; } r -= W_SD;
    if (r < W_L) { cvt_wave_tile(p.w_up_f, 1024, 64, 0, r * 32, p.Wlora, 512, 0, 0, scr, lane); return; } r -= W_L;
    if (r < W_L) { cvt_wave_tile(p.w_up_b, 1024, 64, 0, r * 32, p.Wlora + (size_t)1024 * 512, 512, 0, 64, scr, lane); return; } r -= W_L;
    if (r < W_L) { cvt_wave_tile(p.a_up_f, 1024, 64, 0, r * 32, p.Wlora + (size_t)2048 * 512, 512, 0, 128, scr, lane); return; } r -= W_L;
    if (r < W_L) { cvt_wave_tile(p.a_up_b, 1024, 64, 0, r * 32, p.Wlora + (size_t)3072 * 512, 512, 0, 192, scr, lane); return; } r -= W_L;
    cvt_wave_tile(p.g_up, 1024, 160, (r >> 5) * 64, (r & 31) * 32, p.Wlora + (size_t)4096 * 512, 512, 0, 256, scr, lane);
}
constexpr int CVT_ITEMS = 3 * 32768 / 32, PRE_PER_WG = 0;
__device__ __forceinline__ void tail_split(int G, int& first_idle, int& n_idle) {
    const int rem = ((T_ / 256) * (NPROJ / 256)) % G;
    first_idle = rem == 0 ? G : rem; n_idle = G - first_idle;
}
__device__ __forceinline__ int conv_prefilled(int G) { int f, n; tail_split(G, f, n); const int v = n * PRE_PER_WG; return v < CVT_ITEMS ? v : CVT_ITEMS; }

__device__ __forceinline__ void phase_prologue(const Params& p) {
    const int tid = opaque_tid(), wave = tid >> 6, lane = tid & 63, bid = blockIdx.x, nb = gridDim.x;
    for (int u = bid; u < 192; u += nb) {
        float* sc = (float*)dynlds; float* red = sc + 4 * D_;
        __syncthreads();
        for (int i = tid; i < 4 * D_; i += NTHREADS) { const float cv = p.c[i]; sc[i] = cv * sigmoidf_(cv); }
        __syncthreads();
        float acc[4][4];
#pragma unroll
        for (int b = 0; b < 4; ++b)
#pragma unroll
            for (int j = 0; j < 4; ++j) acc[b][j] = 0.f;
        const int rg = lane >> 4, c4 = (lane & 15) * 4;
        const float* wp = p.w_ada + (size_t)(wave * 256 + rg) * 12288 + u * 64 + c4;
#pragma unroll 16
        for (int it = 0; it < 64; ++it) {
            const float4 wv = *(const float4*)(wp + (size_t)it * 4 * 12288);
            const int k = wave * 256 + it * 4 + rg;
#pragma unroll
            for (int b = 0; b < 4; ++b) { const float sv = sc[b * D_ + k]; acc[b][0] += sv * wv.x; acc[b][1] += sv * wv.y; acc[b][2] += sv * wv.z; acc[b][3] += sv * wv.w; }
        }
#pragma unroll
        for (int b = 0; b < 4; ++b)
#pragma unroll
            for (int j = 0; j < 4; ++j) red[(wave * 16 + b * 4 + j) * 64 + lane] = acc[b][j];
        __syncthreads();
        if (tid < 256) {
            const int b = tid >> 6, col = tid & 63, cl = col >> 2, j = col & 3;
            float sm = 0.f;
#pragma unroll
            for (int w = 0; w < 8; ++w)
#pragma unroll
                for (int g = 0; g < 4; ++g) sm += red[(w * 16 + b * 4 + j) * 64 + g * 16 + cl];
            p.mod[b * 12288 + u * 64 + col] = sm + p.b_ada[u * 64 + col];
        }
        __syncthreads();
    }
    for (int i = bid * NTHREADS + tid; i < 4 * DR_; i += nb * NTHREADS) {
        const int sg = i >> 10, c = i & 1023;
        float v = p.w0_f[c]; if (sg == 1) v = p.w0_b[c]; if (sg == 2) v = p.a0_f[c]; if (sg == 3) v = p.a0_b[c];
        p.lbias[i] = v;
    }
    for (int i = bid * NTHREADS + tid; i < 96 * D_ / 8; i += nb * NTHREADS) *(uint4*)(p.Win + (size_t)RWKV_IN_ * D_ + (size_t)i * 8) = make_uint4(0u, 0u, 0u, 0u);
    {
        float* scr = (float*)dynlds + wave * 2176;
        int fi, ni; tail_split(nb, fi, ni);
        const bool defer = ni > 0;
        __syncthreads();
        for (int it = bid * 8 + wave; it < (defer ? W_TOTAL - W_DEFER : W_TOTAL); it += nb * 8) {
            int r = it; if (defer && r >= W_IN) r += W_DEFER;
            small_tile(p, r, scr, lane);
        }
        __syncthreads();
    }
}

__device__ __forceinline__ void phase_norm1(const Params& p) {
    const int tid = opaque_tid(), wave = tid >> 6, lane = tid & 63;
    for (int row = blockIdx.x * 8 + wave; row < T_; row += gridDim.x * 8) {
        const int b = row >> 12;
        const float4* xr = (const float4*)(p.x + (size_t)row * D_) + lane;
        float4 v[8]; float ss = 0.f;
#pragma unroll
        for (int i = 0; i < 8; ++i) { v[i] = xr[i * 64]; ss += v[i].x * v[i].x + v[i].y * v[i].y + v[i].z * v[i].z + v[i].w * v[i].w; }
        ss = wave_sum(ss);
        const float rstd = rsqrtf(ss * (1.0f / D_) + 1e-6f);
        const float* modb = p.mod + b * 12288;
        bf16_t* hr = p.H + (size_t)row * D_;
#pragma unroll
        for (int i = 0; i < 8; ++i) {
            const int c = i * 256 + lane * 4;
            const float4 nw = *(const float4*)(p.norm1_w + c), sh = *(const float4*)(modb + c), sc = *(const float4*)(modb + 2048 + c);
            u32x2 w;
            w.x = pk2(v[i].x * rstd * nw.x * (1.f + sc.x) + sh.x, v[i].y * rstd * nw.y * (1.f + sc.y) + sh.y);
            w.y = pk2(v[i].z * rstd * nw.z * (1.f + sc.z) + sh.z, v[i].w * rstd * nw.w * (1.f + sc.w) + sh.w);
            *(u32x2*)(hr + c) = w;
        }
    }
}

__device__ __forceinline__ void dense_aoff(unsigned (&aoff)[4], int row0, int pitch) {
    const int tid = opaque_tid();
    int R0, C0, R1, C1; stage_rc(tid * 16, R0, C0); stage_rc(tid * 16 + 8192, R1, C1);
    aoff[0] = (unsigned)(row0 + R0) * pitch + C0 * 2; aoff[1] = (unsigned)(row0 + R1) * pitch + C1 * 2;
    aoff[2] = (unsigned)(row0 + 128 + R0) * pitch + C0 * 2; aoff[3] = (unsigned)(row0 + 128 + R1) * pitch + C1 * 2;
}

__device__ __forceinline__ void phase_gemm_in(const Params& p) {
    for (int i = 0;; ++i) {
        int pm, pn; if (!dense_order(i, blockIdx.x, gridDim.x, T_ / 256, NPROJ / 256, pm, pn)) break;
        unsigned aoff[4]; dense_aoff(aoff, pm * 256, D_ * 2);
        EpiProj epi{p.proj, NPROJ, pm * 256, pn * 256};
        gemm_unit<false>(p.H, aoff, p.Win + (size_t)pn * 256 * D_, D_ * 2, epi);
    }
    int fi, ni; tail_split(gridDim.x, fi, ni);
    if ((int)blockIdx.x >= fi) {
        const int tid = opaque_tid(), wave = tid >> 6, lane = tid & 63, j = blockIdx.x - fi;
        float* scr = (float*)dynlds + wave * 2176;
        for (int it = j * 8 + wave; it < W_DEFER; it += ni * 8) small_tile(p, W_IN + it, scr, lane);
#pragma unroll 1
        for (int k = 0; k < PRE_PER_WG; ++k) {
            const int item = j * PRE_PER_WG + k;
            if (item < CVT_ITEMS) {
#pragma unroll 1
                for (int q = 0; q < 4; ++q) cvt_expert_tile(p, item * 32 + wave * 4 + q, scr, lane);
            }
        }
        __syncthreads();
    }
}
__device__ __forceinline__ void phase_gemm_lora(const Params& p) {
    for (int i = 0;; ++i) {
        int pm, pn; if (!dense_order(i, blockIdx.x, gridDim.x, T_ / 256, 4096 / 256, pm, pn)) break;
        const int koff = 0;
        unsigned aoff[4]; dense_aoff(aoff, pm * 256, 512 * 2);
        EpiLora epi{p.LO, p.lbias, pm * 256, pn * 256};
        gemm_unit<false>((const char*)p.Alora + koff, aoff, (const char*)(p.Wlora + (size_t)pn * 256 * 512) + koff, 512 * 2, epi, 4);
    }
}
__device__ __forceinline__ void phase_gemm_out(const Params& p) {
    for (int i = 0;; ++i) {
        int pm, pn; if (!dense_order(i, blockIdx.x, gridDim.x, T_ / 256, D_ / 256, pm, pn)) break;
        unsigned aoff[4]; dense_aoff(aoff, pm * 256, D_ * 2);
        EpiWout epi{p.x, p.mod + ((pm * 256) >> 12) * 12288 + 4096, p.out, p.ssq, pm * 256, pn * 256};
        gemm_unit<false>(p.ycat, aoff, p.Wout + (size_t)pn * 256 * D_, D_ * 2, epi);
    }
}

__device__ __forceinline__ void shifted8(const Params& p, int t, int ch, float (&z)[8]) {
    const int s = t & (SEQ_ - 1);
    const bf16_t* pr = p.proj + (size_t)t * NPROJ + ch;
    const uint4 cur = *(const uint4*)pr;
    uint4 prv = make_uint4(0u, 0u, 0u, 0u), nxt = make_uint4(0u, 0u, 0u, 0u);
    if (s > 0) prv = *(const uint4*)(pr - NPROJ);
    if (s < SEQ_ - 1) nxt = *(const uint4*)(pr + NPROJ);
    float a[8], b[8], c[8]; unpack8(prv, a); unpack8(cur, b); unpack8(nxt, c);
    const float* sw = p.rwkv_shift + ch;
#pragma unroll
    for (int j = 0; j < 8; ++j) z[j] = sw[j] * a[j] + sw[RWKV_IN_ + j] * b[j] + sw[2 * RWKV_IN_ + j] * c[j];
}

__device__ __forceinline__ void phase_prep(const Params& p) {
    const int tid = opaque_tid();
    for (int u = blockIdx.x; u < T_ / 64; u += gridDim.x) {
        const int t0 = u * 64;
        {
            const int gl = tid & 127, tq = tid >> 7;
#pragma unroll 1
            for (int seg = 0; seg < 3; ++seg) {
                const int ch = gl * 8, pc = seg * 1024 + ch;
                float w0[8], w1[8], w2[8], kkw[8];
#pragma unroll
                for (int j = 0; j < 8; ++j) { w0[j] = p.rwkv_shift[pc + j]; w1[j] = p.rwkv_shift[RWKV_IN_ + pc + j]; w2[j] = p.rwkv_shift[2 * RWKV_IN_ + pc + j]; kkw[j] = p.k_k[ch + j]; }
                const int tb = t0 + tq * 16;
                const bf16_t* pr = p.proj + (size_t)tb * NPROJ + pc;
                float a[8], b[8], c[8];
                { uint4 prv = make_uint4(0u, 0u, 0u, 0u); if ((tb & (SEQ_ - 1)) > 0) prv = *(const uint4*)(pr - NPROJ); unpack8(prv, a); unpack8(*(const uint4*)pr, b); }
#pragma unroll 8
                for (int j16 = 0; j16 < 16; ++j16) {
                    const int t = tb + j16;
                    uint4 nxt = make_uint4(0u, 0u, 0u, 0u);
                    if ((t & (SEQ_ - 1)) < SEQ_ - 1) nxt = *(const uint4*)(pr + (size_t)(j16 + 1) * NPROJ);
                    unpack8(nxt, c);
                    float z[8], kkv[8]; float ss = 0.f;
#pragma unroll
                    for (int j = 0; j < 8; ++j) { z[j] = w0[j] * a[j] + w1[j] * b[j] + w2[j] * c[j]; kkv[j] = z[j] * kkw[j]; ss += kkv[j] * kkv[j]; a[j] = b[j]; b[j] = c[j]; }
                    ss = red8_sum(ss);
                    const size_t o = (size_t)t * DR_ + ch;
                    if (seg == 0) *(uint4*)(p.rb + o) = pack8(z);
                    else if (seg == 2) *(uint4*)(p.vb + o) = pack8(z);
                    else {
                        *(uint4*)(p.kb + o) = pack8(z);
                        const float sc = rsqrtf(fmaxf(ss, 1e-12f));
#pragma unroll
                        for (int j = 0; j < 8; ++j) kkv[j] *= sc;
                        *(uint4*)(p.kkb + o) = pack8(kkv);
                    }
                }
            }
        }
#pragma unroll 4
        for (int it = tid; it < 64 * 64; it += NTHREADS) {
            const int tl = it >> 6, g = it & 63, t = t0 + tl;
            float z[8];
            if (g < 52) {
                shifted8(p, t, PC_L + g * 8, z);
                if (g < 16) {
#pragma unroll
                    for (int j = 0; j < 8; ++j) z[j] = tanhf(z[j]);
                } else if (g >= 32) {
#pragma unroll
                    for (int j = 0; j < 8; ++j) z[j] = sigmoidf_(z[j]);
                }
            } else {
#pragma unroll
                for (int j = 0; j < 8; ++j) z[j] = 0.f;
            }
            *(uint4*)(p.Alora + (size_t)t * 512 + g * 8) = pack8(z);
        }
    }
}

__device__ __forceinline__ void prep_na_tile(const Params& p, const int t0) {
    const int tid = opaque_tid();
    {
#pragma unroll 8
        for (int it = tid; it < 64 * 256; it += NTHREADS) {
            const int tl = it >> 8, g = it & 255, t = t0 + tl, isk = g >> 7, ch = (g & 127) * 8;
            const uint4 raw = *(const uint4*)(p.proj + (size_t)t * NPROJ + (isk ? PC_KN : PC_Q) + ch);
            float v[8]; unpack8(raw, v);
            float ss = 0.f;
#pragma unroll
            for (int j = 0; j < 8; ++j) ss += v[j] * v[j];
            ss = red8_sum(ss);
            const float rs = rsqrtf(ss * (1.0f / 64.0f) + 1e-6f) * (isk ? 1.0f : 0.125f);
            const float* nw = (isk ? p.kn_w : p.qn_w) + (ch & 63);
#pragma unroll
            for (int j = 0; j < 8; ++j) v[j] = v[j] * rs * nw[j];
            *(uint4*)((isk ? p.KN : p.QN) + ((size_t)((t >> 12) * 16 + (ch >> 6)) * SEQ_ + (t & (SEQ_ - 1))) * 64 + (ch & 63)) = pack8(v);
        }
        bf16_t* sT = (bf16_t*)dynlds;
        __syncthreads();
#pragma unroll 8
        for (int it = tid; it < 128 * 64; it += NTHREADS) {
            const int tl = it & 63, g = it >> 6;
            const uint4 raw = *(const uint4*)(p.proj + (size_t)(t0 + tl) * NPROJ + PC_VN + g * 8);
            const unsigned w[4] = {raw.x, raw.y, raw.z, raw.w};
#pragma unroll
            for (int j = 0; j < 4; ++j) { sT[(g * 8 + 2 * j) * 64 + tl] = (bf16_t)(w[j] & 0xffffu); sT[(g * 8 + 2 * j + 1) * 64 + tl] = (bf16_t)(w[j] >> 16); }
        }
        __syncthreads();
        {
            const int b = t0 >> 12, s0 = t0 & (SEQ_ - 1);
#pragma unroll 8
            for (int it = tid; it < 1024 * 8; it += NTHREADS) {
                const int ch = ((it >> 9) << 6) | (it & 63), t8 = (it >> 6) & 7;
                const uint4 v = *(const uint4*)(sT + ch * 64 + t8 * 8);
                *(uint4*)(p.VT + (((size_t)(b * 16 + (ch >> 6)) * (SEQ_ / 8) + (s0 >> 3) + t8) * 64 + (ch & 63)) * 8) = v;
            }
        }
        __syncthreads();
    }
}

typedef short s16x4 __attribute__((ext_vector_type(4)));
constexpr int CVT_TILES = 3 * 32768;
constexpr unsigned SLOT = 9216, SPITCH = 144;
__device__ __forceinline__ bf16x8 lds16(unsigned off) { return *(const LAS bf16x8*)((LAS unsigned char*)dynlds + off); }
template <bool SWAP>
__device__ __forceinline__ void mm_acc(f32x4 (&acc)[2], unsigned X, unsigned Y, int tm, int tn0, int fr, int fq) {
#pragma unroll
    for (int ks = 0; ks < 2; ++ks) {
        const bf16x8 xa = lds16(X + (unsigned)(tm * 16 + fr) * SPITCH + ks * 64 + fq * 16);
#pragma unroll
        for (int q = 0; q < 2; ++q) {
            const bf16x8 yb = lds16(Y + (unsigned)((tn0 + q) * 16 + fr) * SPITCH + ks * 64 + fq * 16);
            acc[q] = SWAP ? __builtin_amdgcn_mfma_f32_16x16x32_bf16(yb, xa, acc[q], 0, 0, 0) : __builtin_amdgcn_mfma_f32_16x16x32_bf16(xa, yb, acc[q], 0, 0, 0);
        }
    }
}
__device__ __forceinline__ void st_rows(unsigned D, const f32x4& v, int tm, int tn, int fr, int fq) {
    u32x2 w; w.x = pk2(v[0], v[1]); w.y = pk2(v[2], v[3]);
    *(LAS u32x2*)((LAS unsigned char*)dynlds + D + (unsigned)(tm * 16 + fr) * SPITCH + (tn * 16 + fq * 4) * 2) = w;
}
__device__ __forceinline__ void st_tr(unsigned DT, const f32x4& v, int tm, int tn, int fr, int fq, bool diag) {
    const int m = tm * 16 + fr;
    const int n0 = tn * 16 + fq * 4;
    float d[4];
#pragma unroll
    for (int e = 0; e < 4; ++e) d[e] = diag ? __uint_as_float(0x3f800000u & (unsigned)((((n0 + e) ^ m) - 1) >> 31)) : 0.f;
    const unsigned w0 = pk2(v[0] + d[0], v[1] + d[1]);
    const unsigned w1 = pk2(v[2] + d[2], v[3] + d[3]);
    LAS bf16_t* base = (LAS bf16_t*)((LAS unsigned char*)dynlds + DT) + (unsigned)(tn * 16 + fq * 4) * (SPITCH / 2) + m;
    base[0] = (bf16_t)(w0 & 0xffffu); base[SPITCH / 2] = (bf16_t)(w0 >> 16); base[SPITCH] = (bf16_t)(w1 & 0xffffu); base[3 * (SPITCH / 2)] = (bf16_t)(w1 >> 16);
}
__device__ __forceinline__ f32x4 ld_rows(unsigned D, int tm, int tn, int fr, int fq) {
    const u32x2 w = *(const LAS u32x2*)((LAS unsigned char*)dynlds + D + (unsigned)(tm * 16 + fr) * SPITCH + (tn * 16 + fq * 4) * 2);
    return (f32x4){bflo(w.x), bfhi(w.x), bflo(w.y), bfhi(w.y)};
}

template <bool REV>
__device__ __forceinline__ void scan_unit(const Params& p, int b, int h) {
    const int tid = opaque_tid(), wave = tid >> 6, lane = tid & 63, fr = lane & 15, fq = lane >> 4, tm = wave >> 1, tn0 = (wave & 1) * 2;
    constexpr unsigned O_SB = 0 * SLOT, O_VT = 1 * SLOT, O_BHT = 2 * SLOT, O_KHT = 3 * SLOT, O_RT = 4 * SLOT, O_MBRT = 5 * SLOT, O_MKRT = 6 * SLOT, O_MKA = 7 * SLOT,
                       O_ATT = 8 * SLOT, O_AT = 9 * SLOT, O_BT = 10 * SLOT, O_KT = 11 * SLOT, O_NA = 12 * SLOT, O_LA = 13 * SLOT, O_NB = 14 * SLOT, O_LB = 15 * SLOT,
                       O_PA = O_AT, O_PB = O_BT, O_U = O_KT, O_M1 = O_KT, O_M2 = 16 * SLOT, O_X2T = O_NA, O_X1T = O_LA, O_CUM = O_NA  ;
    LAS unsigned char* L8 = (LAS unsigned char*)dynlds;
    LAS float* cum = (LAS float*)(L8 + O_CUM); LAS float* btot = (LAS float*)(L8 + O_M2);
    const bf16_t* omd = p.LO + (size_t)(REV ? 1 : 0) * T_ * DR_;
    const bf16_t* asg = p.LO + (size_t)(REV ? 3 : 2) * T_ * DR_;
    bf16_t* yout = p.H + (size_t)(REV ? 1 : 0) * T_ * DR_;
    f32x4 Sf[2];
    Sf[0] = (f32x4){0.f, 0.f, 0.f, 0.f}; Sf[1] = Sf[0];
    __syncthreads();
    st_rows(O_SB, Sf[0], tm, tn0, fr, fq); st_rows(O_SB, Sf[1], tm, tn0 + 1, fr, fq);
    const int pj = tid & 63, ptg = tid >> 6;
    const int ptl = tid >> 3, pcg = tid & 7;
    const float ka1 = p.k_a[h * 64 + pj];
    float ka8[8];
#pragma unroll
    for (int e = 0; e < 8; ++e) ka8[e] = p.k_a[h * 64 + pcg * 8 + e];
    unsigned r_om[8], r_kk[8], r_as[8], r_k[8], r_v[8];
    uint4 q_kk, q_as, q_om, q_k, q_r;
    auto load_chunk = [&](int c) {
#pragma unroll
        for (int e = 0; e < 8; ++e) {
            const int u = c * 64 + ptg * 8 + e; const int t = REV ? (SEQ_ - 1 - u) : u;
            const size_t tb = (size_t)(b * SEQ_ + t) * DR_ + h * 64 + pj;
            r_om[e] = omd[tb]; r_kk[e] = p.kkb[tb]; r_as[e] = asg[tb]; r_k[e] = p.kb[tb]; r_v[e] = p.vb[tb];
        }
        const int u2 = c * 64 + ptl; const int t2 = REV ? (SEQ_ - 1 - u2) : u2;
        const size_t base = (size_t)(b * SEQ_ + t2) * DR_ + h * 64 + pcg * 8;
        q_kk = *(const uint4*)(p.kkb + base); q_as = *(const uint4*)(asg + base); q_om = *(const uint4*)(omd + base);
        q_k = *(const uint4*)(p.kb + base); q_r = *(const uint4*)(p.rb + base);
    };
    load_chunk(0);
#pragma unroll 1
    for (int c = 0; c < SEQ_ / 64; ++c) {
        float cp[8];
        cp[0] = 1.0f - bflo(r_om[0]);
#pragma unroll
        for (int e = 1; e < 8; ++e) cp[e] = cp[e - 1] * (1.0f - bflo(r_om[e]));
        btot[ptg * 64 + pj] = cp[7];
        __syncthreads();
        float pre = 1.f, tot = 1.f;
#pragma unroll
        for (int g = 0; g < 8; ++g) { const float v = btot[g * 64 + pj]; pre *= (g < ptg) ? v : 1.f; tot *= v; }
        {
            float o0[8], o1[8], o2[8], o3[8];
#pragma unroll
            for (int e = 0; e < 8; ++e) {
                const float W = pre * cp[e], wm = (e == 0) ? pre : pre * cp[e > 0 ? e - 1 : 0];
                cum[(ptg * 8 + e) * 64 + pj] = W;
                const float kkv = bflo(r_kk[e]), av = bflo(r_as[e]), kv = bflo(r_k[e]), vv = bflo(r_v[e]);
                const float rat = tot * __builtin_amdgcn_rcpf(W);
                o0[e] = -kkv * wm; o1[e] = kkv * av * rat; o2[e] = kv * (1.0f + (av - 1.0f) * ka1) * rat; o3[e] = vv;
            }
            const unsigned ro = (unsigned)pj * SPITCH + ptg * 16;
            *(LAS u32x4*)(L8 + O_ATT + ro) = pack8v(o0); *(LAS u32x4*)(L8 + O_BHT + ro) = pack8v(o1); *(LAS u32x4*)(L8 + O_KHT + ro) = pack8v(o2); *(LAS u32x4*)(L8 + O_VT + ro) = pack8v(o3);
        }
        __syncthreads();
        float wl[2][4];
        {
            float kk[8], av[8], om[8], kv[8], rv[8];
            unpack8(q_kk, kk); unpack8(q_as, av); unpack8(q_om, om); unpack8(q_k, kv); unpack8(q_r, rv);
            const f32x4 c0 = *(const LAS f32x4*)(cum + ptl * 64 + pcg * 8), c1 = *(const LAS f32x4*)(cum + ptl * 64 + pcg * 8 + 4);
            const int pl = ptl > 0 ? ptl - 1 : 0;
            f32x4 d0 = *(const LAS f32x4*)(cum + pl * 64 + pcg * 8), d1 = *(const LAS f32x4*)(cum + pl * 64 + pcg * 8 + 4);
            if (ptl == 0) { d0 = (f32x4){1.f, 1.f, 1.f, 1.f}; d1 = d0; }
            const float cu[8] = {c0.x, c0.y, c0.z, c0.w, c1.x, c1.y, c1.z, c1.w}, cm[8] = {d0.x, d0.y, d0.z, d0.w, d1.x, d1.y, d1.z, d1.w};
            float o0[8], o1[8], o2[8], o3[8];
#pragma unroll
            for (int e = 0; e < 8; ++e) {
                const float wm = cm[e], iw = __builtin_amdgcn_rcpf(cu[e]);
                o0[e] = -kk[e] * wm; o1[e] = kk[e] * av[e] * iw; o2[e] = kv[e] * (1.0f + (av[e] - 1.0f) * ka8[e]) * iw;
                o3[e] = rv[e] * (REV ? wm : cu[e]);
            }
            const unsigned ro = (unsigned)ptl * SPITCH + pcg * 16;
            *(LAS u32x4*)(L8 + O_AT + ro) = pack8v(o0); *(LAS u32x4*)(L8 + O_BT + ro) = pack8v(o1); *(LAS u32x4*)(L8 + O_KT + ro) = pack8v(o2); *(LAS u32x4*)(L8 + O_RT + ro) = pack8v(o3);
#pragma unroll
            for (int q = 0; q < 2; ++q) {
                const f32x4 cw = *(const LAS f32x4*)(cum + 63 * 64 + (tn0 + q) * 16 + fq * 4);
                wl[q][0] = cw.x; wl[q][1] = cw.y; wl[q][2] = cw.z; wl[q][3] = cw.w;
            }
        }
        if (c + 1 < SEQ_ / 64) load_chunk(c + 1);
        __builtin_amdgcn_sched_barrier(0);
        __syncthreads();
        {
            f32x4 a0[2] = {{0.f, 0.f, 0.f, 0.f}, {0.f, 0.f, 0.f, 0.f}}, a1[2] = {a0[0], a0[0]}, a2[2] = {a0[0], a0[0]}, a3[2] = {a0[0], a0[0]};
            mm_acc<true>(a0, O_BT, O_AT, tm, tn0, fr, fq); mm_acc<true>(a1, O_KT, O_AT, tm, tn0, fr, fq);
            mm_acc<true>(a2, O_RT, O_BT, tm, tn0, fr, fq); mm_acc<true>(a3, O_RT, O_KT, tm, tn0, fr, fq);
            const int m = tm * 16 + fr;
            f32x4 dd[2], m1[2], m2[2];
#pragma unroll
            for (int q = 0; q < 2; ++q) {
#pragma unroll
                for (int e = 0; e < 4; ++e) {
                    const int n = (tn0 + q) * 16 + fq * 4 + e;
                    const unsigned up = (unsigned)((m - n) >> 31), lo = (unsigned)((REV ? (n - m) : (n - m - 1)) >> 31);
                    const unsigned s16 = (unsigned)((((n ^ m) >> 4) - 1) >> 31), s32 = (unsigned)((((n ^ m) >> 5) - 1) >> 31);
                    const unsigned v0 = __float_as_uint(a0[q][e]) & up;
                    dd[q][e] = __uint_as_float(v0 & s16); m1[q][e] = __uint_as_float(v0 & s32 & ~s16); m2[q][e] = __uint_as_float(v0 & ~s32);
                    a1[q][e] = __uint_as_float(__float_as_uint(a1[q][e]) & up); a2[q][e] = __uint_as_float(__float_as_uint(a2[q][e]) & lo); a3[q][e] = __uint_as_float(__float_as_uint(a3[q][e]) & lo);
                }
            }
            const int dq = tm - tn0;
            const bool own = (dq == 0) || (dq == 1);
            f32x4 e1 = {0.f, 0.f, 0.f, 0.f};
            if (own) {
#pragma unroll
                for (int ks = 0; ks < 2; ++ks) {
                    const bf16x8 xa = lds16(O_BT + (unsigned)(tm * 16 + fr) * SPITCH + ks * 64 + fq * 16), yb = lds16(O_AT + (unsigned)(tm * 16 + fr) * SPITCH + ks * 64 + fq * 16);
                    e1 = __builtin_amdgcn_mfma_f32_16x16x32_bf16(xa, yb, e1, 0, 0, 0);
                }
            }
            __syncthreads();
            f32x4 qi = {0.f, 0.f, 0.f, 0.f}, qti = qi;
            if (own) {
                f32x4 E, ET = dq ? dd[1] : dd[0], Q, QT;
#pragma unroll
                for (int e = 0; e < 4; ++e) {
                    const int cc = fq * 4 + e;
                    E[e] = __uint_as_float(__float_as_uint(e1[e]) & (unsigned)((cc - fr) >> 31));
                    const float idn = __uint_as_float(0x3f800000u & (unsigned)(((cc ^ fr) - 1) >> 31));
                    Q[e] = E[e] + idn; QT[e] = ET[e] + idn;
                }
#define PK4S(v) __builtin_bit_cast(s16x4, (u32x2){pk2((v)[0], (v)[1]), pk2((v)[2], (v)[3])})
#define MM16(Xb, Yb, C) __builtin_amdgcn_mfma_f32_16x16x16bf16_1k(Yb, Xb, C, 0, 0, 0)
#pragma unroll
                for (int lv = 0; lv < 3; ++lv) {
                    const s16x4 Eb = PK4S(E), ETb = PK4S(ET), Qb = PK4S(Q);
                    const f32x4 zz = {0.f, 0.f, 0.f, 0.f};
                    const f32x4 E2 = MM16(Eb, ETb, zz), ET2 = MM16(ETb, Eb, zz);
                    const s16x4 ET2b = PK4S(ET2);
                    Q = MM16(Qb, ET2b, Q);
                    QT = MM16(ET2b, Qb, QT);
                    E = E2; ET = ET2;
                }
#undef MM16
#undef PK4S
                qi = Q; qti = QT;
            }
#pragma unroll
            for (int q = 0; q < 2; ++q) {
                const bool dg = own && (q == dq);
                const f32x4 zz = {0.f, 0.f, 0.f, 0.f};
                st_rows(O_PB, dg ? qi : zz, tm, tn0 + q, fr, fq); st_rows(O_LA, dg ? qti : zz, tm, tn0 + q, fr, fq);
                st_tr(O_M1, m1[q], tm, tn0 + q, fr, fq, false); st_tr(O_M2, m2[q], tm, tn0 + q, fr, fq, false);
                st_rows(O_MKA, a1[q], tm, tn0 + q, fr, fq); st_rows(O_MBRT, a2[q], tm, tn0 + q, fr, fq); st_rows(O_MKRT, a3[q], tm, tn0 + q, fr, fq);
            }
        }
        __syncthreads();
        {
            constexpr unsigned O_DINV = O_PB, O_DINVT = O_LA, O_Z1T = O_NA, O_Z2P = O_NB, O_G1 = O_LB, O_WT = O_LA, O_P = O_PA;
            { f32x4 z[2] = {{0.f, 0.f, 0.f, 0.f}, {0.f, 0.f, 0.f, 0.f}}, y[2] = {z[0], z[0]};
              mm_acc<true>(z, O_M1, O_DINVT, tm, tn0, fr, fq); mm_acc<true>(y, O_M2, O_DINVT, tm, tn0, fr, fq);
#pragma unroll
              for (int q = 0; q < 2; ++q) { st_tr(O_Z1T, z[q], tm, tn0 + q, fr, fq, false); st_rows(O_Z2P, y[q], tm, tn0 + q, fr, fq); } }
            __syncthreads();
            { f32x4 g[2], w[2];
              g[0] = ld_rows(O_DINV, tm, tn0, fr, fq); g[1] = ld_rows(O_DINV, tm, tn0 + 1, fr, fq); mm_acc<true>(g, O_DINV, O_Z1T, tm, tn0, fr, fq);
              w[0] = ld_rows(O_Z2P, tm, tn0, fr, fq); w[1] = ld_rows(O_Z2P, tm, tn0 + 1, fr, fq); mm_acc<true>(w, O_Z2P, O_Z1T, tm, tn0, fr, fq);
#pragma unroll
              for (int q = 0; q < 2; ++q) { st_rows(O_G1, g[q], tm, tn0 + q, fr, fq); st_tr(O_WT, w[q], tm, tn0 + q, fr, fq, false); } }
            __syncthreads();
            { f32x4 g[2]; g[0] = ld_rows(O_G1, tm, tn0, fr, fq); g[1] = ld_rows(O_G1, tm, tn0 + 1, fr, fq); mm_acc<true>(g, O_G1, O_WT, tm, tn0, fr, fq);
              st_rows(O_P, g[0], tm, tn0, fr, fq); st_rows(O_P, g[1], tm, tn0 + 1, fr, fq); }
            __syncthreads();
            f32x4 x2[2] = {{0.f, 0.f, 0.f, 0.f}, {0.f, 0.f, 0.f, 0.f}}, x1[2] = {x2[0], x2[0]};
            mm_acc<true>(x2, O_P, O_ATT, tm, tn0, fr, fq); mm_acc<true>(x1, O_P, O_MKA, tm, tn0, fr, fq);
#pragma unroll
            for (int q = 0; q < 2; ++q) { st_rows(O_X2T, x2[q], tm, tn0 + q, fr, fq); st_rows(O_X1T, x1[q], tm, tn0 + q, fr, fq); }
        }
        __syncthreads();
        f32x4 yv[2] = {{0.f, 0.f, 0.f, 0.f}, {0.f, 0.f, 0.f, 0.f}};
        {
            f32x4 uu[2] = {{0.f, 0.f, 0.f, 0.f}, {0.f, 0.f, 0.f, 0.f}};
            mm_acc<true>(uu, O_SB, O_X2T, tm, tn0, fr, fq); mm_acc<true>(uu, O_VT, O_X1T, tm, tn0, fr, fq);
            st_rows(O_U, uu[0], tm, tn0, fr, fq); st_rows(O_U, uu[1], tm, tn0 + 1, fr, fq);
            mm_acc<false>(yv, O_SB, O_RT, tm, tn0, fr, fq); mm_acc<false>(yv, O_VT, O_MKRT, tm, tn0, fr, fq);
        }
        __syncthreads();
        {
#pragma unroll
            for (int q = 0; q < 2; ++q)
#pragma unroll
                for (int e = 0; e < 4; ++e) Sf[q][e] *= wl[q][e];
            mm_acc<true>(Sf, O_U, O_BHT, tm, tn0, fr, fq); mm_acc<true>(Sf, O_VT, O_KHT, tm, tn0, fr, fq);
            st_rows(O_SB, Sf[0], tm, tn0, fr, fq); st_rows(O_SB, Sf[1], tm, tn0 + 1, fr, fq);
            mm_acc<false>(yv, O_U, O_MBRT, tm, tn0, fr, fq);
#pragma unroll
            for (int q = 0; q < 2; ++q) {
                const int u = c * 64 + (tn0 + q) * 16 + fr; const int t = REV ? (SEQ_ - 1 - u) : u;
                u32x2 w; w.x = pk2(yv[q][0], yv[q][1]); w.y = pk2(yv[q][2], yv[q][3]);
                *(u32x2*)(yout + (size_t)(b * SEQ_ + t) * DR_ + h * 64 + tm * 16 + fq * 4) = w;
            }
        }
    }
    __syncthreads();
}

constexpr int NA_KP = 144, NA_P_OFF = 576 * NA_KP  , NA_BIAS_OFF = NA_P_OFF + 8 * 8448  ;
__device__ __forceinline__ void na_unit(const Params& p, int bu) {
    const int tid = opaque_tid(), wave = tid >> 6, lane = tid & 63, fr = lane & 15, fq = lane >> 4;
    const int b = bu >> 9, h = (bu >> 5) & 15, ip = bu & 31;
    LAS unsigned char* L8 = (LAS unsigned char*)dynlds;
    LAS float* rbias = (LAS float*)(L8 + NA_BIAS_OFF);
    LAS bf16_t* Pb = (LAS bf16_t*)(L8 + NA_P_OFF) + wave * (16 * 264);
    const int i0 = ip * 2, rs0 = min(max(i0 - 4, 0), 56);
    const bf16_t* qh = p.QN + (size_t)(b * 16 + h) * SEQ_ * 64; const bf16_t* kh = p.KN + (size_t)(b * 16 + h) * SEQ_ * 64; const bf16_t* vh = p.VT + (size_t)(b * 16 + h) * SEQ_ * 64;
    uint4 vreg[9];
#pragma unroll
    for (int j = 0; j < 9; ++j) {
        const int c = tid + j * NTHREADS;
        const int krow = min(rs0 + (c >> 9), 63), tok = krow * 64 + ((c >> 3) & 63), pc = c & 7;
        const uint4 kv = *(const uint4*)(kh + (size_t)tok * 64 + pc * 8);
        *(LAS u32x4*)(L8 + (unsigned)((c >> 3) * NA_KP + pc * 16)) = (u32x4){kv.x, kv.y, kv.z, kv.w};
        const int vrow = min(rs0 + (c >> 9), 63);
        vreg[j] = *(const uint4*)(vh + ((size_t)(vrow * 8 + ((c >> 6) & 7)) * 64 + (c & 63)) * 8);
    }
    for (int i = tid; i < 465; i += NTHREADS) rbias[i] = p.rel_bias[h * 465 + i];
    __syncthreads();
    const int i = i0 + (wave >> 2), cb = wave & 3;
    const int rs = min(max(i - 4, 0), 56), kc0 = min(max(cb * 16 - 8, 0), 32), lrow = rs - rs0;
    const bf16x8 aq0 = *(const bf16x8*)(qh + (size_t)(i * 64 + cb * 16 + fr) * 64 + fq * 8), aq1 = *(const bf16x8*)(qh + (size_t)(i * 64 + cb * 16 + fr) * 64 + 32 + fq * 8);
    float s[8][2][4];
#pragma unroll
    for (int kr = 0; kr < 8; ++kr)
#pragma unroll
        for (int hh = 0; hh < 2; ++hh) {
            const unsigned ko = (unsigned)(((lrow + kr) * 64 + kc0 + hh * 16 + fr) * NA_KP + fq * 16);
            const bf16x8 bk0 = *(const LAS bf16x8*)(L8 + ko), bk1 = *(const LAS bf16x8*)(L8 + ko + 64);
            f32x4 acc = (f32x4){0.f, 0.f, 0.f, 0.f};
            acc = __builtin_amdgcn_mfma_f32_16x16x32_bf16(aq0, bk0, acc, 0, 0, 0);
            acc = __builtin_amdgcn_mfma_f32_16x16x32_bf16(aq1, bk1, acc, 0, 0, 0);
            const int kc = kc0 + hh * 16 + fr;
#pragma unroll
            for (int jj = 0; jj < 4; ++jj) {
                const int qc = cb * 16 + fq * 4 + jj, wc0 = min(max(qc - 8, 0), 48);
                const unsigned vm = (unsigned)(((wc0 - kc - 1) >> 31) & ((kc - wc0 - 16) >> 31));
                const int bi = (rs + kr - i + 7) * 31 + min(max(kc - qc + 15, 0), 30);
                const float sv = acc[jj] + rbias[bi];
                s[kr][hh][jj] = __uint_as_float((__float_as_uint(sv) & vm) | (0xff800000u & ~vm));
            }
        }
    float mx[4], sm[4];
#pragma unroll
    for (int jj = 0; jj < 4; ++jj) {
        float m = -INFINITY;
#pragma unroll
        for (int kr = 0; kr < 8; ++kr) m = fmaxf(m, fmaxf(s[kr][0][jj], s[kr][1][jj]));
        mx[jj] = red16_max(m);
        float t = 0.f;
#pragma unroll
        for (int kr = 0; kr < 8; ++kr)
#pragma unroll
            for (int hh = 0; hh < 2; ++hh) { const float e = __expf(s[kr][hh][jj] - mx[jj]); s[kr][hh][jj] = e; t += e; }
        sm[jj] = red16_sum(t);
    }
#pragma unroll
    for (int kr = 0; kr < 8; ++kr)
#pragma unroll
        for (int hh = 0; hh < 2; ++hh)
#pragma unroll
            for (int jj = 0; jj < 4; jj += 2) {
                const unsigned w = pk2(s[kr][hh][jj], s[kr][hh][jj + 1]);
                Pb[(fq * 4 + jj) * 264 + kr * 32 + hh * 16 + fr] = (bf16_t)(w & 0xffffu);
                Pb[(fq * 4 + jj + 1) * 264 + kr * 32 + hh * 16 + fr] = (bf16_t)(w >> 16);
            }
    __syncthreads();
#pragma unroll
    for (int j = 0; j < 9; ++j) { const int c = tid + j * NTHREADS; *(LAS u32x4*)(L8 + (unsigned)c * 16) = (u32x4){vreg[j].x, vreg[j].y, vreg[j].z, vreg[j].w}; }
    __syncthreads();
    f32x4 o[4];
#pragma unroll
    for (int dt = 0; dt < 4; ++dt) o[dt] = (f32x4){0.f, 0.f, 0.f, 0.f};
#pragma unroll
    for (int kr = 0; kr < 8; ++kr) {
        const bf16x8 ap = *(const LAS bf16x8*)(Pb + fr * 264 + kr * 32 + fq * 8);
#pragma unroll
        for (int dt = 0; dt < 4; ++dt) {
            const bf16x8 bv = *(const LAS bf16x8*)(L8 + (unsigned)((((lrow + kr) * 8 + (kc0 >> 3) + fq) * 64 + dt * 16 + fr) * 16));
            o[dt] = __builtin_amdgcn_mfma_f32_16x16x32_bf16(ap, bv, o[dt], 0, 0, 0);
        }
    }
#pragma unroll
    for (int jj = 0; jj < 4; ++jj) {
        const float inv = 1.0f / sm[jj];
        bf16_t* orow = p.ycat + ((size_t)b * SEQ_ + i * 64 + cb * 16 + fq * 4 + jj) * D_ + DR_ + h * 64 + fr;
#pragma unroll
        for (int dt = 0; dt < 4; ++dt) orow[dt * 16] = (bf16_t)(pk2(o[dt][jj] * inv, 0.f) & 0xffffu);
    }
    __syncthreads();
}

constexpr int Q_PREP = T_ / 64;
__device__ __forceinline__ void phase_mix(const Params& p) {
    const int G = gridDim.x, bid = blockIdx.x;
    const bool split = (G % 16) == 0;
    if (!split || ((bid >> 3) & 1) == 0) {
        const int sidx = split ? ((bid >> 4) * 8 + (bid & 7)) : bid, nscan = split ? G / 2 : G;
        for (int u = sidx; u < 128; u += nscan) {
            const int b = u >> 5, h = (u >> 1) & 15;
            if (u & 1) scan_unit<true>(p, b, h); else scan_unit<false>(p, b, h);
        }
    }
    const int tid = opaque_tid(), wave = tid >> 6, lane = tid & 63;
    int* qslot = (int*)(dynlds + CTRL_OFF + 512);
    float* scr = (float*)dynlds + wave * 2176;
    __syncthreads();
    if (tid == 0) *qslot = (int)atomicAdd(p.qctr, 1u);
    __syncthreads();
    int it = __builtin_amdgcn_readfirstlane(*qslot);
    bool na_ready = false;
    const int npre = conv_prefilled(G);
    const int C = CVT_ITEMS - npre, n_alt = C < 2048 ? C : 2048, c_lead = C - n_alt;
    const int Q_GL = Q_PREP + 256, Q_LEAD = Q_GL + c_lead, Q_ALT = Q_LEAD + 2 * n_alt, Q_TOTAL = Q_ALT + (2048 - n_alt);
    while (it < Q_TOTAL) {
        __syncthreads();
        unsigned nxt = 0u;
        if (tid == 0) nxt = atomicAdd(p.qctr, 1u);
        int kind, idx;
        if (it < Q_PREP) { kind = 0; idx = it; }
        else if (it < Q_GL) { kind = 3; idx = it - Q_PREP; }
        else if (it < Q_LEAD) { kind = 1; idx = it - Q_GL; }
        else if (it < Q_ALT) { const int k2 = it - Q_LEAD; kind = 1 + (k2 & 1); idx = (k2 & 1) ? (k2 >> 1) : c_lead + (k2 >> 1); }
        else { kind = 2; idx = n_alt + (it - Q_ALT); }
        if (kind == 0) {
            prep_na_tile(p, idx * 64);
            asm volatile("s_waitcnt vmcnt(0)" ::: "memory");
            __syncthreads();
            if (tid == 0) { __builtin_amdgcn_fence(__ATOMIC_RELEASE, "agent"); asm volatile("s_waitcnt vmcnt(0)" ::: "memory"); (void)xb_add(p.qctr + 32, 1u); }
        } else if (kind == 1) {
            const int wt = (idx + npre) * 32 + __builtin_amdgcn_readfirstlane(wave) * 4;
            float tv0[32], tv1[32];
            cvt_expert_load(p, wt, tv0, lane); cvt_expert_load(p, wt + 1, tv1, lane);
            cvt_expert_finish(p, wt, tv0, scr, lane); cvt_expert_load(p, wt + 2, tv0, lane);
            cvt_expert_finish(p, wt + 1, tv1, scr, lane); cvt_expert_load(p, wt + 3, tv1, lane);
            cvt_expert_finish(p, wt + 2, tv0, scr, lane); cvt_expert_finish(p, wt + 3, tv1, scr, lane);
        } else if (kind == 3) {
            const int j = idx, pm = j >> 2, pn = 16 + (j & 3);
            unsigned aoff[4]; dense_aoff(aoff, pm * 256, 512 * 2);
            EpiLora epi{p.LO, p.lbias, pm * 256, pn * 256};
            gemm_unit<false>((const char*)p.Alora + 4 * BK * 2, aoff, (const char*)(p.Wlora + (size_t)pn * 256 * 512) + 4 * BK * 2, 512 * 2, epi, 4);
        } else {
            if (!na_ready) {
                if (tid == 0) {
                    unsigned sp = 0u;
                    while (xb_ld(p.qctr + 32) < (unsigned)Q_PREP) { __builtin_amdgcn_s_sleep(2); if (++sp > (1u << 22)) break; }
                    __builtin_amdgcn_fence(__ATOMIC_ACQUIRE, "agent");
                    asm volatile("s_waitcnt vmcnt(0)" ::: "memory");
                }
                __syncthreads();
                na_ready = true;
            }
            na_unit(p, idx);
        }
        if (tid == 0) *qslot = (int)nxt;
        __syncthreads();
        it = __builtin_amdgcn_readfirstlane(*qslot);
    }
    __syncthreads();
}

__device__ __forceinline__ void phase_combine(const Params& p) {
    const bf16_t* yf = p.H; const bf16_t* yb = p.H + (size_t)T_ * DR_;
    const bf16_t* af = p.LO + (size_t)2 * T_ * DR_; const bf16_t* gg = p.LO + (size_t)4 * T_ * DR_;
    for (int it = blockIdx.x * NTHREADS + threadIdx.x; it < T_ * 128; it += gridDim.x * NTHREADS) {
        const int t = it >> 7, ch = (it & 127) * 8, h = ch >> 6;
        const size_t o = (size_t)t * DR_ + ch;
        float a[8], b[8], r[8], k[8], av[8], v[8], g[8], y[8];
        unpack8(*(const uint4*)(yf + o), a); unpack8(*(const uint4*)(yb + o), b);
        unpack8(*(const uint4*)(p.rb + o), r); unpack8(*(const uint4*)(p.kb + o), k); unpack8(*(const uint4*)(af + o), av);
        unpack8(*(const uint4*)(p.vb + o), v); unpack8(*(const uint4*)(gg + o), g);
        float s1 = 0.f, bs = 0.f;
#pragma unroll
        for (int j = 0; j < 8; ++j) {
            y[j] = a[j] + b[j]; s1 += y[j];
            const float kf = k[j] * (1.0f + (av[j] - 1.0f) * p.k_a[ch + j]);
            bs += r[j] * kf * p.r_k[ch + j];
        }
        s1 = red8_sum(s1); bs = red8_sum(bs);
        const float mu = s1 * (1.0f / 64.0f);
        float s2 = 0.f;
#pragma unroll
        for (int j = 0; j < 8; ++j) { const float d = y[j] - mu; s2 += d * d; }
        s2 = red8_sum(s2);
        const float rstd = rsqrtf(s2 * (1.0f / 64.0f) + 64e-5f);
        float outv[8];
#pragma unroll
        for (int j = 0; j < 8; ++j) outv[j] = ((y[j] - mu) * rstd * p.ln_w[ch + j] + p.ln_b[ch + j] + bs * v[j]) * g[j];
        (void)h;
        *(uint4*)(p.ycat + (size_t)t * D_ + ch) = pack8(outv);
    }
}

__device__ __forceinline__ unsigned long long route_row(float logit, float rbias, int lane, float* gwv) {
    const float score = sigmoidf_(logit);
    const float bsd = score + rbias;
    const float m1 = red8_max(bsd);
    const unsigned long long eq = __ballot(bsd == m1);
    const unsigned gm = (unsigned)(eq >> (lane & 56)) & 0xffu;
    const int first = __ffs(gm) - 1;
    const float ex = ((lane & 7) == first) ? -INFINITY : bsd;
    const float m2 = red8_max(ex);
    const float gs = m1 + m2;
    const int g = lane >> 3; int rank = 0;
#pragma unroll
    for (int gp = 0; gp < 8; ++gp) { const float o = __shfl(gs, gp * 8); rank += ((o > gs) || (o == gs && gp < g)) ? 1 : 0; }
    float cur = (rank < 4) ? bsd : -INFINITY;
    unsigned long long sel = 0ull;
#pragma unroll 1
    for (int itk = 0; itk < TOPK; ++itk) {
        const float mxv = wave_max(cur);
        const unsigned long long em = __ballot(cur == mxv);
        const int idx = __ffsll((long long)em) - 1;
        sel |= 1ull << idx;
        if (lane == idx) cur = -INFINITY;
    }
    const bool me = (sel >> lane) & 1ull;
    const float ssum = wave_sum(me ? score : 0.f);
    *gwv = score / ssum * 2.5f;
    return sel;
}

__device__ __forceinline__ void phase_norm2_router(const Params& p) {
    const int tid = opaque_tid(), wave = tid >> 6, lane = tid & 63, fr = lane & 15, fq = lane >> 4;
    constexpr int HP = 260;
    float* hsl = (float*)dynlds;
    float* lg = hsl + 64 * HP;
    const float rbias = p.router_bias[lane];
    const int rt = wave >> 1, eh = wave & 1;
    for (int u = blockIdx.x; u < T_ / 64; u += gridDim.x) {
        const int row0 = u * 64 + wave * 8, b = row0 >> 12;
        const float* modb = p.mod + b * 12288;
        float rstd[8];
#pragma unroll
        for (int r = 0; r < 8; ++r) {
            const float v = (lane < 32) ? p.ssq[(size_t)(row0 + r) * 32 + lane] : 0.f;
            rstd[r] = rsqrtf(wave_sum(v) * (1.0f / D_) + 1e-6f);
        }
        f32x4 lacc[2]; lacc[0] = (f32x4){0.f, 0.f, 0.f, 0.f}; lacc[1] = lacc[0];
        float* Bs = lg + 64 * 65;
        const int bk0 = tid >> 4, bq4 = (tid & 15) * 4, bdq = bq4 ^ ((bk0 & 3) * 16);
        f32x4 xq[8], bq[8]; float4 nwq, shq, scq;
#define P8_PREFETCH(slv) { const int kbp = (slv) * 256 + lane * 4; \
            nwq = *(const float4*)(p.norm2_w + kbp); shq = *(const float4*)(modb + 6144 + kbp); scq = *(const float4*)(modb + 8192 + kbp); \
            _Pragma("unroll") for (int r = 0; r < 8; ++r) xq[r] = *(const f32x4*)(p.out + (size_t)(row0 + r) * D_ + kbp); \
            _Pragma("unroll") for (int j = 0; j < 8; ++j) bq[j] = *(const f32x4*)(p.w_router + (size_t)((slv) * 256 + bk0 + j * 32) * NEXP + bq4); }
        P8_PREFETCH(0)
#pragma unroll 1
        for (int sl = 0; sl < 8; ++sl) {
            const int kb = sl * 256 + lane * 4;
            const float4 g4 = make_float4(nwq.x * (1.f + scq.x), nwq.y * (1.f + scq.y), nwq.z * (1.f + scq.z), nwq.w * (1.f + scq.w)), sh = shq;
            __syncthreads();
#pragma unroll
            for (int r = 0; r < 8; ++r) {
                const f32x4 xv = xq[r];
                float4 hv; hv.x = xv.x * rstd[r] * g4.x + sh.x; hv.y = xv.y * rstd[r] * g4.y + sh.y; hv.z = xv.z * rstd[r] * g4.z + sh.z; hv.w = xv.w * rstd[r] * g4.w + sh.w;
                *(unsigned*)(p.H8 + (size_t)(row0 + r) * D_ + kb) = pk4_fp8(hv.x, hv.y, hv.z, hv.w);
                *(float4*)(hsl + (wave * 8 + r) * HP + lane * 4) = hv;
            }
#pragma unroll
            for (int j = 0; j < 8; ++j) *(f32x4*)(Bs + (bk0 + j * 32) * NEXP + bdq) = bq[j];
            if (sl + 1 < 8) P8_PREFETCH(sl + 1)
            __syncthreads();
            const float* ap = hsl + (rt * 16 + fr) * HP + fq;
            const float* b0p = Bs + fq * NEXP + ((eh * 32 + fr) ^ (fq * 16));
            const float* b1p = Bs + fq * NEXP + ((eh * 32 + 16 + fr) ^ (fq * 16));
#pragma unroll 16
            for (int k4 = 0; k4 < 64; ++k4) {
                const float av = ap[k4 * 4];
                const float b0 = b0p[k4 * 4 * NEXP], b1 = b1p[k4 * 4 * NEXP];
                lacc[0] = __builtin_amdgcn_mfma_f32_16x16x4f32(av, b0, lacc[0], 0, 0, 0);
                lacc[1] = __builtin_amdgcn_mfma_f32_16x16x4f32(av, b1, lacc[1], 0, 0, 0);
            }
        }
#pragma unroll
        for (int nt = 0; nt < 2; ++nt)
#pragma unroll
            for (int jj = 0; jj < 4; ++jj) lg[(rt * 16 + fq * 4 + jj) * 65 + eh * 32 + nt * 16 + fr] = lacc[nt][jj];
        int* lcnt = (int*)(dynlds + CTRL_OFF + 64); int* lbase = lcnt + 64;
        __syncthreads();
        if (tid < 64) lcnt[tid] = 0;
        __syncthreads();
        unsigned long long selm[8]; int lrank[8]; float gwr[8];
#pragma unroll
        for (int r = 0; r < 8; ++r) {
            selm[r] = route_row(lg[(wave * 8 + r) * 65 + lane], rbias, lane, &gwr[r]);
            lrank[r] = 0;
            if ((selm[r] >> lane) & 1ull) lrank[r] = atomicAdd(lcnt + lane, 1);
        }
        __syncthreads();
        if (tid < 64) lbase[tid] = (int)atomicAdd(p.cnt + tid * 64, (unsigned)lcnt[tid]);
        __syncthreads();
        const int mybase = lbase[lane];
#pragma unroll
        for (int r = 0; r < 8; ++r) {
            if ((selm[r] >> lane) & 1ull) {
                const int kidx = __popcll(selm[r] & ((1ull << lane) - 1ull));
                const unsigned slot = (unsigned)(row0 + r) * NSLOT + kidx;
                p.list[(size_t)lane * LIST_CAP + mybase + lrank[r]] = slot;
                p.gw[(size_t)lane * LIST_CAP + mybase + lrank[r]] = gwr[r];
            }
        }
    }
}

__device__ __forceinline__ int build_tile_table(const Params& p, int* tstart) {
    __syncthreads();
    if (threadIdx.x == 0) {
        int s = 0;
        for (int e = 0; e < NEXP; ++e) { tstart[e] = s; s += ((int)p.cnt[e * 64] + 255) >> 8; }
        tstart[NEXP] = s;
    }
    __syncthreads();
    return tstart[NEXP];
}

__device__ __forceinline__ void phase_moe_up(const Params& p) {
    int* s_tstart = (int*)(dynlds + CTRL_OFF + 64);
    const int R = build_tile_table(p, s_tstart);
    const int nunits = (R + T_ / 256) * 4;
    const int tid = opaque_tid();
    int R0, C0, R1, C1; stage_rc(tid * 16, R0, C0); stage_rc(tid * 16 + 8192, R1, C1);
    int e = 0;
    for (int u = blockIdx.x; u < nunits; u += gridDim.x) {
        const int mt = u >> 2, nt = u & 3;
        unsigned aoff[4]; const fp8_t* Bt;
        if (mt < R) {
            while (s_tstart[e + 1] <= mt) ++e;
            const int r0 = (mt - s_tstart[e]) * 256, cnt = (int)p.cnt[e * 64];
            const unsigned* lst = p.list + (size_t)e * LIST_CAP;
            const int lr[4] = {R0, R1, 128 + R0, 128 + R1}; const int lc[4] = {C0, C1, C0, C1};
#pragma unroll
            for (int q = 0; q < 4; ++q) { const int rr = r0 + lr[q]; const unsigned v = lst[rr < LIST_CAP ? rr : LIST_CAP - 1]; const unsigned tok = rr < cnt ? v / NSLOT : 0u; aoff[q] = tok * D_ + lc[q] * 2; }
            Bt = p.We1q + (size_t)e * 1024 * D_ + (size_t)nt * 256 * D_;
        } else {
            dense_aoff(aoff, (mt - R) * 256, D_);
            Bt = p.Ws1q + (size_t)nt * 256 * D_;
        }
        EpiGateUp epi{p.actq, (size_t)mt * 256, nt * 128};
        gemm_unit<true>(p.H8, aoff, Bt, D_, epi);
    }
}

__device__ __forceinline__ void phase_moe_down(const Params& p) {
    int* s_tstart2 = (int*)(dynlds + CTRL_OFF + 64);
    const int R = build_tile_table(p, s_tstart2);
    const int nunits = (R + T_ / 256) * 8;
    int e = 0;
    bool staged = false;
    for (int u = blockIdx.x; u < nunits; u += gridDim.x) {
        const int mt = u >> 3, nt = u & 7;
        unsigned aoff[4]; dense_aoff(aoff, 0, EFF);
        if (mt < R) { while (s_tstart2[e + 1] <= mt) ++e; }
        const int un = u + gridDim.x, mtn = un >> 3, ntn = un & 7; const bool has_next = un < nunits;
        int en = e;
        if (has_next && mtn < R) { while (s_tstart2[en + 1] <= mtn) ++en; }
        const fp8_t* nA = p.actq + (size_t)mtn * 256 * EFF;
        const fp8_t* nB = (mtn < R) ? p.We2q + (size_t)en * D_ * EFF + (size_t)ntn * 256 * EFF : p.Ws2q + (size_t)ntn * 256 * EFF;
        const fp8_t* cA = p.actq + (size_t)mt * 256 * EFF;
        if (mt < R) {
            const int r0 = (mt - s_tstart2[e]) * 256;
            EpiDownRouted<true> epi{p.slot, p.list + (size_t)e * LIST_CAP, p.gw + (size_t)e * LIST_CAP, r0, (int)p.cnt[e * 64], nt * 256};
            gemm_unit_pre<true, 8>(cA, aoff, p.We2q + (size_t)e * D_ * EFF + (size_t)nt * 256 * EFF, EFF, epi, staged, has_next, nA, nB);
        } else {
            EpiDownRouted<false> epi{p.slot, nullptr, p.gw, (mt - R) * 256, T_, nt * 256};
            gemm_unit_pre<true, 8>(cA, aoff, p.Ws2q + (size_t)nt * 256 * EFF, EFF, epi, staged, has_next, nA, nB);
        }
        staged = has_next;
    }
}

__device__ __forceinline__ void phase_final(const Params& p) {
    for (int it = blockIdx.x * NTHREADS + opaque_tid(); it < T_ * (D_ / 8); it += gridDim.x * NTHREADS) {
        const int t = it >> 8, c = (it & 255) * 8;
        float acc[8];
#pragma unroll
        for (int j = 0; j < 8; ++j) acc[j] = 0.f;
#pragma unroll
        for (int k = 0; k < NSLOT; ++k) {
            const u32x2 w = *(const u32x2*)(p.slot + ((size_t)t * NSLOT + k) * D_ + c);
            const f32x2 a0 = __builtin_amdgcn_cvt_pk_f32_fp8(w.x, false), a1 = __builtin_amdgcn_cvt_pk_f32_fp8(w.x, true), a2 = __builtin_amdgcn_cvt_pk_f32_fp8(w.y, false), a3 = __builtin_amdgcn_cvt_pk_f32_fp8(w.y, true);
            acc[0] += a0.x; acc[1] += a0.y; acc[2] += a1.x; acc[3] += a1.y; acc[4] += a2.x; acc[5] += a2.y; acc[6] += a3.x; acc[7] += a3.y;
        }
#pragma unroll
        for (int j = 0; j < 8; ++j) acc[j] *= (1.0f / SLOT_SCALE);
        const float* gate = p.mod + (t >> 12) * 12288 + 10240 + c;
        const f32x4 g0 = *(const f32x4*)gate, g1 = *(const f32x4*)(gate + 4);
        float* op = p.out + (size_t)t * D_ + c;
        const f32x4 x0 = *(const f32x4*)op, x1 = *(const f32x4*)(op + 4);
        *(f32x4*)op = x0 + g0 * (f32x4){acc[0], acc[1], acc[2], acc[3]};
        *(f32x4*)(op + 4) = x1 + g1 * (f32x4){acc[4], acc[5], acc[6], acc[7]};
    }
}

constexpr int N_PHASES = 12;
__global__ void __launch_bounds__(NTHREADS, 2) fwd_kernel(Params p) {
    LAS unsigned* xbw = (LAS unsigned*)(dynlds + CTRL_OFF);
    if (threadIdx.x == 0) { xbw[0] = 0u; xbw[1] = 0u; xbw[2] = 0u; xbw[3] = 0u; }
    __syncthreads();
    const int lo = (int)p.ph_lo, hi = (int)p.ph_hi;
    const bool multi = (hi - lo) > 1;
    XcdBarrier bar; bar.bar = p.bar; bar.x = 0; bar.st = (volatile LAS unsigned*)xbw;
    if (multi) bar = xcd_barrier_post(p.bar, (volatile LAS unsigned*)xbw);
#ifdef ONLY_PHASE
#define PHASE(k, call) if ((k) == ONLY_PHASE) { if (lo <= (k) && (k) < hi) { call; if ((k) + 1 < hi) xcd_barrier(bar); } }
#else
#define PHASE(k, call) if (lo <= (k) && (k) < hi) { call; if (DUP_PHASE == (k)) { xcd_barrier(bar); call; } if ((k) + 1 < hi) xcd_barrier(bar); }
#endif
    PHASE(0, phase_prologue(p))
    PHASE(1, phase_norm1(p))
    PHASE(2, phase_gemm_in(p))
    PHASE(3, phase_prep(p))
    PHASE(4, phase_gemm_lora(p))
    PHASE(5, phase_mix(p))
    PHASE(6, phase_combine(p))
    PHASE(7, phase_gemm_out(p))
    PHASE(8, phase_norm2_router(p))
    PHASE(9, phase_moe_up(p))
    PHASE(10, phase_moe_down(p))
    PHASE(11, phase_final(p))
#undef PHASE
}

static inline size_t al256(size_t x) { return (x + 255) & ~(size_t)255; }

extern "C" void kernel_launch(void* const* d_in, const int* in_sizes, int n_in, void* d_out, int out_size, void* d_ws, size_t ws_size, hipStream_t stream) {
    static int grid = 0;
    size_t off = 0;
    const size_t o_bar = off;   off = al256(off + XCD_BAR_WORDS * 4);
    const size_t o_mod = off;   off = al256(off + (size_t)NB_ * 12288 * 4);
    const size_t o_cnt = off;   off = al256(off + NEXP * 256 + 256);
    const size_t o_lbias = off; off = al256(off + 4 * DR_ * 4);
    const size_t o_wlora = off; off = al256(off + (size_t)5120 * 512 * 2);
    const size_t zero_end = off;
    const size_t o_we1 = off;   off = al256(off + (size_t)NEXP * 1024 * D_ * 2);
    const size_t o_we2 = off;   off = al256(off + (size_t)NEXP * D_ * EFF * 2);
    const size_t o_ws1 = off;   off = al256(off + (size_t)1024 * D_ * 2);
    const size_t o_ws2 = off;   off = al256(off + (size_t)D_ * EFF * 2);
    const size_t o_h = off;     off = al256(off + (size_t)T_ * D_ * 2);
    const size_t o_ssq = off;   off = al256(off + (size_t)T_ * 32 * 4);
    const size_t arena = off;
    size_t m = arena;
    const size_t o_win = m;   m = al256(m + (size_t)NPROJ * D_ * 2);
    const size_t o_wout = m;  m = al256(m + (size_t)D_ * D_ * 2);
    const size_t o_proj = m;  m = al256(m + (size_t)T_ * NPROJ * 2);
    const size_t o_alora = m; m = al256(m + (size_t)T_ * 512 * 2);
    const size_t o_qn = m;    m = al256(m + (size_t)T_ * DR_ * 2);
    const size_t o_kn = m;    m = al256(m + (size_t)T_ * DR_ * 2);
    const size_t o_vt = m;    m = al256(m + (size_t)T_ * DR_ * 2);
    const size_t o_ycat = m;  m = al256(m + (size_t)T_ * D_ * 2);
    const size_t o_lo = m;    m = al256(m + (size_t)5 * T_ * DR_ * 2);
    size_t f = arena;
    const size_t o_slot = f;  f = al256(f + (size_t)T_ * NSLOT * D_ * 2);
    const size_t o_act = f;   f = al256(f + (size_t)(T_ * TOPK + NEXP * 256 + T_) * EFF * 2);
    const size_t o_list = f;  f = al256(f + (size_t)NEXP * LIST_CAP * 4);
    const size_t o_gw = f;    f = al256(f + (size_t)NEXP * LIST_CAP * 4);
    const size_t ws_need = m > f ? m : f;

    if (grid == 0) {
        if (n_in != 34 || out_size != T_ * D_ || ws_size < ws_need) { fprintf(stderr, "kernel_launch: unexpected problem (n_in %d, out %d, ws %zu, need %zu)\n", n_in, out_size, ws_size, ws_need); grid = -1; return; }
        int dev = 0, cus = 0;
        if (hipGetDevice(&dev) != hipSuccess || hipDeviceGetAttribute(&cus, hipDeviceAttributeMultiprocessorCount, dev) != hipSuccess) { grid = -1; return; }
        if (hipFuncSetAttribute((const void*)fwd_kernel, hipFuncAttributeMaxDynamicSharedMemorySize, DYN_LDS) != hipSuccess) { fprintf(stderr, "kernel_launch: hipFuncSetAttribute failed\n"); grid = -1; return; }
        int per_cu = 0;
        (void)hipOccupancyMaxActiveBlocksPerMultiprocessor(&per_cu, (const void*)fwd_kernel, NTHREADS, DYN_LDS);
        (void)hipGetLastError();
        if (per_cu < 1) fprintf(stderr, "kernel_launch: occupancy query reports %d blocks per CU\n", per_cu);
        grid = cus;
    }
    if (grid < 0) return;
    char* ws = (char*)d_ws;
    hipMemsetAsync(ws, 0, zero_end, stream);
    Params p{};
    const float* const* in = (const float* const*)d_in;
    p.x = in[0]; p.c = in[1]; p.w_ada = in[2]; p.b_ada = in[3]; p.norm1_w = in[4]; p.w_in = in[5]; p.rwkv_shift = in[6]; p.w0_f = in[7]; p.w_up_f = in[8];
    p.w0_b = in[9]; p.w_up_b = in[10]; p.a0_f = in[11]; p.a_up_f = in[12]; p.a0_b = in[13]; p.a_up_b = in[14]; p.g_up = in[15]; p.k_k = in[16]; p.k_a = in[17];
    p.r_k = in[18]; p.ln_w = in[19]; p.ln_b = in[20]; p.qn_w = in[21]; p.kn_w = in[22]; p.rel_bias = in[23]; p.w_out = in[24]; p.norm2_w = in[25];
    p.w_router = in[26]; p.router_bias = in[27]; p.w_gate_e = in[28]; p.w_up_e = in[29]; p.w_down_e = in[30]; p.w_gate_s = in[31]; p.w_up_s = in[32]; p.w_down_s = in[33];
    p.out = (float*)d_out;
    p.bar = (unsigned*)(ws + o_bar); p.mod = (float*)(ws + o_mod); p.cnt = (unsigned*)(ws + o_cnt); p.qctr = p.cnt + NEXP * 64; p.lbias = (float*)(ws + o_lbias);
    p.Wlora = (bf16_t*)(ws + o_wlora); p.We1q = (fp8_t*)(ws + o_we1); p.We2q = (fp8_t*)(ws + o_we2); p.Ws1q = (fp8_t*)(ws + o_ws1); p.Ws2q = (fp8_t*)(ws + o_ws2); p.H8 = (fp8_t*)(ws + o_h);
    p.H = (bf16_t*)(ws + o_h); p.Win = (bf16_t*)(ws + o_win); p.Wout = (bf16_t*)(ws + o_wout); p.proj = (bf16_t*)(ws + o_proj); p.LO = (bf16_t*)(ws + o_lo);
    p.Alora = (bf16_t*)(ws + o_alora); p.QN = (bf16_t*)(ws + o_qn); p.KN = (bf16_t*)(ws + o_kn); p.VT = (bf16_t*)(ws + o_vt); p.ycat = (bf16_t*)(ws + o_ycat);
    p.rb = (bf16_t*)d_out; p.kb = p.rb + (size_t)T_ * DR_; p.vb = p.kb + (size_t)T_ * DR_; p.kkb = p.vb + (size_t)T_ * DR_;
    p.slot = (fp8_t*)(ws + o_slot); p.actq = (fp8_t*)(ws + o_act); p.list = (unsigned*)(ws + o_list); p.gw = (float*)(ws + o_gw);
    p.ssq = (float*)(ws + o_ssq);
#if N_LAUNCH_SPLIT
    for (int k = 0; k < N_PHASES; ++k) {
        p.ph_lo = k; p.ph_hi = k + 1;
        hipLaunchKernelGGL(fwd_kernel, dim3(grid), dim3(NTHREADS), DYN_LDS, stream, p);
    }
#else
    p.ph_lo = 0; p.ph_hi = N_PHASES;
    hipLaunchKernelGGL(fwd_kernel, dim3(grid), dim3(NTHREADS), DYN_LDS, stream, p);
#endif
    (void)in_sizes;
}
```

```cpp
#include <hip/hip_runtime.h>
#include <stdint.h>
#include <stdio.h>

#ifndef DUP_PHASE
#define DUP_PHASE -1
#endif
#ifndef N_LAUNCH_SPLIT
#define N_LAUNCH_SPLIT 0
#endif

typedef unsigned short bf16_t;
typedef short bf16x8 __attribute__((ext_vector_type(8)));
typedef float f32x4 __attribute__((ext_vector_type(4)));
typedef unsigned u32x2 __attribute__((ext_vector_type(2)));
typedef int i32x4 __attribute__((ext_vector_type(4)));
typedef unsigned u32x4 __attribute__((ext_vector_type(4)));
typedef int i32x8 __attribute__((ext_vector_type(8)));
typedef unsigned char fp8_t;
typedef float f32x2 __attribute__((ext_vector_type(2)));
#define LAS __attribute__((address_space(3)))

constexpr int T_ = 16384, SEQ_ = 4096, NB_ = 4, D_ = 2048, DR_ = 1024;
constexpr int NPROJ = 6656;
constexpr int RWKV_IN_ = 3488;
constexpr int PC_R = 0, PC_K = 1024, PC_V = 2048, PC_L = 3072, PC_Q = 3584, PC_KN = 4608, PC_VN = 5632;
constexpr int NEXP = 64, TOPK = 6, EFF = 512, NSLOT = 7;
constexpr int LIST_CAP = 16384;
constexpr int NTHREADS = 512;
constexpr int GEMM_LDS = 131072;
constexpr int CTRL_OFF = 17 * 9216;
constexpr int DYN_LDS = CTRL_OFF + 1024;

#define XB_TMO      128
#define XB_XCNT(j)  (256  + 64 * (j))
#define XB_XSUB(j)  (1280 + 64 * (j))
#define XB_XGEN(j)  (2304 + 64 * (j))
#define XB_TOP      3328
#define XB_TOPGEN   3392
#define XCD_BAR_WORDS 3456
#define XB_SPIN_CAP (1u << 18)

__device__ __forceinline__ unsigned xb_ld(unsigned* p)              { return __hip_atomic_load(p, __ATOMIC_RELAXED, __HIP_MEMORY_SCOPE_AGENT); }
__device__ __forceinline__ unsigned xb_add(unsigned* p, unsigned v) { return __hip_atomic_fetch_add(p, v, __ATOMIC_RELAXED, __HIP_MEMORY_SCOPE_AGENT); }
__device__ __forceinline__ unsigned xb_xcc_id() { return (unsigned)__builtin_amdgcn_s_getreg((3 << 11) | 20) & 0xFu; }
#define XB_SPIN(cond, bar) do { unsigned _sp = 0; while (cond) { __builtin_amdgcn_s_sleep(1); \
    if ((++_sp & 255u) == 0u) { if (xb_ld(&(bar)[XB_TMO])) break; if (_sp > XB_SPIN_CAP) { atomicAdd(&(bar)[XB_TMO], 1u); break; } } } } while (0)

struct XcdBarrier { unsigned* bar; unsigned x; volatile LAS unsigned* st; };

__device__ __forceinline__ XcdBarrier xcd_barrier_post(unsigned* bar, volatile LAS unsigned* st) {
    XcdBarrier b; b.bar = bar; b.x = xb_xcc_id(); b.st = st;
    if (threadIdx.x == 0) (void)xb_add(&bar[XB_XCNT(b.x)], 1u);
    return b;
}
__device__ __forceinline__ void xcd_barrier_complete(unsigned* bar, unsigned x, unsigned& nloc, unsigned& nx) {
    const unsigned G = gridDim.x * gridDim.y * gridDim.z;
    unsigned sum, cnt, mine, sp = 0u;
    for (;;) {
        sum = 0u; cnt = 0u; mine = 0u;
#pragma unroll
        for (unsigned j = 0; j < 16; ++j) { const unsigned c = xb_ld(&bar[XB_XCNT(j)]); sum += c; cnt += (c > 0u) ? 1u : 0u; mine = (j == x) ? c : mine; }
        if (sum == G) break;
        __builtin_amdgcn_s_sleep(1);
        if ((++sp & 255u) == 0u) { if (xb_ld(&bar[XB_TMO])) break; if (sp > XB_SPIN_CAP) { atomicAdd(&bar[XB_TMO], 1u); break; } }
    }
    nloc = mine > 0u ? mine : 1u; nx = cnt > 0u ? cnt : 1u;
}
__device__ __forceinline__ void xcd_barrier(const XcdBarrier& b) {
    asm volatile("s_waitcnt vmcnt(0)" ::: "memory");
    __syncthreads();
    if (threadIdx.x == 0) {
        unsigned* bar = b.bar;
        __builtin_amdgcn_s_waitcnt(0);
        unsigned nloc = b.st[0], nx = b.st[1];
        if (nloc == 0u) { xcd_barrier_complete(bar, b.x, nloc, nx); b.st[0] = nloc; b.st[1] = nx; }
        const unsigned old = xb_add(&bar[XB_XSUB(b.x)], 1u);
        const unsigned gen = old / nloc;
        if (old + 1u == (gen + 1u) * nloc) {
            __builtin_amdgcn_fence(__ATOMIC_RELEASE, "agent");
            asm volatile("s_waitcnt vmcnt(0)" ::: "memory");
            const unsigned og = xb_add(&bar[XB_TOP], 1u);
            const unsigned tg = og / nx;
            if (og + 1u == (tg + 1u) * nx) xb_add(&bar[XB_TOPGEN], 1u);
            else XB_SPIN(xb_ld(&bar[XB_TOPGEN]) == tg, bar);
            __builtin_amdgcn_fence(__ATOMIC_ACQUIRE, "agent");
            xb_add(&bar[XB_XGEN(b.x)], 1u);
            asm volatile("s_waitcnt vmcnt(0)" ::: "memory");
        } else {
            XB_SPIN(xb_ld(&bar[XB_XGEN(b.x)]) == gen, bar);
            __builtin_amdgcn_fence(__ATOMIC_ACQUIRE, "agent");
            asm volatile("s_waitcnt vmcnt(0)" ::: "memory");
        }
    }
    __syncthreads();
}

struct Params {
    const float *x, *c, *w_ada, *b_ada, *norm1_w, *w_in, *rwkv_shift, *w0_f, *w_up_f, *w0_b, *w_up_b, *a0_f, *a_up_f, *a0_b, *a_up_b,
                *g_up, *k_k, *k_a, *r_k, *ln_w, *ln_b, *qn_w, *kn_w, *rel_bias, *w_out, *norm2_w, *w_router, *router_bias,
                *w_gate_e, *w_up_e, *w_down_e, *w_gate_s, *w_up_s, *w_down_s;
    float* out;
    unsigned* bar; float* mod; unsigned* cnt; float* lbias; unsigned* qctr;
    bf16_t *Wlora, *H, *Win, *Wout, *proj, *Alora, *QN, *KN, *VT, *ycat, *LO;
    fp8_t *We1q, *We2q, *Ws1q, *Ws2q, *H8, *actq;
    bf16_t *rb, *kb, *vb, *kkb;
    fp8_t *slot; unsigned* list; float* gw;
    float* ssq;
    long long ph_lo, ph_hi;
};

extern __shared__ __attribute__((aligned(16))) char dynlds[];

__device__ __forceinline__ int opaque_tid() { int t = threadIdx.x; asm volatile("" : "+v"(t)); return t; }
typedef __bf16 bf16x2_t __attribute__((ext_vector_type(2)));
__device__ __forceinline__ unsigned pk2(float lo, float hi) { bf16x2_t v = {(__bf16)lo, (__bf16)hi}; return __builtin_bit_cast(unsigned, v); }
__device__ __forceinline__ float bflo(unsigned u) { return __uint_as_float(u << 16); }
__device__ __forceinline__ float bfhi(unsigned u) { return __uint_as_float(u & 0xffff0000u); }
__device__ __forceinline__ void unpack8(const uint4& u, float (&f)[8]) {
    f[0] = bflo(u.x); f[1] = bfhi(u.x); f[2] = bflo(u.y); f[3] = bfhi(u.y); f[4] = bflo(u.z); f[5] = bfhi(u.z); f[6] = bflo(u.w); f[7] = bfhi(u.w);
}
__device__ __forceinline__ u32x4 pack8v(const float (&f)[8]) { u32x4 r; r.x = pk2(f[0], f[1]); r.y = pk2(f[2], f[3]); r.z = pk2(f[4], f[5]); r.w = pk2(f[6], f[7]); return r; }
__device__ __forceinline__ uint4 pack8(const float (&f)[8]) { uint4 r; r.x = pk2(f[0], f[1]); r.y = pk2(f[2], f[3]); r.z = pk2(f[4], f[5]); r.w = pk2(f[6], f[7]); return r; }
__device__ __forceinline__ float clamp448(float x) { return fminf(fmaxf(x, -448.0f), 448.0f); }
__device__ __forceinline__ unsigned pk4_fp8(float a, float b, float c, float d) {
    int w = 0;
    w = __builtin_amdgcn_cvt_pk_fp8_f32(clamp448(a), clamp448(b), w, false);
    w = __builtin_amdgcn_cvt_pk_fp8_f32(clamp448(c), clamp448(d), w, true);
    return (unsigned)w;
}
template <int CTRL> __device__ __forceinline__ float dppf(float x) { return __builtin_bit_cast(float, __builtin_amdgcn_mov_dpp(__builtin_bit_cast(int, x), CTRL, 0xf, 0xf, true)); }
__device__ __forceinline__ float red8_sum(float v)  { v += dppf<0xB1>(v); v += dppf<0x4E>(v); v += dppf<0x141>(v); return v; }
__device__ __forceinline__ float red16_sum(float v) { v += dppf<0xB1>(v); v += dppf<0x4E>(v); v += dppf<0x141>(v); v += dppf<0x128>(v); return v; }
__device__ __forceinline__ float red8_max(float v)  { v = fmaxf(v, dppf<0xB1>(v)); v = fmaxf(v, dppf<0x4E>(v)); v = fmaxf(v, dppf<0x141>(v)); return v; }
__device__ __forceinline__ float red16_max(float v) { v = fmaxf(v, dppf<0xB1>(v)); v = fmaxf(v, dppf<0x4E>(v)); v = fmaxf(v, dppf<0x141>(v)); v = fmaxf(v, dppf<0x128>(v)); return v; }
__device__ __forceinline__ float wave_sum(float v) {
#pragma unroll
    for (int o = 1; o < 64; o <<= 1) v += __shfl_xor(v, o);
    return v;
}
__device__ __forceinline__ float wave_max(float v) {
#pragma unroll
    for (int o = 1; o < 64; o <<= 1) v = fmaxf(v, __shfl_xor(v, o));
    return v;
}
__device__ __forceinline__ float sigmoidf_(float x) { return 1.0f / (1.0f + __expf(-x)); }

constexpr int BK = 64, HALF = 128, HTB = HALF * BK * 2;
__device__ __forceinline__ int lds_byte(int r, int c) {
    int st = (r >> 4) * 2 + (c >> 5), rr = r & 15, cc = c & 31, ob = rr * 64 + cc * 2;
    return st * 1024 + (ob ^ (((ob >> 9) & 1) << 5));
}
__device__ __forceinline__ void stage_rc(int b, int& R, int& C) {
    int st = b / 1024, sb = b % 1024, swz = sb ^ (((sb >> 9) & 1) << 5);
    R = (st >> 1) * 16 + swz / 64; C = (st & 1) * 32 + (swz % 64) / 2;
}

#define G_SA(b, h) (((b) * 4 + (h)) * HTB)
#define G_SB(b, h) (((b) * 4 + 2 + (h)) * HTB)
#define G_STAGE(bufoff, gbase, v0, v1) do { \
    __builtin_amdgcn_global_load_lds((const unsigned*)((const char*)(gbase) + (v0)), (LAS unsigned*)(lds + (bufoff) + ldsw), 16, 0, 0); \
    __builtin_amdgcn_global_load_lds((const unsigned*)((const char*)(gbase) + (v1)), (LAS unsigned*)(lds + (bufoff) + ldsw + 8192), 16, 0, 0); } while (0)
#define G_STAGE_A(b, h, kt) G_STAGE(G_SA(b, h), Ab + (size_t)(kt) * (BK * 2), va[(h) * 2], va[(h) * 2 + 1])
#define G_STAGE_B(b, h, kt) G_STAGE(G_SB(b, h), Bb + (size_t)(h) * hstep + (size_t)(kt) * (BK * 2), vb0, vb1)
#define G_LD8(base) __builtin_shufflevector(*(const LAS i32x4*)(lds + (base)), *(const LAS i32x4*)(lds + (base) + 1024), 0, 1, 2, 3, 4, 5, 6, 7)
#define G_LDA(dst, b, h) do { _Pragma("unroll") for (int m = 0; m < 4; ++m) dst[m] = G_LD8(G_SA(b, h) + laoff + m * 2048); } while (0)
#define G_LDB(dst, b, h) do { _Pragma("unroll") for (int n = 0; n < 2; ++n) dst[n] = G_LD8(G_SB(b, h) + lboff + n * 2048); } while (0)
#define G_LO(v) __builtin_bit_cast(bf16x8, __builtin_shufflevector(v, v, 0, 1, 2, 3))
#define G_HI(v) __builtin_bit_cast(bf16x8, __builtin_shufflevector(v, v, 4, 5, 6, 7))
#define G_MMA(ai, bj, Af, Bf) do { __builtin_amdgcn_s_setprio(1); \
    if (FP8) { \
      _Pragma("unroll") for (int m = 0; m < 4; ++m) _Pragma("unroll") for (int n = 0; n < 2; ++n) \
        asm volatile("v_mfma_f32_16x16x128_f8f6f4 %0, %1, %2, %0" : "+v"(acc[ai][bj][m][n]) : "v"(Bf[n]), "v"(Af[m])); \
    } else { \
      _Pragma("unroll") for (int m = 0; m < 4; ++m) _Pragma("unroll") for (int n = 0; n < 2; ++n) { \
        acc[ai][bj][m][n] = __builtin_amdgcn_mfma_f32_16x16x32_bf16(G_LO(Bf[n]), G_LO(Af[m]), acc[ai][bj][m][n], 0, 0, 0); \
        acc[ai][bj][m][n] = __builtin_amdgcn_mfma_f32_16x16x32_bf16(G_HI(Bf[n]), G_HI(Af[m]), acc[ai][bj][m][n], 0, 0, 0); } } \
    __builtin_amdgcn_s_setprio(0); } while (0)
#define G_WAIT_V(n) asm volatile("s_waitcnt vmcnt(" #n ")" ::: "memory")
#define G_WAIT_L(n) asm volatile("s_waitcnt lgkmcnt(" #n ")" ::: "memory")
#define G_BAR __builtin_amdgcn_s_barrier()
#define G_SCHED __builtin_amdgcn_sched_barrier(0)

__device__ __forceinline__ int gemm_stage_row(int tid, int i) { int R, C; stage_rc(tid * 16 + i * 8192, R, C); return R; }
__device__ __forceinline__ int gemm_stage_col(int tid, int i) { int R, C; stage_rc(tid * 16 + i * 8192, R, C); return C; }

template <bool FP8, class Epi>
__device__ __forceinline__ void gemm_unit(const void* __restrict__ A, const unsigned (&aoffb)[4], const void* __restrict__ Bt, const int PITCH, const Epi& epi, const int NT = 0) {
    LAS unsigned char* lds = (LAS unsigned char*)dynlds;
    const int tid = opaque_tid();
    const int wid = __builtin_amdgcn_readfirstlane(tid >> 6), lane = tid & 63, wr = wid >> 2, wc = wid & 3, fr = lane & 15, fq = lane >> 4;
    const unsigned va[4] = {aoffb[0], aoffb[1], aoffb[2], aoffb[3]};
    unsigned vb0, vb1;
    { int R0, C0, R1, C1; stage_rc(tid * 16, R0, C0); stage_rc(tid * 16 + 8192, R1, C1); vb0 = (unsigned)(R0 * PITCH + C0 * 2); vb1 = (unsigned)(R1 * PITCH + C1 * 2); }
    const char* Ab = (const char*)A; const char* Bb = (const char*)Bt;
    const size_t hstep = (size_t)HALF * PITCH;
    const unsigned ldsw = (unsigned)wid * 1024u;
    const int laoff = lds_byte(wr * 64 + fr, fq * 8), lboff = lds_byte(wc * 32 + fr, fq * 8);
    f32x4 acc[2][2][4][2];
#pragma unroll
    for (int a = 0; a < 2; ++a)
#pragma unroll
        for (int b = 0; b < 2; ++b)
#pragma unroll
            for (int m = 0; m < 4; ++m)
#pragma unroll
                for (int n = 0; n < 2; ++n) acc[a][b][m][n] = (f32x4){0.f, 0.f, 0.f, 0.f};
    i32x8 At[4], B0[2], B1[2];
    const int nt = NT ? NT : PITCH / (BK * 2);
    __syncthreads();
    G_STAGE_B(0, 0, 0); G_STAGE_A(0, 0, 0); G_STAGE_B(0, 1, 0); G_STAGE_A(0, 1, 0);
    if (wr == 1) G_BAR;
    G_WAIT_V(4); G_BAR;
    G_STAGE_B(1, 0, 1); G_STAGE_A(1, 0, 1); G_STAGE_B(1, 1, 1);
    G_WAIT_V(6); G_BAR;
    for (int t = 0; t < nt - 2; t += 2) {
        G_LDB(B0, 0, 0); G_SCHED; G_LDA(At, 0, 0); G_STAGE_A(1, 1, t + 1);
        G_WAIT_L(8); G_BAR; G_WAIT_L(0); G_MMA(0, 0, At, B0); G_BAR; G_SCHED;
        G_LDB(B1, 0, 1); G_STAGE_B(0, 0, t + 2);
        G_BAR; G_WAIT_L(0); G_MMA(0, 1, At, B1); G_BAR;
        G_LDA(At, 0, 1); G_STAGE_A(0, 0, t + 2);
        G_BAR; G_WAIT_L(0); G_MMA(1, 0, At, B0); G_BAR; G_SCHED;
        G_STAGE_B(0, 1, t + 2);
        G_WAIT_V(6); G_BAR; G_MMA(1, 1, At, B1); G_BAR;
        G_LDB(B0, 1, 0); G_SCHED; G_LDA(At, 1, 0); G_STAGE_A(0, 1, t + 2);
        G_WAIT_L(8); G_BAR; G_WAIT_L(0); G_MMA(0, 0, At, B0); G_BAR; G_SCHED;
        G_LDB(B1, 1, 1); G_STAGE_B(1, 0, t + 3);
        G_BAR; G_WAIT_L(0); G_MMA(0, 1, At, B1); G_BAR;
        G_LDA(At, 1, 1); G_STAGE_A(1, 0, t + 3);
        G_BAR; G_WAIT_L(0); G_MMA(1, 0, At, B0); G_BAR; G_SCHED;
        G_STAGE_B(1, 1, t + 3);
        G_WAIT_V(6); G_BAR; G_MMA(1, 1, At, B1); G_BAR;
    }
    { G_LDB(B0, 0, 0); G_WAIT_V(0); G_LDA(At, 0, 0); G_STAGE_A(1, 1, nt - 1);
      G_BAR; G_WAIT_L(0); G_MMA(0, 0, At, B0); G_BAR;
      G_LDB(B1, 0, 1); G_BAR; G_WAIT_L(0); G_MMA(0, 1, At, B1); G_BAR;
      G_LDA(At, 0, 1); G_WAIT_V(4); G_BAR; G_WAIT_L(0); G_MMA(1, 0, At, B0); G_MMA(1, 1, At, B1); G_BAR; }
    { G_LDB(B0, 1, 0); G_LDA(At, 1, 0); G_WAIT_V(2); G_BAR; G_WAIT_L(0); G_MMA(0, 0, At, B0); G_BAR;
      G_LDB(B1, 1, 1); G_WAIT_V(0); G_BAR; G_WAIT_L(0); G_MMA(0, 1, At, B1); G_BAR;
      G_LDA(At, 1, 1); G_BAR; G_WAIT_L(0); G_MMA(1, 0, At, B0); G_MMA(1, 1, At, B1); G_BAR; }
    if (wr == 0) G_BAR;
    if (FP8) asm volatile("s_nop 15\n\ts_nop 15" ::: "memory");
    {
        int tz = threadIdx.x; asm volatile("" : "+v"(tz));
        const int wid2 = tz >> 6, lane2 = tz & 63;
        epi(acc, wid2 >> 2, wid2 & 3, lane2 & 15, lane2 >> 4);
    }
    __syncthreads();
}

template <bool FP8, int EPI_STORES, class Epi>
__device__ __forceinline__ void gemm_unit_pre(const void* __restrict__ A, const unsigned (&aoffb)[4], const void* __restrict__ Bt, const int PITCH, const Epi& epi,
                                              const bool staged, const bool has_next, const void* __restrict__ nA, const void* __restrict__ nB) {
    constexpr int NT = 0;
    LAS unsigned char* lds = (LAS unsigned char*)dynlds;
    const int tid = opaque_tid();
    const int wid = __builtin_amdgcn_readfirstlane(tid >> 6), lane = tid & 63, wr = wid >> 2, wc = wid & 3, fr = lane & 15, fq = lane >> 4;
    const unsigned va[4] = {aoffb[0], aoffb[1], aoffb[2], aoffb[3]};
    unsigned vb0, vb1;
    { int R0, C0, R1, C1; stage_rc(tid * 16, R0, C0); stage_rc(tid * 16 + 8192, R1, C1); vb0 = (unsigned)(R0 * PITCH + C0 * 2); vb1 = (unsigned)(R1 * PITCH + C1 * 2); }
    const char* Ab = (const char*)A; const char* Bb = (const char*)Bt;
    const size_t hstep = (size_t)HALF * PITCH;
    const unsigned ldsw = (unsigned)wid * 1024u;
    const int laoff = lds_byte(wr * 64 + fr, fq * 8), lboff = lds_byte(wc * 32 + fr, fq * 8);
    f32x4 acc[2][2][4][2];
#pragma unroll
    for (int a = 0; a < 2; ++a)
#pragma unroll
        for (int b = 0; b < 2; ++b)
#pragma unroll
            for (int m = 0; m < 4; ++m)
#pragma unroll
                for (int n = 0; n < 2; ++n) acc[a][b][m][n] = (f32x4){0.f, 0.f, 0.f, 0.f};
    i32x8 At[4], B0[2], B1[2];
    const int nt = NT ? NT : PITCH / (BK * 2);
    if (!staged) {
        __syncthreads();
        G_STAGE_B(0, 0, 0); G_STAGE_A(0, 0, 0); G_STAGE_B(0, 1, 0); G_STAGE_A(0, 1, 0);
        if (wr == 1) G_BAR;
        G_WAIT_V(4); G_BAR;
    } else {
        static_assert(EPI_STORES == 8, "the counted wait below is written for 8 stores");
        if (wr == 1) G_BAR;
        G_WAIT_V(8); G_BAR;
    }
    G_STAGE_B(1, 0, 1); G_STAGE_A(1, 0, 1); G_STAGE_B(1, 1, 1);
    G_WAIT_V(6); G_BAR;
    for (int t = 0; t < nt - 2; t += 2) {
        G_LDB(B0, 0, 0); G_SCHED; G_LDA(At, 0, 0); G_STAGE_A(1, 1, t + 1);
        G_WAIT_L(8); G_BAR; G_WAIT_L(0); G_MMA(0, 0, At, B0); G_BAR; G_SCHED;
        G_LDB(B1, 0, 1); G_STAGE_B(0, 0, t + 2);
        G_BAR; G_WAIT_L(0); G_MMA(0, 1, At, B1); G_BAR;
        G_LDA(At, 0, 1); G_STAGE_A(0, 0, t + 2);
        G_BAR; G_WAIT_L(0); G_MMA(1, 0, At, B0); G_BAR; G_SCHED;
        G_STAGE_B(0, 1, t + 2);
        G_WAIT_V(6); G_BAR; G_MMA(1, 1, At, B1); G_BAR;
        G_LDB(B0, 1, 0); G_SCHED; G_LDA(At, 1, 0); G_STAGE_A(0, 1, t + 2);
        G_WAIT_L(8); G_BAR; G_WAIT_L(0); G_MMA(0, 0, At, B0); G_BAR; G_SCHED;
        G_LDB(B1, 1, 1); G_STAGE_B(1, 0, t + 3);
        G_BAR; G_WAIT_L(0); G_MMA(0, 1, At, B1); G_BAR;
        G_LDA(At, 1, 1); G_STAGE_A(1, 0, t + 3);
        G_BAR; G_WAIT_L(0); G_MMA(1, 0, At, B0); G_BAR; G_SCHED;
        G_STAGE_B(1, 1, t + 3);
        G_WAIT_V(6); G_BAR; G_MMA(1, 1, At, B1); G_BAR;
    }
    { G_LDB(B0, 0, 0); G_WAIT_V(0); G_LDA(At, 0, 0); G_STAGE_A(1, 1, nt - 1);
      G_BAR; G_WAIT_L(0); G_MMA(0, 0, At, B0); G_BAR;
      G_LDB(B1, 0, 1); G_BAR; G_WAIT_L(0); G_MMA(0, 1, At, B1); G_BAR;
      G_LDA(At, 0, 1); G_WAIT_V(4); G_BAR; G_WAIT_L(0); G_MMA(1, 0, At, B0); G_MMA(1, 1, At, B1); G_BAR; }
    { G_LDB(B0, 1, 0); G_LDA(At, 1, 0); G_WAIT_V(2); G_BAR; G_WAIT_L(0); G_MMA(0, 0, At, B0); G_BAR;
      G_LDB(B1, 1, 1); G_WAIT_V(0); G_BAR; G_WAIT_L(0); G_MMA(0, 1, At, B1); G_BAR;
      G_LDA(At, 1, 1); G_BAR; G_WAIT_L(0); G_MMA(1, 0, At, B0); G_MMA(1, 1, At, B1); G_BAR; }
    if (wr == 0) G_BAR;
    if (FP8) asm volatile("s_nop 15\n\ts_nop 15" ::: "memory");
    {
        int tz = threadIdx.x; asm volatile("" : "+v"(tz));
        const int wid2 = tz >> 6, lane2 = tz & 63;
        epi.stage(acc, wid2 >> 2, wid2 & 3, lane2 & 15, lane2 >> 4);
    }
    if (has_next) {
        const char* nAb = (const char*)nA; const char* nBb = (const char*)nB;
        int tz2 = threadIdx.x; asm volatile("" : "+v"(tz2));
        int R0, C0, R1, C1; stage_rc(tz2 * 16, R0, C0); stage_rc(tz2 * 16 + 8192, R1, C1);
        const unsigned o0 = (unsigned)(R0 * PITCH + C0 * 2), o1 = (unsigned)(R1 * PITCH + C1 * 2);
        const size_t hs = (size_t)HALF * PITCH;
        {
            const unsigned ldsw = (unsigned)(tz2 >> 6) * 1024u;
            G_STAGE(G_SB(0, 0), nBb, o0, o1); G_STAGE(G_SA(0, 0), nAb, o0, o1); G_STAGE(G_SB(0, 1), nBb + hs, o0, o1); G_STAGE(G_SA(0, 1), nAb + hs, o0, o1);
        }
    }
    epi.store();
    G_WAIT_L(0); G_BAR;
}


struct GUnit { const char* A; const char* B; int u0, u1, u2, u3; };
template <bool FP8, bool GATHER, class Sc>
__device__ __forceinline__ void gemm_stream(Sc& sc, const int PITCH, const int nt) {
    LAS unsigned char* lds = (LAS unsigned char*)dynlds;
    const int tid = opaque_tid();
    const int wid = __builtin_amdgcn_readfirstlane(tid >> 6), lane = tid & 63, wr = wid >> 2, wc = wid & 3, fr = lane & 15, fq = lane >> 4;
    unsigned vb0, vb1, vac[4], van[4];
    { int R0, C0, R1, C1; stage_rc(tid * 16, R0, C0); stage_rc(tid * 16 + 8192, R1, C1); vb0 = (unsigned)(R0 * PITCH + C0 * 2); vb1 = (unsigned)(R1 * PITCH + C1 * 2); }
    const size_t hstep = (size_t)HALF * PITCH, kstep = (size_t)(BK * 2);
    vac[0] = vb0; vac[1] = vb1; vac[2] = vb0 + (unsigned)hstep; vac[3] = vb1 + (unsigned)hstep;
    const unsigned ldsw = (unsigned)wid * 1024u;
    const int laoff = lds_byte(wr * 64 + fr, fq * 8), lboff = lds_byte(wc * 32 + fr, fq * 8);
    GUnit cur, nxt;
    if (!sc.next(0, cur, vac)) return;
    f32x4 acc[2][2][4][2];
#pragma unroll
    for (int a = 0; a < 2; ++a)
#pragma unroll
        for (int b = 0; b < 2; ++b)
#pragma unroll
            for (int m = 0; m < 4; ++m)
#pragma unroll
                for (int n = 0; n < 2; ++n) acc[a][b][m][n] = (f32x4){0.f, 0.f, 0.f, 0.f};
    i32x8 At[4], B0[2], B1[2];
    const char* cA = cur.A; const char* cB = cur.B;
#define S_STA(b, h, base, V) G_STAGE(G_SA(b, h), base, V[(h) * 2], V[(h) * 2 + 1])
#define S_STB(b, h, base) G_STAGE(G_SB(b, h), (base) + (size_t)(h) * hstep, vb0, vb1)
    __syncthreads();
    S_STB(0, 0, cB); S_STA(0, 0, cA, vac); S_STB(0, 1, cB); S_STA(0, 1, cA, vac);
    if (wr == 1) G_BAR;
    G_WAIT_V(4); G_BAR;
    S_STB(1, 0, cB + kstep); S_STA(1, 0, cA + kstep, vac); S_STB(1, 1, cB + kstep);
    G_WAIT_V(6); G_BAR;
    for (int ui = 0;; ++ui) {
        bool has_next;
        if (GATHER) has_next = sc.next(ui + 1, nxt, van); else { unsigned dummy[4]; has_next = sc.next(ui + 1, nxt, dummy); }
        const char* nA = has_next ? nxt.A : cA; const char* nB = has_next ? nxt.B : cB;
        if (GATHER && !has_next) { van[0] = vac[0]; van[1] = vac[1]; van[2] = vac[2]; van[3] = vac[3]; }
        for (int t = 0; t < nt; t += 2) {
            const bool last = (t == nt - 2);
            const char* a1 = cA + (size_t)(t + 1) * kstep;
            const char* a2 = last ? nA : cA + (size_t)(t + 2) * kstep; const char* b2 = last ? nB : cB + (size_t)(t + 2) * kstep;
            const char* a3 = a2 + kstep; const char* b3 = b2 + kstep;
            unsigned vx[4];
            if (GATHER) { vx[0] = last ? van[0] : vac[0]; vx[1] = last ? van[1] : vac[1]; vx[2] = last ? van[2] : vac[2]; vx[3] = last ? van[3] : vac[3]; }
            else { vx[0] = vac[0]; vx[1] = vac[1]; vx[2] = vac[2]; vx[3] = vac[3]; }
            G_LDB(B0, 0, 0); G_SCHED; G_LDA(At, 0, 0); S_STA(1, 1, a1, vac);
            G_WAIT_L(8); G_BAR; G_WAIT_L(0); G_MMA(0, 0, At, B0); G_BAR; G_SCHED;
            G_LDB(B1, 0, 1); S_STB(0, 0, b2);
            G_BAR; G_WAIT_L(0); G_MMA(0, 1, At, B1); G_BAR;
            G_LDA(At, 0, 1); S_STA(0, 0, a2, vx);
            G_BAR; G_WAIT_L(0); G_MMA(1, 0, At, B0); G_BAR; G_SCHED;
            S_STB(0, 1, b2);
            G_WAIT_V(6); G_BAR; G_MMA(1, 1, At, B1); G_BAR;
            G_LDB(B0, 1, 0); G_SCHED; G_LDA(At, 1, 0); S_STA(0, 1, a2, vx);
            G_WAIT_L(8); G_BAR; G_WAIT_L(0); G_MMA(0, 0, At, B0); G_BAR; G_SCHED;
            G_LDB(B1, 1, 1); S_STB(1, 0, b3);
            G_BAR; G_WAIT_L(0); G_MMA(0, 1, At, B1); G_BAR;
            G_LDA(At, 1, 1); S_STA(1, 0, a3, vx);
            G_BAR; G_WAIT_L(0); G_MMA(1, 0, At, B0); G_BAR; G_SCHED;
            S_STB(1, 1, b3);
            G_WAIT_V(6); G_BAR; G_MMA(1, 1, At, B1); G_BAR;
        }
        if (FP8) asm volatile("s_nop 15\n\ts_nop 15" ::: "memory");
        {
            int tz = threadIdx.x; asm volatile("" : "+v"(tz));
            const int wid2 = tz >> 6, lane2 = tz & 63;
            sc.epilogue(acc, cur, wid2 >> 2, wid2 & 3, lane2 & 15, lane2 >> 4);
        }
        if (!has_next) break;
#pragma unroll
        for (int a = 0; a < 2; ++a)
#pragma unroll
            for (int b = 0; b < 2; ++b)
#pragma unroll
                for (int m = 0; m < 4; ++m)
#pragma unroll
                    for (int n = 0; n < 2; ++n) acc[a][b][m][n] = (f32x4){0.f, 0.f, 0.f, 0.f};
        cur = nxt; cA = nA; cB = nB;
        if (GATHER) { vac[0] = van[0]; vac[1] = van[1]; vac[2] = van[2]; vac[3] = van[3]; }
    }
    G_WAIT_V(0);
    if (wr == 0) G_BAR;
    __syncthreads();
#undef S_STA
#undef S_STB
}

__device__ __forceinline__ bool dense_order(int i, int c, int G, int nM, int nN, int& pm, int& pn) {
    const int nwg = nM * nN; const long L = (long)i * G + c; if (L >= nwg) return false;
    int wgid = (int)L; { const int q = nwg / 8, r = nwg % 8, xcd = wgid % 8, off = wgid / 8; wgid = (xcd < r ? xcd * (q + 1) : r * (q + 1) + (xcd - r) * q) + off; }
    const int nig = 8 * nN, gid = wgid / nig, fm = gid * 8, gsz = (nM - fm) < 8 ? (nM - fm) : 8;
    pm = fm + ((wgid % nig) % gsz); pn = (wgid % nig) / gsz; return true;
}

typedef f32x4 AccT[2][2][4][2];

constexpr unsigned TPB = 528;
__device__ __forceinline__ void stage_tile_bf16(const AccT& acc, int wr, int wc, int fr, int fq, float scale) {
    LAS unsigned char* L8 = (LAS unsigned char*)dynlds;
#pragma unroll
    for (int ai = 0; ai < 2; ++ai)
#pragma unroll
        for (int m = 0; m < 4; ++m) {
            const unsigned ro = (unsigned)(ai * 128 + wr * 64 + m * 16 + fr) * TPB + (wc * 32 + fq * 4) * 2;
#pragma unroll
            for (int bj = 0; bj < 2; ++bj)
#pragma unroll
                for (int n = 0; n < 2; ++n) { const f32x4 v = acc[ai][bj][m][n] * scale; u32x2 w; w.x = pk2(v[0], v[1]); w.y = pk2(v[2], v[3]); *(LAS u32x2*)(L8 + ro + (bj * 128 + n * 16) * 2) = w; }
        }
}

struct EpiProj {
    bf16_t* C; int ldc; int row0, col0;
    __device__ __forceinline__ void operator()(const AccT& acc, int wr, int wc, int fr, int fq) const {
        stage_tile_bf16(acc, wr, wc, fr, fq, 1.0f);
        __syncthreads();
        const int tid = opaque_tid(), wave = tid >> 6, lane = tid & 63;
        LAS unsigned char* L8 = (LAS unsigned char*)dynlds;
#pragma unroll 8
        for (int i = 0; i < 32; ++i) {
            const int r = wave * 32 + i;
            *(u32x2*)(C + (size_t)(row0 + r) * ldc + col0 + lane * 4) = *(const LAS u32x2*)(L8 + (unsigned)r * TPB + lane * 8);
        }
    }
};

struct EpiLora {
    bf16_t* LO; const float* lbias; int row0, col0;
    __device__ __forceinline__ void operator()(const AccT& acc, int wr, int wc, int fr, int fq) const {
        const int seg = col0 >> 10, cbase = (col0 & 1023) + wc * 32 + fq * 4;
        const float* bias = lbias + (seg & 3) * DR_;
        LAS unsigned char* L8 = (LAS unsigned char*)dynlds;
#pragma unroll
        for (int bj = 0; bj < 2; ++bj)
#pragma unroll
            for (int n = 0; n < 2; ++n) {
                const int c = cbase + bj * 128 + n * 16;
                f32x4 bv = (f32x4){0.f, 0.f, 0.f, 0.f};
                if (seg < 4) bv = *(const f32x4*)(bias + c);
#pragma unroll
                for (int ai = 0; ai < 2; ++ai)
#pragma unroll
                    for (int m = 0; m < 4; ++m) {
                        const f32x4 v = acc[ai][bj][m][n] + bv; float o[4];
#pragma unroll
                        for (int j = 0; j < 4; ++j) {
                            const float xx = v[j];
                            if (seg < 2) o[j] = 1.0f - __expf(-0.60653066f * sigmoidf_(xx));
                            else if (seg < 4) o[j] = sigmoidf_(xx);
                            else o[j] = xx;
                        }
                        u32x2 w; w.x = pk2(o[0], o[1]); w.y = pk2(o[2], o[3]);
                        *(LAS u32x2*)(L8 + (unsigned)(ai * 128 + wr * 64 + m * 16 + fr) * TPB + (bj * 128 + wc * 32 + n * 16 + fq * 4) * 2) = w;
                    }
            }
        __syncthreads();
        const int tid = opaque_tid(), wave = tid >> 6, lane = tid & 63;
        bf16_t* outp = LO + (size_t)seg * T_ * DR_ + (col0 & 1023);
#pragma unroll 8
        for (int i = 0; i < 32; ++i) {
            const int r = wave * 32 + i;
            *(u32x2*)(outp + (size_t)(row0 + r) * DR_ + lane * 4) = *(const LAS u32x2*)(L8 + (unsigned)r * TPB + lane * 8);
        }
    }
};

struct EpiWout {
    const float* x; const float* gate; float* out; float* ssq; int row0, col0;
    __device__ __forceinline__ void ldx(f32x4 (&xv)[8], int g, int wr, int wc, int fr, int fq) const {
        const int c = col0 + (g >> 1) * 128 + wc * 32 + (g & 1) * 16 + fq * 4;
#pragma unroll
        for (int ai = 0; ai < 2; ++ai)
#pragma unroll
            for (int m = 0; m < 4; ++m) xv[ai * 4 + m] = *(const f32x4*)(x + (size_t)(row0 + ai * 128 + wr * 64 + m * 16 + fr) * D_ + c);
    }
    __device__ __forceinline__ void operator()(const AccT& acc, int wr, int wc, int fr, int fq) const {
        float ss[2][4];
#pragma unroll
        for (int ai = 0; ai < 2; ++ai)
#pragma unroll
            for (int m = 0; m < 4; ++m) ss[ai][m] = 0.f;
#pragma unroll
        for (int g = 0; g < 4; ++g) {
            const int bj = g >> 1, n = g & 1;
            const int c = col0 + bj * 128 + wc * 32 + n * 16 + fq * 4;
            const f32x4 gv = *(const f32x4*)(gate + c);
            f32x4 xa[8];
            ldx(xa, g, wr, wc, fr, fq);
#pragma unroll
            for (int ai = 0; ai < 2; ++ai)
#pragma unroll
                for (int m = 0; m < 4; ++m) {
                    const size_t o = (size_t)(row0 + ai * 128 + wr * 64 + m * 16 + fr) * D_ + c;
                    const f32x4 r = xa[ai * 4 + m] + gv * acc[ai][bj][m][n];
                    *(f32x4*)(out + o) = r;
                    ss[ai][m] += r[0] * r[0] + r[1] * r[1] + r[2] * r[2] + r[3] * r[3];
                }
        }
#pragma unroll
        for (int ai = 0; ai < 2; ++ai)
#pragma unroll
            for (int m = 0; m < 4; ++m) {
                float v = ss[ai][m];
                v += __shfl_xor(v, 16); v += __shfl_xor(v, 32);
                if (fq == 0) ssq[(size_t)(row0 + ai * 128 + wr * 64 + m * 16 + fr) * 32 + (col0 >> 8) * 4 + wc] = v;
            }
    }
};

struct EpiGateUp {
    fp8_t* act; size_t arow0; int ncol0;
    __device__ __forceinline__ void operator()(const AccT& acc, int wr, int wc, int fr, int fq) const {
        LAS unsigned char* L8 = (LAS unsigned char*)dynlds;
        constexpr unsigned TP8 = 144;
#pragma unroll
        for (int ai = 0; ai < 2; ++ai)
#pragma unroll
            for (int m = 0; m < 4; ++m) {
#pragma unroll
                for (int n = 0; n < 2; ++n) {
                    const f32x4 g = acc[ai][0][m][n] * (1.0f / 64.0f), u = acc[ai][1][m][n] * (1.0f / 64.0f); float o[4];
#pragma unroll
                    for (int j = 0; j < 4; ++j) o[j] = g[j] * sigmoidf_(g[j]) * u[j];
                    *(LAS unsigned*)(L8 + (unsigned)(ai * 128 + wr * 64 + m * 16 + fr) * TP8 + wc * 32 + n * 16 + fq * 4) = pk4_fp8(o[0], o[1], o[2], o[3]);
                }
            }
        __syncthreads();
        const int tid = opaque_tid(), wave = tid >> 6, lane = tid & 63;
#pragma unroll
        for (int i = 0; i < 4; ++i) {
            const int r = wave * 32 + i * 8 + (lane >> 3);
            *(u32x4*)(act + (arow0 + r) * EFF + ncol0 + (lane & 7) * 16) = *(const LAS u32x4*)(L8 + (unsigned)r * TP8 + (lane & 7) * 16);
        }
    }
};

constexpr float SLOT_SCALE = 16.0f;
constexpr unsigned DR_STAGE = 65536;
constexpr unsigned DUMP_ROW = T_ * NSLOT;
template <bool ROUTED>
struct EpiDownRouted {
    fp8_t* slot; const unsigned* list; const float* gw; int r0, cnt, col0;
    static constexpr unsigned TQ = 272;
    __device__ __forceinline__ void stage(const AccT& acc, int wr, int wc, int fr, int fq) const {
        LAS unsigned char* L8 = (LAS unsigned char*)dynlds + DR_STAGE;
        LAS unsigned* rowslot = (LAS unsigned*)(L8 + 256 * TQ);
        unsigned sl[8]; float gg[8];
#pragma unroll
        for (int q = 0; q < 8; ++q) {
            const int lr = (q >> 2) * 128 + wr * 64 + (q & 3) * 16 + fr, rr = r0 + lr;
            if (ROUTED) { const int rc = rr < LIST_CAP ? rr : LIST_CAP - 1; const unsigned v = list[rc]; gg[q] = gw[rc] * (SLOT_SCALE / 32.0f); sl[q] = (rr < cnt) ? v : 0xffffffffu; }
            else { sl[q] = (unsigned)rr * NSLOT + TOPK; gg[q] = SLOT_SCALE / 32.0f; }
        }
#pragma unroll
        for (int ai = 0; ai < 2; ++ai)
#pragma unroll
            for (int m = 0; m < 4; ++m) {
                const int q = ai * 4 + m, lr = ai * 128 + wr * 64 + m * 16 + fr;
                if (wc == 0 && fq == 0) rowslot[lr] = (sl[q] != 0xffffffffu) ? sl[q] : DUMP_ROW;
                const unsigned ro = (unsigned)lr * TQ + wc * 32 + fq * 4;
#pragma unroll
                for (int bj = 0; bj < 2; ++bj)
#pragma unroll
                    for (int n = 0; n < 2; ++n) { const f32x4 v = acc[ai][bj][m][n] * gg[q]; *(LAS unsigned*)(L8 + ro + bj * 128 + n * 16) = pk4_fp8(v[0], v[1], v[2], v[3]); }
            }
        __syncthreads();
    }
    __device__ __forceinline__ void store() const {
        LAS unsigned char* L8 = (LAS unsigned char*)dynlds + DR_STAGE;
        LAS unsigned* rowslot = (LAS unsigned*)(L8 + 256 * TQ);
        const int tid = opaque_tid(), wave = tid >> 6, lane = tid & 63;
#pragma unroll
        for (int i = 0; i < 8; ++i) {
            const int r = wave * 32 + i * 4 + (lane >> 4);
            const unsigned sr = rowslot[r];
            *(u32x4*)(slot + (size_t)sr * D_ + col0 + (lane & 15) * 16) = *(const LAS u32x4*)(L8 + (unsigned)r * TQ + (lane & 15) * 16);
        }
    }
};

__device__ __forceinline__ int map_row(int mode, int n) {
    if (mode == 1) return ((n >> 7) << 8) + (n & 127);
    if (mode == 2) return ((n >> 7) << 8) + 128 + (n & 127);
    if (mode == 3) return n < RWKV_IN_ ? n : n + 96;
    return n;
}
__device__ __forceinline__ void cvt_wave_tile(const float* __restrict__ W, int N, int Kv, int k0, int n0, bf16_t* __restrict__ dst, int dld, int mode, int dcol0, float* scr, int lane) {
    f32x4 tv[8];
#pragma unroll
    for (int i = 0; i < 8; ++i) {
        const int kk = 8 * i + (lane >> 3);
        tv[i] = (f32x4){0.f, 0.f, 0.f, 0.f};
        if (k0 + kk < Kv) tv[i] = *(const f32x4*)(W + (size_t)(k0 + kk) * N + n0 + (lane & 7) * 4);
    }
#pragma unroll
    for (int i = 0; i < 8; ++i) {
        const int kk = 8 * i + (lane >> 3);
#pragma unroll
        for (int j = 0; j < 4; ++j) scr[kk * 33 + (lane & 7) * 4 + j] = tv[i][j];
    }
    asm volatile("s_waitcnt lgkmcnt(0)" ::: "memory");
    const int c = lane & 7;
#pragma unroll
    for (int j = 0; j < 4; ++j) {
        const int n = (lane >> 3) + 8 * j; const float* sp = scr + (8 * c) * 33 + n;
        uint4 o; o.x = pk2(sp[0 * 33], sp[1 * 33]); o.y = pk2(sp[2 * 33], sp[3 * 33]); o.z = pk2(sp[4 * 33], sp[5 * 33]); o.w = pk2(sp[6 * 33], sp[7 * 33]);
        *(uint4*)(dst + (size_t)map_row(mode, n0 + n) * dld + dcol0 + k0 + 8 * c) = o;
    }
    asm volatile("s_waitcnt lgkmcnt(0)" ::: "memory");
}
__device__ __forceinline__ void cvt_f8_load(const float* __restrict__ W, int N, int k0, int n0, float (&tv)[32], int lane) {
#pragma unroll
    for (int i = 0; i < 8; ++i) {
        const float* Wi = W + (size_t)(k0 + 16 * i) * N + n0;
        const f32x4 v = *(const f32x4*)(Wi + (unsigned)((lane >> 2) * N + (lane & 3) * 4));
        tv[4 * i] = v[0]; tv[4 * i + 1] = v[1]; tv[4 * i + 2] = v[2]; tv[4 * i + 3] = v[3];
    }
}
__device__ __forceinline__ void cvt_f8_finish(const float (&tv)[32], int k0, int n0, fp8_t* __restrict__ dst, int dld, int mode, float scl, float* scr, int lane) {
#pragma unroll
    for (int i = 0; i < 8; ++i)
#pragma unroll
        for (int j = 0; j < 4; ++j) scr[(16 * i + (lane >> 2)) * 17 + (lane & 3) * 4 + j] = tv[4 * i + j];
    asm volatile("s_waitcnt lgkmcnt(0)" ::: "memory");
#pragma unroll
    for (int q = 0; q < 2; ++q) {
        const int pr = lane + 64 * q, n = pr >> 3, ck = pr & 7; const float* sp = scr + (ck * 16) * 17 + n;
        uint4 o;
        o.x = pk4_fp8(sp[0 * 17] * scl, sp[1 * 17] * scl, sp[2 * 17] * scl, sp[3 * 17] * scl);
        o.y = pk4_fp8(sp[4 * 17] * scl, sp[5 * 17] * scl, sp[6 * 17] * scl, sp[7 * 17] * scl);
        o.z = pk4_fp8(sp[8 * 17] * scl, sp[9 * 17] * scl, sp[10 * 17] * scl, sp[11 * 17] * scl);
        o.w = pk4_fp8(sp[12 * 17] * scl, sp[13 * 17] * scl, sp[14 * 17] * scl, sp[15 * 17] * scl);
        *(uint4*)(dst + (size_t)map_row(mode, n0 + n) * dld + k0 + ck * 16) = o;
    }
    asm volatile("s_waitcnt lgkmcnt(0)" ::: "memory");
}
__device__ __forceinline__ void cvt_wave_tile_f8(const float* __restrict__ W, int N, int k0, int n0, fp8_t* __restrict__ dst, int dld, int mode, float scl, float* scr, int lane) {
    float tv[32]; cvt_f8_load(W, N, k0, n0, tv, lane); cvt_f8_finish(tv, k0, n0, dst, dld, mode, scl, scr, lane);
}
__device__ __forceinline__ void cvt_expert_load(const Params& p, int wt, float (&tv)[32], int lane) {
    const int mtx = wt >> 15, r = wt & 32767, e = r >> 9, rr = r & 511;
    if (mtx < 2) cvt_f8_load((mtx ? p.w_up_e : p.w_gate_e) + (size_t)e * 2048 * 512, 512, (rr >> 5) * 128, (rr & 31) * 16, tv, lane);
    else cvt_f8_load(p.w_down_e + (size_t)e * 512 * 2048, 2048, (rr >> 7) * 128, (rr & 127) * 16, tv, lane);
}
__device__ __forceinline__ void cvt_expert_finish(const Params& p, int wt, const float (&tv)[32], float* scr, int lane) {
    const int mtx = wt >> 15, r = wt & 32767, e = r >> 9, rr = r & 511;
    if (mtx < 2) cvt_f8_finish(tv, (rr >> 5) * 128, (rr & 31) * 16, p.We1q + (size_t)e * 1024 * 2048, 2048, 1 + mtx, 64.0f, scr, lane);
    else cvt_f8_finish(tv, (rr >> 7) * 128, (rr & 127) * 16, p.We2q + (size_t)e * 2048 * 512, 512, 0, 32.0f, scr, lane);
}
__device__ __forceinline__ void cvt_expert_tile(const Params& p, int wt, float* scr, int lane) {
    float tv[32]; cvt_expert_load(p, wt, tv, lane); cvt_expert_finish(p, wt, tv, scr, lane);
}

constexpr int W_IN = 32 * 205, W_OUT = 32 * 64, W_S = 32 * 16, W_SD = 8 * 64, W_L = 32, W_G = 3 * 32;
constexpr int W_DEFER = W_OUT + 2 * W_S + W_SD, W_TOTAL = W_IN + W_DEFER + 4 * W_L + W_G;
__device__ __forceinline__ void small_tile(const Params& p, int r, float* scr, int lane) {
    if (r < W_IN) { cvt_wave_tile(p.w_in, 6560, 2048, (r / 205) * 64, (r % 205) * 32, p.Win, 2048, 3, 0, scr, lane); return; } r -= W_IN;
    if (r < W_OUT) { cvt_wave_tile(p.w_out, 2048, 2048, (r >> 6) * 64, (r & 63) * 32, p.Wout, 2048, 0, 0, scr, lane); return; } r -= W_OUT;
    if (r < W_S) { cvt_wave_tile_f8(p.w_gate_s, 512, (r >> 5) * 128, (r & 31) * 16, p.Ws1q, 2048, 1, 64.0f, scr, lane); return; } r -= W_S;
    if (r < W_S) { cvt_wave_tile_f8(p.w_up_s, 512, (r >> 5) * 128, (r & 31) * 16, p.Ws1q, 2048, 2, 64.0f, scr, lane); return; } r -= W_S;
    if (r < W_SD) { cvt_wave_tile_f8(p.w_down_s, 2048, (r >> 7) * 128, (r & 127) * 16, p.Ws2q, 512, 0, 32.0f, scr, lane); return; } r -= W_SD;
    if (r < W_L) { cvt_wave_tile(p.w_up_f, 1024, 64, 0, r * 32, p.Wlora, 512, 0, 0, scr, lane); return; } r -= W_L;
    if (r < W_L) { cvt_wave_tile(p.w_up_b, 1024, 64, 0, r * 32, p.Wlora + (size_t)1024 * 512, 512, 0, 64, scr, lane); return; } r -= W_L;
    if (r < W_L) { cvt_wave_tile(p.a_up_f, 1024, 64, 0, r * 32, p.Wlora + (size_t)2048 * 512, 512, 0, 128, scr, lane); return; } r -= W_L;
    if (r < W_L) { cvt_wave_tile(p.a_up_b, 1024, 64, 0, r * 32, p.Wlora + (size_t)3072 * 512, 512, 0, 192, scr, lane); return; } r -= W_L;
    cvt_wave_tile(p.g_up, 1024, 160, (r >> 5) * 64, (r & 31) * 32, p.Wlora + (size_t)4096 * 512, 512, 0, 256, scr, lane);
}
constexpr int CVT_ITEMS = 3 * 32768 / 32, PRE_PER_WG = 0;
__device__ __forceinline__ void tail_split(int G, int& first_idle, int& n_idle) {
    const int rem = ((T_ / 256) * (NPROJ / 256)) % G;
    first_idle = rem == 0 ? G : rem; n_idle = G - first_idle;
}
__device__ __forceinline__ int conv_prefilled(int G) { int f, n; tail_split(G, f, n); const int v = n * PRE_PER_WG; return v < CVT_ITEMS ? v : CVT_ITEMS; }

__device__ __forceinline__ void phase_prologue(const Params& p) {
    const int tid = opaque_tid(), wave = tid >> 6, lane = tid & 63, bid = blockIdx.x, nb = gridDim.x;
    for (int u = bid; u < 192; u += nb) {
        float* sc = (float*)dynlds; float* red = sc + 4 * D_;
        __syncthreads();
        for (int i = tid; i < 4 * D_; i += NTHREADS) { const float cv = p.c[i]; sc[i] = cv * sigmoidf_(cv); }
        __syncthreads();
        float acc[4][4];
#pragma unroll
        for (int b = 0; b < 4; ++b)
#pragma unroll
            for (int j = 0; j < 4; ++j) acc[b][j] = 0.f;
        const int rg = lane >> 4, c4 = (lane & 15) * 4;
        const float* wp = p.w_ada + (size_t)(wave * 256 + rg) * 12288 + u * 64 + c4;
#pragma unroll 16
        for (int it = 0; it < 64; ++it) {
            const float4 wv = *(const float4*)(wp + (size_t)it * 4 * 12288);
            const int k = wave * 256 + it * 4 + rg;
#pragma unroll
            for (int b = 0; b < 4; ++b) { const float sv = sc[b * D_ + k]; acc[b][0] += sv * wv.x; acc[b][1] += sv * wv.y; acc[b][2] += sv * wv.z; acc[b][3] += sv * wv.w; }
        }
#pragma unroll
        for (int b = 0; b < 4; ++b)
#pragma unroll
            for (int j = 0; j < 4; ++j) red[(wave * 16 + b * 4 + j) * 64 + lane] = acc[b][j];
        __syncthreads();
        if (tid < 256) {
            const int b = tid >> 6, col = tid & 63, cl = col >> 2, j = col & 3;
            float sm = 0.f;
#pragma unroll
            for (int w = 0; w < 8; ++w)
#pragma unroll
                for (int g = 0; g < 4; ++g) sm += red[(w * 16 + b * 4 + j) * 64 + g * 16 + cl];
            p.mod[b * 12288 + u * 64 + col] = sm + p.b_ada[u * 64 + col];
        }
        __syncthreads();
    }
    for (int i = bid * NTHREADS + tid; i < 4 * DR_; i += nb * NTHREADS) {
        const int sg = i >> 10, c = i & 1023;
        float v = p.w0_f[c]; if (sg == 1) v = p.w0_b[c]; if (sg == 2) v = p.a0_f[c]; if (sg == 3) v = p.a0_b[c];
        p.lbias[i] = v;
    }
    for (int i = bid * NTHREADS + tid; i < 96 * D_ / 8; i += nb * NTHREADS) *(uint4*)(p.Win + (size_t)RWKV_IN_ * D_ + (size_t)i * 8) = make_uint4(0u, 0u, 0u, 0u);
    {
        float* scr = (float*)dynlds + wave * 2176;
        int fi, ni; tail_split(nb, fi, ni);
        const bool defer = ni > 0;
        __syncthreads();
        for (int it = bid * 8 + wave; it < (defer ? W_TOTAL - W_DEFER : W_TOTAL); it += nb * 8) {
            int r = it; if (defer && r >= W_IN) r += W_DEFER;
            small_tile(p, r, scr, lane);
        }
        __syncthreads();
    }
}

__device__ __forceinline__ void phase_norm1(const Params& p) {
    const int tid = opaque_tid(), wave = tid >> 6, lane = tid & 63;
    for (int row = blockIdx.x * 8 + wave; row < T_; row += gridDim.x * 8) {
        const int b = row >> 12;
        const float4* xr = (const float4*)(p.x + (size_t)row * D_) + lane;
        float4 v[8]; float ss = 0.f;
#pragma unroll
        for (int i = 0; i < 8; ++i) { v[i] = xr[i * 64]; ss += v[i].x * v[i].x + v[i].y * v[i].y + v[i].z * v[i].z + v[i].w * v[i].w; }
        ss = wave_sum(ss);
        const float rstd = rsqrtf(ss * (1.0f / D_) + 1e-6f);
        const float* modb = p.mod + b * 12288;
        bf16_t* hr = p.H + (size_t)row * D_;
#pragma unroll
        for (int i = 0; i < 8; ++i) {
            const int c = i * 256 + lane * 4;
            const float4 nw = *(const float4*)(p.norm1_w + c), sh = *(const float4*)(modb + c), sc = *(const float4*)(modb + 2048 + c);
            u32x2 w;
            w.x = pk2(v[i].x * rstd * nw.x * (1.f + sc.x) + sh.x, v[i].y * rstd * nw.y * (1.f + sc.y) + sh.y);
            w.y = pk2(v[i].z * rstd * nw.z * (1.f + sc.z) + sh.z, v[i].w * rstd * nw.w * (1.f + sc.w) + sh.w);
            *(u32x2*)(hr + c) = w;
        }
    }
}

__device__ __forceinline__ void dense_aoff(unsigned (&aoff)[4], int row0, int pitch) {
    const int tid = opaque_tid();
    int R0, C0, R1, C1; stage_rc(tid * 16, R0, C0); stage_rc(tid * 16 + 8192, R1, C1);
    aoff[0] = (unsigned)(row0 + R0) * pitch + C0 * 2; aoff[1] = (unsigned)(row0 + R1) * pitch + C1 * 2;
    aoff[2] = (unsigned)(row0 + 128 + R0) * pitch + C0 * 2; aoff[3] = (unsigned)(row0 + 128 + R1) * pitch + C1 * 2;
}

__device__ __forceinline__ void phase_gemm_in(const Params& p) {
    for (int i = 0;; ++i) {
        int pm, pn; if (!dense_order(i, blockIdx.x, gridDim.x, T_ / 256, NPROJ / 256, pm, pn)) break;
        unsigned aoff[4]; dense_aoff(aoff, pm * 256, D_ * 2);
        EpiProj epi{p.proj, NPROJ, pm * 256, pn * 256};
        gemm_unit<false>(p.H, aoff, p.Win + (size_t)pn * 256 * D_, D_ * 2, epi);
    }
    int fi, ni; tail_split(gridDim.x, fi, ni);
    if ((int)blockIdx.x >= fi) {
        const int tid = opaque_tid(), wave = tid >> 6, lane = tid & 63, j = blockIdx.x - fi;
        float* scr = (float*)dynlds + wave * 2176;
        for (int it = j * 8 + wave; it < W_DEFER; it += ni * 8) small_tile(p, W_IN + it, scr, lane);
#pragma unroll 1
        for (int k = 0; k < PRE_PER_WG; ++k) {
            const int item = j * PRE_PER_WG + k;
            if (item < CVT_ITEMS) {
#pragma unroll 1
                for (int q = 0; q < 4; ++q) cvt_expert_tile(p, item * 32 + wave * 4 + q, scr, lane);
            }
        }
        __syncthreads();
    }
}
__device__ __forceinline__ void phase_gemm_lora(const Params& p) {
    for (int i = 0;; ++i) {
        int pm, pn; if (!dense_order(i, blockIdx.x, gridDim.x, T_ / 256, 4096 / 256, pm, pn)) break;
        const int koff = 0;
        unsigned aoff[4]; dense_aoff(aoff, pm * 256, 512 * 2);
        EpiLora epi{p.LO, p.lbias, pm * 256, pn * 256};
        gemm_unit<false>((const char*)p.Alora + koff, aoff, (const char*)(p.Wlora + (size_t)pn * 256 * 512) + koff, 512 * 2, epi, 4);
    }
}
__device__ __forceinline__ void phase_gemm_out(const Params& p) {
    for (int i = 0;; ++i) {
        int pm, pn; if (!dense_order(i, blockIdx.x, gridDim.x, T_ / 256, D_ / 256, pm, pn)) break;
        unsigned aoff[4]; dense_aoff(aoff, pm * 256, D_ * 2);
        EpiWout epi{p.x, p.mod + ((pm * 256) >> 12) * 12288 + 4096, p.out, p.ssq, pm * 256, pn * 256};
        gemm_unit<false>(p.ycat, aoff, p.Wout + (size_t)pn * 256 * D_, D_ * 2, epi);
    }
}

__device__ __forceinline__ void shifted8(const Params& p, int t, int ch, float (&z)[8]) {
    const int s = t & (SEQ_ - 1);
    const bf16_t* pr = p.proj + (size_t)t * NPROJ + ch;
    const uint4 cur = *(const uint4*)pr;
    uint4 prv = make_uint4(0u, 0u, 0u, 0u), nxt = make_uint4(0u, 0u, 0u, 0u);
    if (s > 0) prv = *(const uint4*)(pr - NPROJ);
    if (s < SEQ_ - 1) nxt = *(const uint4*)(pr + NPROJ);
    float a[8], b[8], c[8]; unpack8(prv, a); unpack8(cur, b); unpack8(nxt, c);
    const float* sw = p.rwkv_shift + ch;
#pragma unroll
    for (int j = 0; j < 8; ++j) z[j] = sw[j] * a[j] + sw[RWKV_IN_ + j] * b[j] + sw[2 * RWKV_IN_ + j] * c[j];
}

__device__ __forceinline__ void phase_prep(const Params& p) {
    const int tid = opaque_tid();
    for (int u = blockIdx.x; u < T_ / 64; u += gridDim.x) {
        const int t0 = u * 64;
        {
            const int gl = tid & 127, tq = tid >> 7;
#pragma unroll 1
            for (int seg = 0; seg < 3; ++seg) {
                const int ch = gl * 8, pc = seg * 1024 + ch;
                float w0[8], w1[8], w2[8], kkw[8];
#pragma unroll
                for (int j = 0; j < 8; ++j) { w0[j] = p.rwkv_shift[pc + j]; w1[j] = p.rwkv_shift[RWKV_IN_ + pc + j]; w2[j] = p.rwkv_shift[2 * RWKV_IN_ + pc + j]; kkw[j] = p.k_k[ch + j]; }
                const int tb = t0 + tq * 16;
                const bf16_t* pr = p.proj + (size_t)tb * NPROJ + pc;
                float a[8], b[8], c[8];
                { uint4 prv = make_uint4(0u, 0u, 0u, 0u); if ((tb & (SEQ_ - 1)) > 0) prv = *(const uint4*)(pr - NPROJ); unpack8(prv, a); unpack8(*(const uint4*)pr, b); }
#pragma unroll 8
                for (int j16 = 0; j16 < 16; ++j16) {
                    const int t = tb + j16;
                    uint4 nxt = make_uint4(0u, 0u, 0u, 0u);
                    if ((t & (SEQ_ - 1)) < SEQ_ - 1) nxt = *(const uint4*)(pr + (size_t)(j16 + 1) * NPROJ);
                    unpack8(nxt, c);
                    float z[8], kkv[8]; float ss = 0.f;
#pragma unroll
                    for (int j = 0; j < 8; ++j) { z[j] = w0[j] * a[j] + w1[j] * b[j] + w2[j] * c[j]; kkv[j] = z[j] * kkw[j]; ss += kkv[j] * kkv[j]; a[j] = b[j]; b[j] = c[j]; }
                    ss = red8_sum(ss);
                    const size_t o = (size_t)t * DR_ + ch;
                    if (seg == 0) *(uint4*)(p.rb + o) = pack8(z);
                    else if (seg == 2) *(uint4*)(p.vb + o) = pack8(z);
                    else {
                        *(uint4*)(p.kb + o) = pack8(z);
                        const float sc = rsqrtf(fmaxf(ss, 1e-12f));
#pragma unroll
                        for (int j = 0; j < 8; ++j) kkv[j] *= sc;
                        *(uint4*)(p.kkb + o) = pack8(kkv);
                    }
                }
            }
        }
#pragma unroll 4
        for (int it = tid; it < 64 * 64; it += NTHREADS) {
            const int tl = it >> 6, g = it & 63, t = t0 + tl;
            float z[8];
            if (g < 52) {
                shifted8(p, t, PC_L + g * 8, z);
                if (g < 16) {
#pragma unroll
                    for (int j = 0; j < 8; ++j) z[j] = tanhf(z[j]);
                } else if (g >= 32) {
#pragma unroll
                    for (int j = 0; j < 8; ++j) z[j] = sigmoidf_(z[j]);
                }
            } else {
#pragma unroll
                for (int j = 0; j < 8; ++j) z[j] = 0.f;
            }
            *(uint4*)(p.Alora + (size_t)t * 512 + g * 8) = pack8(z);
        }
    }
}

__device__ __forceinline__ void prep_na_tile(const Params& p, const int t0) {
    const int tid = opaque_tid();
    {
#pragma unroll 8
        for (int it = tid; it < 64 * 256; it += NTHREADS) {
            const int tl = it >> 8, g = it & 255, t = t0 + tl, isk = g >> 7, ch = (g & 127) * 8;
            const uint4 raw = *(const uint4*)(p.proj + (size_t)t * NPROJ + (isk ? PC_KN : PC_Q) + ch);
            float v[8]; unpack8(raw, v);
            float ss = 0.f;
#pragma unroll
            for (int j = 0; j < 8; ++j) ss += v[j] * v[j];
            ss = red8_sum(ss);
            const float rs = rsqrtf(ss * (1.0f / 64.0f) + 1e-6f) * (isk ? 1.0f : 0.125f);
            const float* nw = (isk ? p.kn_w : p.qn_w) + (ch & 63);
#pragma unroll
            for (int j = 0; j < 8; ++j) v[j] = v[j] * rs * nw[j];
            *(uint4*)((isk ? p.KN : p.QN) + ((size_t)((t >> 12) * 16 + (ch >> 6)) * SEQ_ + (t & (SEQ_ - 1))) * 64 + (ch & 63)) = pack8(v);
        }
        bf16_t* sT = (bf16_t*)dynlds;
        __syncthreads();
#pragma unroll 8
        for (int it = tid; it < 128 * 64; it += NTHREADS) {
            const int tl = it & 63, g = it >> 6;
            const uint4 raw = *(const uint4*)(p.proj + (size_t)(t0 + tl) * NPROJ + PC_VN + g * 8);
            const unsigned w[4] = {raw.x, raw.y, raw.z, raw.w};
#pragma unroll
            for (int j = 0; j < 4; ++j) { sT[(g * 8 + 2 * j) * 64 + tl] = (bf16_t)(w[j] & 0xffffu); sT[(g * 8 + 2 * j + 1) * 64 + tl] = (bf16_t)(w[j] >> 16); }
        }
        __syncthreads();
        {
            const int b = t0 >> 12, s0 = t0 & (SEQ_ - 1);
#pragma unroll 8
            for (int it = tid; it < 1024 * 8; it += NTHREADS) {
                const int ch = ((it >> 9) << 6) | (it & 63), t8 = (it >> 6) & 7;
                const uint4 v = *(const uint4*)(sT + ch * 64 + t8 * 8);
                *(uint4*)(p.VT + (((size_t)(b * 16 + (ch >> 6)) * (SEQ_ / 8) + (s0 >> 3) + t8) * 64 + (ch & 63)) * 8) = v;
            }
        }
        __syncthreads();
    }
}

typedef short s16x4 __attribute__((ext_vector_type(4)));
constexpr int CVT_TILES = 3 * 32768;
constexpr unsigned SLOT = 9216, SPITCH = 144;
__device__ __forceinline__ bf16x8 lds16(unsigned off) { return *(const LAS bf16x8*)((LAS unsigned char*)dynlds + off); }
template <bool SWAP>
__device__ __forceinline__ void mm_acc(f32x4 (&acc)[2], unsigned X, unsigned Y, int tm, int tn0, int fr, int fq) {
#pragma unroll
    for (int ks = 0; ks < 2; ++ks) {
        const bf16x8 xa = lds16(X + (unsigned)(tm * 16 + fr) * SPITCH + ks * 64 + fq * 16);
#pragma unroll
        for (int q = 0; q < 2; ++q) {
            const bf16x8 yb = lds16(Y + (unsigned)((tn0 + q) * 16 + fr) * SPITCH + ks * 64 + fq * 16);
            acc[q] = SWAP ? __builtin_amdgcn_mfma_f32_16x16x32_bf16(yb, xa, acc[q], 0, 0, 0) : __builtin_amdgcn_mfma_f32_16x16x32_bf16(xa, yb, acc[q], 0, 0, 0);
        }
    }
}
__device__ __forceinline__ void st_rows(unsigned D, const f32x4& v, int tm, int tn, int fr, int fq) {
    u32x2 w; w.x = pk2(v[0], v[1]); w.y = pk2(v[2], v[3]);
    *(LAS u32x2*)((LAS unsigned char*)dynlds + D + (unsigned)(tm * 16 + fr) * SPITCH + (tn * 16 + fq * 4) * 2) = w;
}
__device__ __forceinline__ void st_tr(unsigned DT, const f32x4& v, int tm, int tn, int fr, int fq, bool diag) {
    const int m = tm * 16 + fr;
    const int n0 = tn * 16 + fq * 4;
    float d[4];
#pragma unroll
    for (int e = 0; e < 4; ++e) d[e] = diag ? __uint_as_float(0x3f800000u & (unsigned)((((n0 + e) ^ m) - 1) >> 31)) : 0.f;
    const unsigned w0 = pk2(v[0] + d[0], v[1] + d[1]);
    const unsigned w1 = pk2(v[2] + d[2], v[3] + d[3]);
    LAS bf16_t* base = (LAS bf16_t*)((LAS unsigned char*)dynlds + DT) + (unsigned)(tn * 16 + fq * 4) * (SPITCH / 2) + m;
    base[0] = (bf16_t)(w0 & 0xffffu); base[SPITCH / 2] = (bf16_t)(w0 >> 16); base[SPITCH] = (bf16_t)(w1 & 0xffffu); base[3 * (SPITCH / 2)] = (bf16_t)(w1 >> 16);
}
__device__ __forceinline__ f32x4 ld_rows(unsigned D, int tm, int tn, int fr, int fq) {
    const u32x2 w = *(const LAS u32x2*)((LAS unsigned char*)dynlds + D + (unsigned)(tm * 16 + fr) * SPITCH + (tn * 16 + fq * 4) * 2);
    return (f32x4){bflo(w.x), bfhi(w.x), bflo(w.y), bfhi(w.y)};
}

template <bool REV>
__device__ __forceinline__ void scan_unit(const Params& p, int b, int h) {
    const int tid = opaque_tid(), wave = tid >> 6, lane = tid & 63, fr = lane & 15, fq = lane >> 4, tm = wave >> 1, tn0 = (wave & 1) * 2;
    constexpr unsigned O_SB = 0 * SLOT, O_VT = 1 * SLOT, O_BHT = 2 * SLOT, O_KHT = 3 * SLOT, O_RT = 4 * SLOT, O_MBRT = 5 * SLOT, O_MKRT = 6 * SLOT, O_MKA = 7 * SLOT,
                       O_ATT = 8 * SLOT, O_AT = 9 * SLOT, O_BT = 10 * SLOT, O_KT = 11 * SLOT, O_NA = 12 * SLOT, O_LA = 13 * SLOT, O_NB = 14 * SLOT, O_LB = 15 * SLOT,
                       O_PA = O_AT, O_PB = O_BT, O_U = O_KT, O_M1 = O_KT, O_M2 = 16 * SLOT, O_X2T = O_NA, O_X1T = O_LA, O_CUM = O_NA  ;
    LAS unsigned char* L8 = (LAS unsigned char*)dynlds;
    LAS float* cum = (LAS float*)(L8 + O_CUM); LAS float* btot = (LAS float*)(L8 + O_M2);
    const bf16_t* omd = p.LO + (size_t)(REV ? 1 : 0) * T_ * DR_;
    const bf16_t* asg = p.LO + (size_t)(REV ? 3 : 2) * T_ * DR_;
    bf16_t* yout = p.H + (size_t)(REV ? 1 : 0) * T_ * DR_;
    f32x4 Sf[2];
    Sf[0] = (f32x4){0.f, 0.f, 0.f, 0.f}; Sf[1] = Sf[0];
    __syncthreads();
    st_rows(O_SB, Sf[0], tm, tn0, fr, fq); st_rows(O_SB, Sf[1], tm, tn0 + 1, fr, fq);
    const int pj = tid & 63, ptg = tid >> 6;
    const int ptl = tid >> 3, pcg = tid & 7;
    const float ka1 = p.k_a[h * 64 + pj];
    float ka8[8];
#pragma unroll
    for (int e = 0; e < 8; ++e) ka8[e] = p.k_a[h * 64 + pcg * 8 + e];
    unsigned r_om[8], r_kk[8], r_as[8], r_k[8], r_v[8];
    uint4 q_kk, q_as, q_om, q_k, q_r;
    auto load_chunk = [&](int c) {
#pragma unroll
        for (int e = 0; e < 8; ++e) {
            const int u = c * 64 + ptg * 8 + e; const int t = REV ? (SEQ_ - 1 - u) : u;
            const size_t tb = (size_t)(b * SEQ_ + t) * DR_ + h * 64 + pj;
            r_om[e] = omd[tb]; r_kk[e] = p.kkb[tb]; r_as[e] = asg[tb]; r_k[e] = p.kb[tb]; r_v[e] = p.vb[tb];
        }
        const int u2 = c * 64 + ptl; const int t2 = REV ? (SEQ_ - 1 - u2) : u2;
        const size_t base = (size_t)(b * SEQ_ + t2) * DR_ + h * 64 + pcg * 8;
        q_kk = *(const uint4*)(p.kkb + base); q_as = *(const uint4*)(asg + base); q_om = *(const uint4*)(omd + base);
        q_k = *(const uint4*)(p.kb + base); q_r = *(const uint4*)(p.rb + base);
    };
    load_chunk(0);
#pragma unroll 1
    for (int c = 0; c < SEQ_ / 64; ++c) {
        float cp[8];
        cp[0] = 1.0f - bflo(r_om[0]);
#pragma unroll
        for (int e = 1; e < 8; ++e) cp[e] = cp[e - 1] * (1.0f - bflo(r_om[e]));
        btot[ptg * 64 + pj] = cp[7];
        __syncthreads();
        float pre = 1.f, tot = 1.f;
#pragma unroll
        for (int g = 0; g < 8; ++g) { const float v = btot[g * 64 + pj]; pre *= (g < ptg) ? v : 1.f; tot *= v; }
        {
            float o0[8], o1[8], o2[8], o3[8];
#pragma unroll
            for (int e = 0; e < 8; ++e) {
                const float W = pre * cp[e], wm = (e == 0) ? pre : pre * cp[e > 0 ? e - 1 : 0];
                cum[(ptg * 8 + e) * 64 + pj] = W;
                const float kkv = bflo(r_kk[e]), av = bflo(r_as[e]), kv = bflo(r_k[e]), vv = bflo(r_v[e]);
                const float rat = tot * __builtin_amdgcn_rcpf(W);
                o0[e] = -kkv * wm; o1[e] = kkv * av * rat; o2[e] = kv * (1.0f + (av - 1.0f) * ka1) * rat; o3[e] = vv;
            }
            const unsigned ro = (unsigned)pj * SPITCH + ptg * 16;
            *(LAS u32x4*)(L8 + O_ATT + ro) = pack8v(o0); *(LAS u32x4*)(L8 + O_BHT + ro) = pack8v(o1); *(LAS u32x4*)(L8 + O_KHT + ro) = pack8v(o2); *(LAS u32x4*)(L8 + O_VT + ro) = pack8v(o3);
        }
        __syncthreads();
        float wl[2][4];
        {
            float kk[8], av[8], om[8], kv[8], rv[8];
            unpack8(q_kk, kk); unpack8(q_as, av); unpack8(q_om, om); unpack8(q_k, kv); unpack8(q_r, rv);
            const f32x4 c0 = *(const LAS f32x4*)(cum + ptl * 64 + pcg * 8), c1 = *(const LAS f32x4*)(cum + ptl * 64 + pcg * 8 + 4);
            const int pl = ptl > 0 ? ptl - 1 : 0;
            f32x4 d0 = *(const LAS f32x4*)(cum + pl * 64 + pcg * 8), d1 = *(const LAS f32x4*)(cum + pl * 64 + pcg * 8 + 4);
            if (ptl == 0) { d0 = (f32x4){1.f, 1.f, 1.f, 1.f}; d1 = d0; }
            const float cu[8] = {c0.x, c0.y, c0.z, c0.w, c1.x, c1.y, c1.z, c1.w}, cm[8] = {d0.x, d0.y, d0.z, d0.w, d1.x, d1.y, d1.z, d1.w};
            float o0[8], o1[8], o2[8], o3[8];
#pragma unroll
            for (int e = 0; e < 8; ++e) {
                const float wm = cm[e], iw = __builtin_amdgcn_rcpf(cu[e]);
                o0[e] = -kk[e] * wm; o1[e] = kk[e] * av[e] * iw; o2[e] = kv[e] * (1.0f + (av[e] - 1.0f) * ka8[e]) * iw;
                o3[e] = rv[e] * (REV ? wm : cu[e]);
            }
            const unsigned ro = (unsigned)ptl * SPITCH + pcg * 16;
            *(LAS u32x4*)(L8 + O_AT + ro) = pack8v(o0); *(LAS u32x4*)(L8 + O_BT + ro) = pack8v(o1); *(LAS u32x4*)(L8 + O_KT + ro) = pack8v(o2); *(LAS u32x4*)(L8 + O_RT + ro) = pack8v(o3);
#pragma unroll
            for (int q = 0; q < 2; ++q) {
                const f32x4 cw = *(const LAS f32x4*)(cum + 63 * 64 + (tn0 + q) * 16 + fq * 4);
                wl[q][0] = cw.x; wl[q][1] = cw.y; wl[q][2] = cw.z; wl[q][3] = cw.w;
            }
        }
        if (c + 1 < SEQ_ / 64) load_chunk(c + 1);
        __builtin_amdgcn_sched_barrier(0);
        __syncthreads();
        {
            f32x4 a0[2] = {{0.f, 0.f, 0.f, 0.f}, {0.f, 0.f, 0.f, 0.f}}, a1[2] = {a0[0], a0[0]}, a2[2] = {a0[0], a0[0]}, a3[2] = {a0[0], a0[0]};
            mm_acc<true>(a0, O_BT, O_AT, tm, tn0, fr, fq); mm_acc<true>(a1, O_KT, O_AT, tm, tn0, fr, fq);
            mm_acc<true>(a2, O_RT, O_BT, tm, tn0, fr, fq); mm_acc<true>(a3, O_RT, O_KT, tm, tn0, fr, fq);
            const int m = tm * 16 + fr;
            f32x4 dd[2], m1[2], m2[2];
#pragma unroll
            for (int q = 0; q < 2; ++q) {
#pragma unroll
                for (int e = 0; e < 4; ++e) {
                    const int n = (tn0 + q) * 16 + fq * 4 + e;
                    const unsigned up = (unsigned)((m - n) >> 31), lo = (unsigned)((REV ? (n - m) : (n - m - 1)) >> 31);
                    const unsigned s16 = (unsigned)((((n ^ m) >> 4) - 1) >> 31), s32 = (unsigned)((((n ^ m) >> 5) - 1) >> 31);
                    const unsigned v0 = __float_as_uint(a0[q][e]) & up;
                    dd[q][e] = __uint_as_float(v0 & s16); m1[q][e] = __uint_as_float(v0 & s32 & ~s16); m2[q][e] = __uint_as_float(v0 & ~s32);
                    a1[q][e] = __uint_as_float(__float_as_uint(a1[q][e]) & up); a2[q][e] = __uint_as_float(__float_as_uint(a2[q][e]) & lo); a3[q][e] = __uint_as_float(__float_as_uint(a3[q][e]) & lo);
                }
            }
            const int dq = tm - tn0;
            const bool own = (dq == 0) || (dq == 1);
            f32x4 e1 = {0.f, 0.f, 0.f, 0.f};
            if (own) {
#pragma unroll
                for (int ks = 0; ks < 2; ++ks) {
                    const bf16x8 xa = lds16(O_BT + (unsigned)(tm * 16 + fr) * SPITCH + ks * 64 + fq * 16), yb = lds16(O_AT + (unsigned)(tm * 16 + fr) * SPITCH + ks * 64 + fq * 16);
                    e1 = __builtin_amdgcn_mfma_f32_16x16x32_bf16(xa, yb, e1, 0, 0, 0);
                }
            }
            __syncthreads();
            f32x4 qi = {0.f, 0.f, 0.f, 0.f}, qti = qi;
            if (own) {
                f32x4 E, ET = dq ? dd[1] : dd[0], Q, QT;
#pragma unroll
                for (int e = 0; e < 4; ++e) {
                    const int cc = fq * 4 + e;
                    E[e] = __uint_as_float(__float_as_uint(e1[e]) & (unsigned)((cc - fr) >> 31));
                    const float idn = __uint_as_float(0x3f800000u & (unsigned)(((cc ^ fr) - 1) >> 31));
                    Q[e] = E[e] + idn; QT[e] = ET[e] + idn;
                }
#define PK4S(v) __builtin_bit_cast(s16x4, (u32x2){pk2((v)[0], (v)[1]), pk2((v)[2], (v)[3])})
#define MM16(Xb, Yb, C) __builtin_amdgcn_mfma_f32_16x16x16bf16_1k(Yb, Xb, C, 0, 0, 0)
#pragma unroll
                for (int lv = 0; lv < 3; ++lv) {
                    const s16x4 Eb = PK4S(E), ETb = PK4S(ET), Qb = PK4S(Q);
                    const f32x4 zz = {0.f, 0.f, 0.f, 0.f};
                    const f32x4 E2 = MM16(Eb, ETb, zz), ET2 = MM16(ETb, Eb, zz);
                    const s16x4 ET2b = PK4S(ET2);
                    Q = MM16(Qb, ET2b, Q);
                    QT = MM16(ET2b, Qb, QT);
                    E = E2; ET = ET2;
                }
#undef MM16
#undef PK4S
                qi = Q; qti = QT;
            }
#pragma unroll
            for (int q = 0; q < 2; ++q) {
                const bool dg = own && (q == dq);
                const f32x4 zz = {0.f, 0.f, 0.f, 0.f};
                st_rows(O_PB, dg ? qi : zz, tm, tn0 + q, fr, fq); st_rows(O_LA, dg ? qti : zz, tm, tn0 + q, fr, fq);
                st_tr(O_M1, m1[q], tm, tn0 + q, fr, fq, false); st_tr(O_M2, m2[q], tm, tn0 + q, fr, fq, false);
                st_rows(O_MKA, a1[q], tm, tn0 + q, fr, fq); st_rows(O_MBRT, a2[q], tm, tn0 + q, fr, fq); st_rows(O_MKRT, a3[q], tm, tn0 + q, fr, fq);
            }
        }
        __syncthreads();
        {
            constexpr unsigned O_DINV = O_PB, O_DINVT = O_LA, O_Z1T = O_NA, O_Z2P = O_NB, O_G1 = O_LB, O_WT = O_LA, O_P = O_PA;
            { f32x4 z[2] = {{0.f, 0.f, 0.f, 0.f}, {0.f, 0.f, 0.f, 0.f}}, y[2] = {z[0], z[0]};
              mm_acc<true>(z, O_M1, O_DINVT, tm, tn0, fr, fq); mm_acc<true>(y, O_M2, O_DINVT, tm, tn0, fr, fq);
#pragma unroll
              for (int q = 0; q < 2; ++q) { st_tr(O_Z1T, z[q], tm, tn0 + q, fr, fq, false); st_rows(O_Z2P, y[q], tm, tn0 + q, fr, fq); } }
            __syncthreads();
            { f32x4 g[2], w[2];
              g[0] = ld_rows(O_DINV, tm, tn0, fr, fq); g[1] = ld_rows(O_DINV, tm, tn0 + 1, fr, fq); mm_acc<true>(g, O_DINV, O_Z1T, tm, tn0, fr, fq);
              w[0] = ld_rows(O_Z2P, tm, tn0, fr, fq); w[1] = ld_rows(O_Z2P, tm, tn0 + 1, fr, fq); mm_acc<true>(w, O_Z2P, O_Z1T, tm, tn0, fr, fq);
#pragma unroll
              for (int q = 0; q < 2; ++q) { st_rows(O_G1, g[q], tm, tn0 + q, fr, fq); st_tr(O_WT, w[q], tm, tn0 + q, fr, fq, false); } }
            __syncthreads();
            { f32x4 g[2]; g[0] = ld_rows(O_G1, tm, tn0, fr, fq); g[1] = ld_rows(O_G1, tm, tn0 + 1, fr, fq); mm_acc<true>(g, O_G1, O_WT, tm, tn0, fr, fq);
              st_rows(O_P, g[0], tm, tn0, fr, fq); st_rows(O_P, g[1], tm, tn0 + 1, fr, fq); }
            __syncthreads();
            f32x4 x2[2] = {{0.f, 0.f, 0.f, 0.f}, {0.f, 0.f, 0.f, 0.f}}, x1[2] = {x2[0], x2[0]};
            mm_acc<true>(x2, O_P, O_ATT, tm, tn0, fr, fq); mm_acc<true>(x1, O_P, O_MKA, tm, tn0, fr, fq);
#pragma unroll
            for (int q = 0; q < 2; ++q) { st_rows(O_X2T, x2[q], tm, tn0 + q, fr, fq); st_rows(O_X1T, x1[q], tm, tn0 + q, fr, fq); }
        }
        __syncthreads();
        f32x4 yv[2] = {{0.f, 0.f, 0.f, 0.f}, {0.f, 0.f, 0.f, 0.f}};
        {
            f32x4 uu[2] = {{0.f, 0.f, 0.f, 0.f}, {0.f, 0.f, 0.f, 0.f}};
            mm_acc<true>(uu, O_SB, O_X2T, tm, tn0, fr, fq); mm_acc<true>(uu, O_VT, O_X1T, tm, tn0, fr, fq);
            st_rows(O_U, uu[0], tm, tn0, fr, fq); st_rows(O_U, uu[1], tm, tn0 + 1, fr, fq);
            mm_acc<false>(yv, O_SB, O_RT, tm, tn0, fr, fq); mm_acc<false>(yv, O_VT, O_MKRT, tm, tn0, fr, fq);
        }
        __syncthreads();
        {
#pragma unroll
            for (int q = 0; q < 2; ++q)
#pragma unroll
                for (int e = 0; e < 4; ++e) Sf[q][e] *= wl[q][e];
            mm_acc<true>(Sf, O_U, O_BHT, tm, tn0, fr, fq); mm_acc<true>(Sf, O_VT, O_KHT, tm, tn0, fr, fq);
            st_rows(O_SB, Sf[0], tm, tn0, fr, fq); st_rows(O_SB, Sf[1], tm, tn0 + 1, fr, fq);
            mm_acc<false>(yv, O_U, O_MBRT, tm, tn0, fr, fq);
#pragma unroll
            for (int q = 0; q < 2; ++q) {
                const int u = c * 64 + (tn0 + q) * 16 + fr; const int t = REV ? (SEQ_ - 1 - u) : u;
                u32x2 w; w.x = pk2(yv[q][0], yv[q][1]); w.y = pk2(yv[q][2], yv[q][3]);
                *(u32x2*)(yout + (size_t)(b * SEQ_ + t) * DR_ + h * 64 + tm * 16 + fq * 4) = w;
            }
        }
    }
    __syncthreads();
}

constexpr int NA_KP = 144, NA_P_OFF = 576 * NA_KP  , NA_BIAS_OFF = NA_P_OFF + 8 * 8448  ;
__device__ __forceinline__ void na_unit(const Params& p, int bu) {
    const int tid = opaque_tid(), wave = tid >> 6, lane = tid & 63, fr = lane & 15, fq = lane >> 4;
    const int b = bu >> 9, h = (bu >> 5) & 15, ip = bu & 31;
    LAS unsigned char* L8 = (LAS unsigned char*)dynlds;
    LAS float* rbias = (LAS float*)(L8 + NA_BIAS_OFF);
    LAS bf16_t* Pb = (LAS bf16_t*)(L8 + NA_P_OFF) + wave * (16 * 264);
    const int i0 = ip * 2, rs0 = min(max(i0 - 4, 0), 56);
    const bf16_t* qh = p.QN + (size_t)(b * 16 + h) * SEQ_ * 64; const bf16_t* kh = p.KN + (size_t)(b * 16 + h) * SEQ_ * 64; const bf16_t* vh = p.VT + (size_t)(b * 16 + h) * SEQ_ * 64;
    uint4 vreg[9];
#pragma unroll
    for (int j = 0; j < 9; ++j) {
        const int c = tid + j * NTHREADS;
        const int krow = min(rs0 + (c >> 9), 63), tok = krow * 64 + ((c >> 3) & 63), pc = c & 7;
        const uint4 kv = *(const uint4*)(kh + (size_t)tok * 64 + pc * 8);
        *(LAS u32x4*)(L8 + (unsigned)((c >> 3) * NA_KP + pc * 16)) = (u32x4){kv.x, kv.y, kv.z, kv.w};
        const int vrow = min(rs0 + (c >> 9), 63);
        vreg[j] = *(const uint4*)(vh + ((size_t)(vrow * 8 + ((c >> 6) & 7)) * 64 + (c & 63)) * 8);
    }
    for (int i = tid; i < 465; i += NTHREADS) rbias[i] = p.rel_bias[h * 465 + i];
    __syncthreads();
    const int i = i0 + (wave >> 2), cb = wave & 3;
    const int rs = min(max(i - 4, 0), 56), kc0 = min(max(cb * 16 - 8, 0), 32), lrow = rs - rs0;
    const bf16x8 aq0 = *(const bf16x8*)(qh + (size_t)(i * 64 + cb * 16 + fr) * 64 + fq * 8), aq1 = *(const bf16x8*)(qh + (size_t)(i * 64 + cb * 16 + fr) * 64 + 32 + fq * 8);
    float s[8][2][4];
#pragma unroll
    for (int kr = 0; kr < 8; ++kr)
#pragma unroll
        for (int hh = 0; hh < 2; ++hh) {
            const unsigned ko = (unsigned)(((lrow + kr) * 64 + kc0 + hh * 16 + fr) * NA_KP + fq * 16);
            const bf16x8 bk0 = *(const LAS bf16x8*)(L8 + ko), bk1 = *(const LAS bf16x8*)(L8 + ko + 64);
            f32x4 acc = (f32x4){0.f, 0.f, 0.f, 0.f};
            acc = __builtin_amdgcn_mfma_f32_16x16x32_bf16(aq0, bk0, acc, 0, 0, 0);
            acc = __builtin_amdgcn_mfma_f32_16x16x32_bf16(aq1, bk1, acc, 0, 0, 0);
            const int kc = kc0 + hh * 16 + fr;
#pragma unroll
            for (int jj = 0; jj < 4; ++jj) {
                const int qc = cb * 16 + fq * 4 + jj, wc0 = min(max(qc - 8, 0), 48);
                const unsigned vm = (unsigned)(((wc0 - kc - 1) >> 31) & ((kc - wc0 - 16) >> 31));
                const int bi = (rs + kr - i + 7) * 31 + min(max(kc - qc + 15, 0), 30);
                const float sv = acc[jj] + rbias[bi];
                s[kr][hh][jj] = __uint_as_float((__float_as_uint(sv) & vm) | (0xff800000u & ~vm));
            }
        }
    float mx[4], sm[4];
#pragma unroll
    for (int jj = 0; jj < 4; ++jj) {
        float m = -INFINITY;
#pragma unroll
        for (int kr = 0; kr < 8; ++kr) m = fmaxf(m, fmaxf(s[kr][0][jj], s[kr][1][jj]));
        mx[jj] = red16_max(m);
        float t = 0.f;
#pragma unroll
        for (int kr = 0; kr < 8; ++kr)
#pragma unroll
            for (int hh = 0; hh < 2; ++hh) { const float e = __expf(s[kr][hh][jj] - mx[jj]); s[kr][hh][jj] = e; t += e; }
        sm[jj] = red16_sum(t);
    }
#pragma unroll
    for (int kr = 0; kr < 8; ++kr)
#pragma unroll
        for (int hh = 0; hh < 2; ++hh)
#pragma unroll
            for (int jj = 0; jj < 4; jj += 2) {
                const unsigned w = pk2(s[kr][hh][jj], s[kr][hh][jj + 1]);
                Pb[(fq * 4 + jj) * 264 + kr * 32 + hh * 16 + fr] = (bf16_t)(w & 0xffffu);
                Pb[(fq * 4 + jj + 1) * 264 + kr * 32 + hh * 16 + fr] = (bf16_t)(w >> 16);
            }
    __syncthreads();
#pragma unroll
    for (int j = 0; j < 9; ++j) { const int c = tid + j * NTHREADS; *(LAS u32x4*)(L8 + (unsigned)c * 16) = (u32x4){vreg[j].x, vreg[j].y, vreg[j].z, vreg[j].w}; }
    __syncthreads();
    f32x4 o[4];
#pragma unroll
    for (int dt = 0; dt < 4; ++dt) o[dt] = (f32x4){0.f, 0.f, 0.f, 0.f};
#pragma unroll
    for (int kr = 0; kr < 8; ++kr) {
        const bf16x8 ap = *(const LAS bf16x8*)(Pb + fr * 264 + kr * 32 + fq * 8);
#pragma unroll
        for (int dt = 0; dt < 4; ++dt) {
            const bf16x8 bv = *(const LAS bf16x8*)(L8 + (unsigned)((((lrow + kr) * 8 + (kc0 >> 3) + fq) * 64 + dt * 16 + fr) * 16));
            o[dt] = __builtin_amdgcn_mfma_f32_16x16x32_bf16(ap, bv, o[dt], 0, 0, 0);
        }
    }
#pragma unroll
    for (int jj = 0; jj < 4; ++jj) {
        const float inv = 1.0f / sm[jj];
        bf16_t* orow = p.ycat + ((size_t)b * SEQ_ + i * 64 + cb * 16 + fq * 4 + jj) * D_ + DR_ + h * 64 + fr;
#pragma unroll
        for (int dt = 0; dt < 4; ++dt) orow[dt * 16] = (bf16_t)(pk2(o[dt][jj] * inv, 0.f) & 0xffffu);
    }
    __syncthreads();
}

constexpr int Q_PREP = T_ / 64;
__device__ __forceinline__ void phase_mix(const Params& p) {
    const int G = gridDim.x, bid = blockIdx.x;
    const bool split = (G % 16) == 0;
    if (!split || ((bid >> 3) & 1) == 0) {
        const int sidx = split ? ((bid >> 4) * 8 + (bid & 7)) : bid, nscan = split ? G / 2 : G;
        for (int u = sidx; u < 128; u += nscan) {
            const int b = u >> 5, h = (u >> 1) & 15;
            if (u & 1) scan_unit<true>(p, b, h); else scan_unit<false>(p, b, h);
        }
    }
    const int tid = opaque_tid(), wave = tid >> 6, lane = tid & 63;
    int* qslot = (int*)(dynlds + CTRL_OFF + 512);
    float* scr = (float*)dynlds + wave * 2176;
    __syncthreads();
    if (tid == 0) *qslot = (int)atomicAdd(p.qctr, 1u);
    __syncthreads();
    int it = __builtin_amdgcn_readfirstlane(*qslot);
    bool na_ready = false;
    const int npre = conv_prefilled(G);
    const int C = CVT_ITEMS - npre, n_alt = C < 2048 ? C : 2048, c_lead = C - n_alt;
    const int Q_GL = Q_PREP + 256, Q_LEAD = Q_GL + c_lead, Q_ALT = Q_LEAD + 2 * n_alt, Q_TOTAL = Q_ALT + (2048 - n_alt);
    while (it < Q_TOTAL) {
        __syncthreads();
        unsigned nxt = 0u;
        if (tid == 0) nxt = atomicAdd(p.qctr, 1u);
        int kind, idx;
        if (it < Q_PREP) { kind = 0; idx = it; }
        else if (it < Q_GL) { kind = 3; idx = it - Q_PREP; }
        else if (it < Q_LEAD) { kind = 1; idx = it - Q_GL; }
        else if (it < Q_ALT) { const int k2 = it - Q_LEAD; kind = 1 + (k2 & 1); idx = (k2 & 1) ? (k2 >> 1) : c_lead + (k2 >> 1); }
        else { kind = 2; idx = n_alt + (it - Q_ALT); }
        if (kind == 0) {
            prep_na_tile(p, idx * 64);
            asm volatile("s_waitcnt vmcnt(0)" ::: "memory");
            __syncthreads();
            if (tid == 0) { __builtin_amdgcn_fence(__ATOMIC_RELEASE, "agent"); asm volatile("s_waitcnt vmcnt(0)" ::: "memory"); (void)xb_add(p.qctr + 32, 1u); }
        } else if (kind == 1) {
            const int wt = (idx + npre) * 32 + __builtin_amdgcn_readfirstlane(wave) * 4;
            float tv0[32], tv1[32];
            cvt_expert_load(p, wt, tv0, lane); cvt_expert_load(p, wt + 1, tv1, lane);
            cvt_expert_finish(p, wt, tv0, scr, lane); cvt_expert_load(p, wt + 2, tv0, lane);
            cvt_expert_finish(p, wt + 1, tv1, scr, lane); cvt_expert_load(p, wt + 3, tv1, lane);
            cvt_expert_finish(p, wt + 2, tv0, scr, lane); cvt_expert_finish(p, wt + 3, tv1, scr, lane);
        } else if (kind == 3) {
            const int j = idx, pm = j >> 2, pn = 16 + (j & 3);
            unsigned aoff[4]; dense_aoff(aoff, pm * 256, 512 * 2);
            EpiLora epi{p.LO, p.lbias, pm * 256, pn * 256};
            gemm_unit<false>((const char*)p.Alora + 4 * BK * 2, aoff, (const char*)(p.Wlora + (size_t)pn * 256 * 512) + 4 * BK * 2, 512 * 2, epi, 4);
        } else {
            if (!na_ready) {
                if (tid == 0) {
                    unsigned sp = 0u;
                    while (xb_ld(p.qctr + 32) < (unsigned)Q_PREP) { __builtin_amdgcn_s_sleep(2); if (++sp > (1u << 22)) break; }
                    __builtin_amdgcn_fence(__ATOMIC_ACQUIRE, "agent");
                    asm volatile("s_waitcnt vmcnt(0)" ::: "memory");
                }
                __syncthreads();
                na_ready = true;
            }
            na_unit(p, idx);
        }
        if (tid == 0) *qslot = (int)nxt;
        __syncthreads();
        it = __builtin_amdgcn_readfirstlane(*qslot);
    }
    __syncthreads();
}

__device__ __forceinline__ void phase_combine(const Params& p) {
    const bf16_t* yf = p.H; const bf16_t* yb = p.H + (size_t)T_ * DR_;
    const bf16_t* af = p.LO + (size_t)2 * T_ * DR_; const bf16_t* gg = p.LO + (size_t)4 * T_ * DR_;
    for (int it = blockIdx.x * NTHREADS + threadIdx.x; it < T_ * 128; it += gridDim.x * NTHREADS) {
        const int t = it >> 7, ch = (it & 127) * 8, h = ch >> 6;
        const size_t o = (size_t)t * DR_ + ch;
        float a[8], b[8], r[8], k[8], av[8], v[8], g[8], y[8];
        unpack8(*(const uint4*)(yf + o), a); unpack8(*(const uint4*)(yb + o), b);
        unpack8(*(const uint4*)(p.rb + o), r); unpack8(*(const uint4*)(p.kb + o), k); unpack8(*(const uint4*)(af + o), av);
        unpack8(*(const uint4*)(p.vb + o), v); unpack8(*(const uint4*)(gg + o), g);
        float s1 = 0.f, bs = 0.f;
#pragma unroll
        for (int j = 0; j < 8; ++j) {
            y[j] = a[j] + b[j]; s1 += y[j];
            const float kf = k[j] * (1.0f + (av[j] - 1.0f) * p.k_a[ch + j]);
            bs += r[j] * kf * p.r_k[ch + j];
        }
        s1 = red8_sum(s1); bs = red8_sum(bs);
        const float mu = s1 * (1.0f / 64.0f);
        float s2 = 0.f;
#pragma unroll
        for (int j = 0; j < 8; ++j) { const float d = y[j] - mu; s2 += d * d; }
        s2 = red8_sum(s2);
        const float rstd = rsqrtf(s2 * (1.0f / 64.0f) + 64e-5f);
        float outv[8];
#pragma unroll
        for (int j = 0; j < 8; ++j) outv[j] = ((y[j] - mu) * rstd * p.ln_w[ch + j] + p.ln_b[ch + j] + bs * v[j]) * g[j];
        (void)h;
        *(uint4*)(p.ycat + (size_t)t * D_ + ch) = pack8(outv);
    }
}

__device__ __forceinline__ unsigned long long route_row(float logit, float rbias, int lane, float* gwv) {
    const float score = sigmoidf_(logit);
    const float bsd = score + rbias;
    const float m1 = red8_max(bsd);
    const unsigned long long eq = __ballot(bsd == m1);
    const unsigned gm = (unsigned)(eq >> (lane & 56)) & 0xffu;
    const int first = __ffs(gm) - 1;
    const float ex = ((lane & 7) == first) ? -INFINITY : bsd;
    const float m2 = red8_max(ex);
    const float gs = m1 + m2;
    const int g = lane >> 3; int rank = 0;
#pragma unroll
    for (int gp = 0; gp < 8; ++gp) { const float o = __shfl(gs, gp * 8); rank += ((o > gs) || (o == gs && gp < g)) ? 1 : 0; }
    float cur = (rank < 4) ? bsd : -INFINITY;
    unsigned long long sel = 0ull;
#pragma unroll 1
    for (int itk = 0; itk < TOPK; ++itk) {
        const float mxv = wave_max(cur);
        const unsigned long long em = __ballot(cur == mxv);
        const int idx = __ffsll((long long)em) - 1;
        sel |= 1ull << idx;
        if (lane == idx) cur = -INFINITY;
    }
    const bool me = (sel >> lane) & 1ull;
    const float ssum = wave_sum(me ? score : 0.f);
    *gwv = score / ssum * 2.5f;
    return sel;
}

__device__ __forceinline__ void phase_norm2_router(const Params& p) {
    const int tid = opaque_tid(), wave = tid >> 6, lane = tid & 63, fr = lane & 15, fq = lane >> 4;
    constexpr int HP = 260;
    float* hsl = (float*)dynlds;
    float* lg = hsl + 64 * HP;
    const float rbias = p.router_bias[lane];
    const int rt = wave >> 1, eh = wave & 1;
    for (int u = blockIdx.x; u < T_ / 64; u += gridDim.x) {
        const int row0 = u * 64 + wave * 8, b = row0 >> 12;
        const float* modb = p.mod + b * 12288;
        float rstd[8];
#pragma unroll
        for (int r = 0; r < 8; ++r) {
            const float v = (lane < 32) ? p.ssq[(size_t)(row0 + r) * 32 + lane] : 0.f;
            rstd[r] = rsqrtf(wave_sum(v) * (1.0f / D_) + 1e-6f);
        }
        f32x4 lacc[2]; lacc[0] = (f32x4){0.f, 0.f, 0.f, 0.f}; lacc[1] = lacc[0];
        float* Bs = lg + 64 * 65;
        const int bk0 = tid >> 4, bq4 = (tid & 15) * 4, bdq = bq4 ^ ((bk0 & 3) * 16);
        f32x4 xq[8], bq[8]; float4 nwq, shq, scq;
#define P8_PREFETCH(slv) { const int kbp = (slv) * 256 + lane * 4; \
            nwq = *(const float4*)(p.norm2_w + kbp); shq = *(const float4*)(modb + 6144 + kbp); scq = *(const float4*)(modb + 8192 + kbp); \
            _Pragma("unroll") for (int r = 0; r < 8; ++r) xq[r] = *(const f32x4*)(p.out + (size_t)(row0 + r) * D_ + kbp); \
            _Pragma("unroll") for (int j = 0; j < 8; ++j) bq[j] = *(const f32x4*)(p.w_router + (size_t)((slv) * 256 + bk0 + j * 32) * NEXP + bq4); }
        P8_PREFETCH(0)
#pragma unroll 1
        for (int sl = 0; sl < 8; ++sl) {
            const int kb = sl * 256 + lane * 4;
            const float4 g4 = make_float4(nwq.x * (1.f + scq.x), nwq.y * (1.f + scq.y), nwq.z * (1.f + scq.z), nwq.w * (1.f + scq.w)), sh = shq;
            __syncthreads();
#pragma unroll
            for (int r = 0; r < 8; ++r) {
                const f32x4 xv = xq[r];
                float4 hv; hv.x = xv.x * rstd[r] * g4.x + sh.x; hv.y = xv.y * rstd[r] * g4.y + sh.y; hv.z = xv.z * rstd[r] * g4.z + sh.z; hv.w = xv.w * rstd[r] * g4.w + sh.w;
                *(unsigned*)(p.H8 + (size_t)(row0 + r) * D_ + kb) = pk4_fp8(hv.x, hv.y, hv.z, hv.w);
                *(float4*)(hsl + (wave * 8 + r) * HP + lane * 4) = hv;
            }
#pragma unroll
            for (int j = 0; j < 8; ++j) *(f32x4*)(Bs + (bk0 + j * 32) * NEXP + bdq) = bq[j];
            if (sl + 1 < 8) P8_PREFETCH(sl + 1)
            __syncthreads();
            const float* ap = hsl + (rt * 16 + fr) * HP + fq;
            const float* b0p = Bs + fq * NEXP + ((eh * 32 + fr) ^ (fq * 16));
            const float* b1p = Bs + fq * NEXP + ((eh * 32 + 16 + fr) ^ (fq * 16));
#pragma unroll 16
            for (int k4 = 0; k4 < 64; ++k4) {
                const float av = ap[k4 * 4];
                const float b0 = b0p[k4 * 4 * NEXP], b1 = b1p[k4 * 4 * NEXP];
                lacc[0] = __builtin_amdgcn_mfma_f32_16x16x4f32(av, b0, lacc[0], 0, 0, 0);
                lacc[1] = __builtin_amdgcn_mfma_f32_16x16x4f32(av, b1, lacc[1], 0, 0, 0);
            }
        }
#pragma unroll
        for (int nt = 0; nt < 2; ++nt)
#pragma unroll
            for (int jj = 0; jj < 4; ++jj) lg[(rt * 16 + fq * 4 + jj) * 65 + eh * 32 + nt * 16 + fr] = lacc[nt][jj];
        int* lcnt = (int*)(dynlds + CTRL_OFF + 64); int* lbase = lcnt + 64;
        __syncthreads();
        if (tid < 64) lcnt[tid] = 0;
        __syncthreads();
        unsigned long long selm[8]; int lrank[8]; float gwr[8];
#pragma unroll
        for (int r = 0; r < 8; ++r) {
            selm[r] = route_row(lg[(wave * 8 + r) * 65 + lane], rbias, lane, &gwr[r]);
            lrank[r] = 0;
            if ((selm[r] >> lane) & 1ull) lrank[r] = atomicAdd(lcnt + lane, 1);
        }
        __syncthreads();
        if (tid < 64) lbase[tid] = (int)atomicAdd(p.cnt + tid * 64, (unsigned)lcnt[tid]);
        __syncthreads();
        const int mybase = lbase[lane];
#pragma unroll
        for (int r = 0; r < 8; ++r) {
            if ((selm[r] >> lane) & 1ull) {
                const int kidx = __popcll(selm[r] & ((1ull << lane) - 1ull));
                const unsigned slot = (unsigned)(row0 + r) * NSLOT + kidx;
                p.list[(size_t)lane * LIST_CAP + mybase + lrank[r]] = slot;
                p.gw[(size_t)lane * LIST_CAP + mybase + lrank[r]] = gwr[r];
            }
        }
    }
}

__device__ __forceinline__ int build_tile_table(const Params& p, int* tstart) {
    __syncthreads();
    if (threadIdx.x == 0) {
        int s = 0;
        for (int e = 0; e < NEXP; ++e) { tstart[e] = s; s += ((int)p.cnt[e * 64] + 255) >> 8; }
        tstart[NEXP] = s;
    }
    __syncthreads();
    return tstart[NEXP];
}

__device__ __forceinline__ void phase_moe_up(const Params& p) {
    int* s_tstart = (int*)(dynlds + CTRL_OFF + 64);
    const int R = build_tile_table(p, s_tstart);
    const int nunits = (R + T_ / 256) * 4;
    const int tid = opaque_tid();
    int R0, C0, R1, C1; stage_rc(tid * 16, R0, C0); stage_rc(tid * 16 + 8192, R1, C1);
    int e = 0;
    for (int u = blockIdx.x; u < nunits; u += gridDim.x) {
        const int mt = u >> 2, nt = u & 3;
        unsigned aoff[4]; const fp8_t* Bt;
        if (mt < R) {
            while (s_tstart[e + 1] <= mt) ++e;
            const int r0 = (mt - s_tstart[e]) * 256, cnt = (int)p.cnt[e * 64];
            const unsigned* lst = p.list + (size_t)e * LIST_CAP;
            const int lr[4] = {R0, R1, 128 + R0, 128 + R1}; const int lc[4] = {C0, C1, C0, C1};
#pragma unroll
            for (int q = 0; q < 4; ++q) { const int rr = r0 + lr[q]; const unsigned v = lst[rr < LIST_CAP ? rr : LIST_CAP - 1]; const unsigned tok = rr < cnt ? v / NSLOT : 0u; aoff[q] = tok * D_ + lc[q] * 2; }
            Bt = p.We1q + (size_t)e * 1024 * D_ + (size_t)nt * 256 * D_;
        } else {
            dense_aoff(aoff, (mt - R) * 256, D_);
            Bt = p.Ws1q + (size_t)nt * 256 * D_;
        }
        EpiGateUp epi{p.actq, (size_t)mt * 256, nt * 128};
        gemm_unit<true>(p.H8, aoff, Bt, D_, epi);
    }
}

__device__ __forceinline__ void phase_moe_down(const Params& p) {
    int* s_tstart2 = (int*)(dynlds + CTRL_OFF + 64);
    const int R = build_tile_table(p, s_tstart2);
    const int nunits = (R + T_ / 256) * 8;
    int e = 0;
    bool staged = false;
    for (int u = blockIdx.x; u < nunits; u += gridDim.x) {
        const int mt = u >> 3, nt = u & 7;
        unsigned aoff[4]; dense_aoff(aoff, 0, EFF);
        if (mt < R) { while (s_tstart2[e + 1] <= mt) ++e; }
        const int un = u + gridDim.x, mtn = un >> 3, ntn = un & 7; const bool has_next = un < nunits;
        int en = e;
        if (has_next && mtn < R) { while (s_tstart2[en + 1] <= mtn) ++en; }
        const fp8_t* nA = p.actq + (size_t)mtn * 256 * EFF;
        const fp8_t* nB = (mtn < R) ? p.We2q + (size_t)en * D_ * EFF + (size_t)ntn * 256 * EFF : p.Ws2q + (size_t)ntn * 256 * EFF;
        const fp8_t* cA = p.actq + (size_t)mt * 256 * EFF;
        if (mt < R) {
            const int r0 = (mt - s_tstart2[e]) * 256;
            EpiDownRouted<true> epi{p.slot, p.list + (size_t)e * LIST_CAP, p.gw + (size_t)e * LIST_CAP, r0, (int)p.cnt[e * 64], nt * 256};
            gemm_unit_pre<true, 8>(cA, aoff, p.We2q + (size_t)e * D_ * EFF + (size_t)nt * 256 * EFF, EFF, epi, staged, has_next, nA, nB);
        } else {
            EpiDownRouted<false> epi{p.slot, nullptr, p.gw, (mt - R) * 256, T_, nt * 256};
            gemm_unit_pre<true, 8>(cA, aoff, p.Ws2q + (size_t)nt * 256 * EFF, EFF, epi, staged, has_next, nA, nB);
        }
        staged = has_next;
    }
}

__device__ __forceinline__ void phase_final(const Params& p) {
    for (int it = blockIdx.x * NTHREADS + opaque_tid(); it < T_ * (D_ / 8); it += gridDim.x * NTHREADS) {
        const int t = it >> 8, c = (it & 255) * 8;
        float acc[8];
#pragma unroll
        for (int j = 0; j < 8; ++j) acc[j] = 0.f;
#pragma unroll
        for (int k = 0; k < NSLOT; ++k) {
            const u32x2 w = *(const u32x2*)(p.slot + ((size_t)t * NSLOT + k) * D_ + c);
            const f32x2 a0 = __builtin_amdgcn_cvt_pk_f32_fp8(w.x, false), a1 = __builtin_amdgcn_cvt_pk_f32_fp8(w.x, true), a2 = __builtin_amdgcn_cvt_pk_f32_fp8(w.y, false), a3 = __builtin_amdgcn_cvt_pk_f32_fp8(w.y, true);
            acc[0] += a0.x; acc[1] += a0.y; acc[2] += a1.x; acc[3] += a1.y; acc[4] += a2.x; acc[5] += a2.y; acc[6] += a3.x; acc[7] += a3.y;
        }
#pragma unroll
        for (int j = 0; j < 8; ++j) acc[j] *= (1.0f / SLOT_SCALE);
        const float* gate = p.mod + (t >> 12) * 12288 + 10240 + c;
        const f32x4 g0 = *(const f32x4*)gate, g1 = *(const f32x4*)(gate + 4);
        float* op = p.out + (size_t)t * D_ + c;
        const f32x4 x0 = *(const f32x4*)op, x1 = *(const f32x4*)(op + 4);
        *(f32x4*)op = x0 + g0 * (f32x4){acc[0], acc[1], acc[2], acc[3]};
        *(f32x4*)(op + 4) = x1 + g1 * (f32x4){acc[4], acc[5], acc[6], acc[7]};
    }
}

constexpr int N_PHASES = 12;
__global__ void __launch_bounds__(NTHREADS, 2) fwd_kernel(Params p) {
    LAS unsigned* xbw = (LAS unsigned*)(dynlds + CTRL_OFF);
    if (threadIdx.x == 0) { xbw[0] = 0u; xbw[1] = 0u; xbw[2] = 0u; xbw[3] = 0u; }
    __syncthreads();
    const int lo = (int)p.ph_lo, hi = (int)p.ph_hi;
    const bool multi = (hi - lo) > 1;
    XcdBarrier bar; bar.bar = p.bar; bar.x = 0; bar.st = (volatile LAS unsigned*)xbw;
    if (multi) bar = xcd_barrier_post(p.bar, (volatile LAS unsigned*)xbw);
#ifdef ONLY_PHASE
#define PHASE(k, call) if ((k) == ONLY_PHASE) { if (lo <= (k) && (k) < hi) { call; if ((k) + 1 < hi) xcd_barrier(bar); } }
#else
#define PHASE(k, call) if (lo <= (k) && (k) < hi) { call; if (DUP_PHASE == (k)) { xcd_barrier(bar); call; } if ((k) + 1 < hi) xcd_barrier(bar); }
#endif
    PHASE(0, phase_prologue(p))
    PHASE(1, phase_norm1(p))
    PHASE(2, phase_gemm_in(p))
    PHASE(3, phase_prep(p))
    PHASE(4, phase_gemm_lora(p))
    PHASE(5, phase_mix(p))
    PHASE(6, phase_combine(p))
    PHASE(7, phase_gemm_out(p))
    PHASE(8, phase_norm2_router(p))
    PHASE(9, phase_moe_up(p))
    PHASE(10, phase_moe_down(p))
    PHASE(11, phase_final(p))
#undef PHASE
}

static inline size_t al256(size_t x) { return (x + 255) & ~(size_t)255; }

extern "C" void kernel_launch(void* const* d_in, const int* in_sizes, int n_in, void* d_out, int out_size, void* d_ws, size_t ws_size, hipStream_t stream) {
    static int grid = 0;
    size_t off = 0;
    const size_t o_bar = off;   off = al256(off + XCD_BAR_WORDS * 4);
    const size_t o_mod = off;   off = al256(off + (size_t)NB_ * 12288 * 4);
    const size_t o_cnt = off;   off = al256(off + NEXP * 256 + 256);
    const size_t o_lbias = off; off = al256(off + 4 * DR_ * 4);
    const size_t o_wlora = off; off = al256(off + (size_t)5120 * 512 * 2);
    const size_t zero_end = off;
    const size_t o_we1 = off;   off = al256(off + (size_t)NEXP * 1024 * D_ * 2);
    const size_t o_we2 = off;   off = al256(off + (size_t)NEXP * D_ * EFF * 2);
    const size_t o_ws1 = off;   off = al256(off + (size_t)1024 * D_ * 2);
    const size_t o_ws2 = off;   off = al256(off + (size_t)D_ * EFF * 2);
    const size_t o_h = off;     off = al256(off + (size_t)T_ * D_ * 2);
    const size_t o_ssq = off;   off = al256(off + (size_t)T_ * 32 * 4);
    const size_t arena = off;
    size_t m = arena;
    const size_t o_win = m;   m = al256(m + (size_t)NPROJ * D_ * 2);
    const size_t o_wout = m;  m = al256(m + (size_t)D_ * D_ * 2);
    const size_t o_proj = m;  m = al256(m + (size_t)T_ * NPROJ * 2);
    const size_t o_alora = m; m = al256(m + (size_t)T_ * 512 * 2);
    const size_t o_qn = m;    m = al256(m + (size_t)T_ * DR_ * 2);
    const size_t o_kn = m;    m = al256(m + (size_t)T_ * DR_ * 2);
    const size_t o_vt = m;    m = al256(m + (size_t)T_ * DR_ * 2);
    const size_t o_ycat = m;  m = al256(m + (size_t)T_ * D_ * 2);
    const size_t o_lo = m;    m = al256(m + (size_t)5 * T_ * DR_ * 2);
    size_t f = arena;
    const size_t o_slot = f;  f = al256(f + (size_t)T_ * NSLOT * D_ * 2);
    const size_t o_act = f;   f = al256(f + (size_t)(T_ * TOPK + NEXP * 256 + T_) * EFF * 2);
    const size_t o_list = f;  f = al256(f + (size_t)NEXP * LIST_CAP * 4);
    const size_t o_gw = f;    f = al256(f + (size_t)NEXP * LIST_CAP * 4);
    const size_t ws_need = m > f ? m : f;

    if (grid == 0) {
        if (n_in != 34 || out_size != T_ * D_ || ws_size < ws_need) { fprintf(stderr, "kernel_launch: unexpected problem (n_in %d, out %d, ws %zu, need %zu)\n", n_in, out_size, ws_size, ws_need); grid = -1; return; }
        int dev = 0, cus = 0;
        if (hipGetDevice(&dev) != hipSuccess || hipDeviceGetAttribute(&cus, hipDeviceAttributeMultiprocessorCount, dev) != hipSuccess) { grid = -1; return; }
        if (hipFuncSetAttribute((const void*)fwd_kernel, hipFuncAttributeMaxDynamicSharedMemorySize, DYN_LDS) != hipSuccess) { fprintf(stderr, "kernel_launch: hipFuncSetAttribute failed\n"); grid = -1; return; }
        int per_cu = 0;
        (void)hipOccupancyMaxActiveBlocksPerMultiprocessor(&per_cu, (const void*)fwd_kernel, NTHREADS, DYN_LDS);
        (void)hipGetLastError();
        if (per_cu < 1) fprintf(stderr, "kernel_launch: occupancy query reports %d blocks per CU\n", per_cu);
        grid = cus;
    }
    if (grid < 0) return;
    char* ws = (char*)d_ws;
    hipMemsetAsync(ws, 0, zero_end, stream);
    Params p{};
    const float* const* in = (const float* const*)d_in;
    p.x = in[0]; p.c = in[1]; p.w_ada = in[2]; p.b_ada = in[3]; p.norm1_w = in[4]; p.w_in = in[5]; p.rwkv_shift = in[6]; p.w0_f = in[7]; p.w_up_f = in[8];
    p.w0_b = in[9]; p.w_up_b = in[10]; p.a0_f = in[11]; p.a_up_f = in[12]; p.a0_b = in[13]; p.a_up_b = in[14]; p.g_up = in[15]; p.k_k = in[16]; p.k_a = in[17];
    p.r_k = in[18]; p.ln_w = in[19]; p.ln_b = in[20]; p.qn_w = in[21]; p.kn_w = in[22]; p.rel_bias = in[23]; p.w_out = in[24]; p.norm2_w = in[25];
    p.w_router = in[26]; p.router_bias = in[27]; p.w_gate_e = in[28]; p.w_up_e = in[29]; p.w_down_e = in[30]; p.w_gate_s = in[31]; p.w_up_s = in[32]; p.w_down_s = in[33];
    p.out = (float*)d_out;
    p.bar = (unsigned*)(ws + o_bar); p.mod = (float*)(ws + o_mod); p.cnt = (unsigned*)(ws + o_cnt); p.qctr = p.cnt + NEXP * 64; p.lbias = (float*)(ws + o_lbias);
    p.Wlora = (bf16_t*)(ws + o_wlora); p.We1q = (fp8_t*)(ws + o_we1); p.We2q = (fp8_t*)(ws + o_we2); p.Ws1q = (fp8_t*)(ws + o_ws1); p.Ws2q = (fp8_t*)(ws + o_ws2); p.H8 = (fp8_t*)(ws + o_h);
    p.H = (bf16_t*)(ws + o_h); p.Win = (bf16_t*)(ws + o_win); p.Wout = (bf16_t*)(ws + o_wout); p.proj = (bf16_t*)(ws + o_proj); p.LO = (bf16_t*)(ws + o_lo);
    p.Alora = (bf16_t*)(ws + o_alora); p.QN = (bf16_t*)(ws + o_qn); p.KN = (bf16_t*)(ws + o_kn); p.VT = (bf16_t*)(ws + o_vt); p.ycat = (bf16_t*)(ws + o_ycat);
    p.rb = (bf16_t*)d_out; p.kb = p.rb + (size_t)T_ * DR_; p.vb = p.kb + (size_t)T_ * DR_; p.kkb = p.vb + (size_t)T_ * DR_;
    p.slot = (fp8_t*)(ws + o_slot); p.actq = (fp8_t*)(ws + o_act); p.list = (unsigned*)(ws + o_list); p.gw = (float*)(ws + o_gw);
    p.ssq = (float*)(ws + o_ssq);
#if N_LAUNCH_SPLIT
    for (int k = 0; k < N_PHASES; ++k) {
        p.ph_lo = k; p.ph_hi = k + 1;
        hipLaunchKernelGGL(fwd_kernel, dim3(grid), dim3(NTHREADS), DYN_LDS, stream, p);
    }
#else
    p.ph_lo = 0; p.ph_hi = N_PHASES;
    hipLaunchKernelGGL(fwd_kernel, dim3(grid), dim3(NTHREADS), DYN_LDS, stream, p);
#endif
    (void)in_sizes;
}
```

```cpp
#include <hip/hip_runtime.h>
#include <stdint.h>
#include <stdio.h>

#ifndef DUP_PHASE
#define DUP_PHASE -1
#endif
#ifndef N_LAUNCH_SPLIT
#define N_LAUNCH_SPLIT 0
#endif

typedef unsigned short bf16_t;
typedef short bf16x8 __attribute__((ext_vector_type(8)));
typedef float f32x4 __attribute__((ext_vector_type(4)));
typedef unsigned u32x2 __attribute__((ext_vector_type(2)));
typedef int i32x4 __attribute__((ext_vector_type(4)));
typedef unsigned u32x4 __attribute__((ext_vector_type(4)));
typedef int i32x8 __attribute__((ext_vector_type(8)));
typedef unsigned char fp8_t;
typedef float f32x2 __attribute__((ext_vector_type(2)));
#define LAS __attribute__((address_space(3)))

constexpr int T_ = 16384, SEQ_ = 4096, NB_ = 4, D_ = 2048, DR_ = 1024;
constexpr int NPROJ = 6656;
constexpr int RWKV_IN_ = 3488;
constexpr int PC_R = 0, PC_K = 1024, PC_V = 2048, PC_L = 3072, PC_Q = 3584, PC_KN = 4608, PC_VN = 5632;
constexpr int NEXP = 64, TOPK = 6, EFF = 512, NSLOT = 7;
constexpr int LIST_CAP = 16384;
constexpr int NTHREADS = 512;
constexpr int GEMM_LDS = 131072;
constexpr int CTRL_OFF = 17 * 9216;
constexpr int DYN_LDS = CTRL_OFF + 1024;

#define XB_TMO      128
#define XB_XCNT(j)  (256  + 64 * (j))
#define XB_XSUB(j)  (1280 + 64 * (j))
#define XB_XGEN(j)  (2304 + 64 * (j))
#define XB_TOP      3328
#define XB_TOPGEN   3392
#define XCD_BAR_WORDS 3456
#define XB_SPIN_CAP (1u << 18)

__device__ __forceinline__ unsigned xb_ld(unsigned* p)              { return __hip_atomic_load(p, __ATOMIC_RELAXED, __HIP_MEMORY_SCOPE_AGENT); }
__device__ __forceinline__ unsigned xb_add(unsigned* p, unsigned v) { return __hip_atomic_fetch_add(p, v, __ATOMIC_RELAXED, __HIP_MEMORY_SCOPE_AGENT); }
__device__ __forceinline__ unsigned xb_xcc_id() { return (unsigned)__builtin_amdgcn_s_getreg((3 << 11) | 20) & 0xFu; }
#define XB_SPIN(cond, bar) do { unsigned _sp = 0; while (cond) { __builtin_amdgcn_s_sleep(1); \
    if ((++_sp & 255u) == 0u) { if (xb_ld(&(bar)[XB_TMO])) break; if (_sp > XB_SPIN_CAP) { atomicAdd(&(bar)[XB_TMO], 1u); break; } } } } while (0)

struct XcdBarrier { unsigned* bar; unsigned x; volatile LAS unsigned* st; };

__device__ __forceinline__ XcdBarrier xcd_barrier_post(unsigned* bar, volatile LAS unsigned* st) {
    XcdBarrier b; b.bar = bar; b.x = xb_xcc_id(); b.st = st;
    if (threadIdx.x == 0) (void)xb_add(&bar[XB_XCNT(b.x)], 1u);
    return b;
}
__device__ __forceinline__ void xcd_barrier_complete(unsigned* bar, unsigned x, unsigned& nloc, unsigned& nx) {
    const unsigned G = gridDim.x * gridDim.y * gridDim.z;
    unsigned sum, cnt, mine, sp = 0u;
    for (;;) {
        sum = 0u; cnt = 0u; mine = 0u;
#pragma unroll
        for (unsigned j = 0; j < 16; ++j) { const unsigned c = xb_ld(&bar[XB_XCNT(j)]); sum += c; cnt += (c > 0u) ? 1u : 0u; mine = (j == x) ? c : mine; }
        if (sum == G) break;
        __builtin_amdgcn_s_sleep(1);
        if ((++sp & 255u) == 0u) { if (xb_ld(&bar[XB_TMO])) break; if (sp > XB_SPIN_CAP) { atomicAdd(&bar[XB_TMO], 1u); break; } }
    }
    nloc = mine > 0u ? mine : 1u; nx = cnt > 0u ? cnt : 1u;
}
__device__ __forceinline__ void xcd_barrier(const XcdBarrier& b) {
    asm volatile("s_waitcnt vmcnt(0)" ::: "memory");
    __syncthreads();
    if (threadIdx.x == 0) {
        unsigned* bar = b.bar;
        __builtin_amdgcn_s_waitcnt(0);
        unsigned nloc = b.st[0], nx = b.st[1];
        if (nloc == 0u) { xcd_barrier_complete(bar, b.x, nloc, nx); b.st[0] = nloc; b.st[1] = nx; }
        const unsigned old = xb_add(&bar[XB_XSUB(b.x)], 1u);
        const unsigned gen = old / nloc;
        if (old + 1u == (gen + 1u) * nloc) {
            __builtin_amdgcn_fence(__ATOMIC_RELEASE, "agent");
            asm volatile("s_waitcnt vmcnt(0)" ::: "memory");
            const unsigned og = xb_add(&bar[XB_TOP], 1u);
            const unsigned tg = og / nx;
            if (og + 1u == (tg + 1u) * nx) xb_add(&bar[XB_TOPGEN], 1u);
            else XB_SPIN(xb_ld(&bar[XB_TOPGEN]) == tg, bar);
            __builtin_amdgcn_fence(__ATOMIC_ACQUIRE, "agent");
            xb_add(&bar[XB_XGEN(b.x)], 1u);
            asm volatile("s_waitcnt vmcnt(0)" ::: "memory");
        } else {
            XB_SPIN(xb_ld(&bar[XB_XGEN(b.x)]) == gen, bar);
            __builtin_amdgcn_fence(__ATOMIC_ACQUIRE, "agent");
            asm volatile("s_waitcnt vmcnt(0)" ::: "memory");
        }
    }
    __syncthreads();
}

struct Params {
    const float *x, *c, *w_ada, *b_ada, *norm1_w, *w_in, *rwkv_shift, *w0_f, *w_up_f, *w0_b, *w_up_b, *a0_f, *a_up_f, *a0_b, *a_up_b,
                *g_up, *k_k, *k_a, *r_k, *ln_w, *ln_b, *qn_w, *kn_w, *rel_bias, *w_out, *norm2_w, *w_router, *router_bias,
                *w_gate_e, *w_up_e, *w_down_e, *w_gate_s, *w_up_s, *w_down_s;
    float* out;
    unsigned* bar; float* mod; unsigned* cnt; float* lbias; unsigned* qctr;
    bf16_t *Wlora, *H, *Win, *Wout, *proj, *Alora, *QN, *KN, *VT, *ycat, *LO;
    fp8_t *We1q, *We2q, *Ws1q, *Ws2q, *H8, *actq;
    bf16_t *rb, *kb, *vb, *kkb;
    fp8_t *slot; unsigned* list; float* gw;
    float* ssq;
    long long ph_lo, ph_hi;
};

extern __shared__ __attribute__((aligned(16))) char dynlds[];

__device__ __forceinline__ int opaque_tid() { int t = threadIdx.x; asm volatile("" : "+v"(t)); return t; }
typedef __bf16 bf16x2_t __attribute__((ext_vector_type(2)));
__device__ __forceinline__ unsigned pk2(float lo, float hi) { bf16x2_t v = {(__bf16)lo, (__bf16)hi}; return __builtin_bit_cast(unsigned, v); }
__device__ __forceinline__ float bflo(unsigned u) { return __uint_as_float(u << 16); }
__device__ __forceinline__ float bfhi(unsigned u) { return __uint_as_float(u & 0xffff0000u); }
__device__ __forceinline__ void unpack8(const uint4& u, float (&f)[8]) {
    f[0] = bflo(u.x); f[1] = bfhi(u.x); f[2] = bflo(u.y); f[3] = bfhi(u.y); f[4] = bflo(u.z); f[5] = bfhi(u.z); f[6] = bflo(u.w); f[7] = bfhi(u.w);
}
__device__ __forceinline__ u32x4 pack8v(const float (&f)[8]) { u32x4 r; r.x = pk2(f[0], f[1]); r.y = pk2(f[2], f[3]); r.z = pk2(f[4], f[5]); r.w = pk2(f[6], f[7]); return r; }
__device__ __forceinline__ uint4 pack8(const float (&f)[8]) { uint4 r; r.x = pk2(f[0], f[1]); r.y = pk2(f[2], f[3]); r.z = pk2(f[4], f[5]); r.w = pk2(f[6], f[7]); return r; }
__device__ __forceinline__ float clamp448(float x) { return fminf(fmaxf(x, -448.0f), 448.0f); }
__device__ __forceinline__ unsigned pk4_fp8(float a, float b, float c, float d) {
    int w = 0;
    w = __builtin_amdgcn_cvt_pk_fp8_f32(clamp448(a), clamp448(b), w, false);
    w = __builtin_amdgcn_cvt_pk_fp8_f32(clamp448(c), clamp448(d), w, true);
    return (unsigned)w;
}
template <int CTRL> __device__ __forceinline__ float dppf(float x) { return __builtin_bit_cast(float, __builtin_amdgcn_mov_dpp(__builtin_bit_cast(int, x), CTRL, 0xf, 0xf, true)); }
__device__ __forceinline__ float red8_sum(float v)  { v += dppf<0xB1>(v); v += dppf<0x4E>(v); v += dppf<0x141>(v); return v; }
__device__ __forceinline__ float red16_sum(float v) { v += dppf<0xB1>(v); v += dppf<0x4E>(v); v += dppf<0x141>(v); v += dppf<0x128>(v); return v; }
__device__ __forceinline__ float red8_max(float v)  { v = fmaxf(v, dppf<0xB1>(v)); v = fmaxf(v, dppf<0x4E>(v)); v = fmaxf(v, dppf<0x141>(v)); return v; }
__device__ __forceinline__ float red16_max(float v) { v = fmaxf(v, dppf<0xB1>(v)); v = fmaxf(v, dppf<0x4E>(v)); v = fmaxf(v, dppf<0x141>(v)); v = fmaxf(v, dppf<0x128>(v)); return v; }
__device__ __forceinline__ float wave_sum(float v) {
#pragma unroll
    for (int o = 1; o < 64; o <<= 1) v += __shfl_xor(v, o);
    return v;
}
__device__ __forceinline__ float wave_max(float v) {
#pragma unroll
    for (int o = 1; o < 64; o <<= 1) v = fmaxf(v, __shfl_xor(v, o));
    return v;
}
__device__ __forceinline__ float sigmoidf_(float x) { return 1.0f / (1.0f + __expf(-x)); }

constexpr int BK = 64, HALF = 128, HTB = HALF * BK * 2;
__device__ __forceinline__ int lds_byte(int r, int c) {
    int st = (r >> 4) * 2 + (c >> 5), rr = r & 15, cc = c & 31, ob = rr * 64 + cc * 2;
    return st * 1024 + (ob ^ (((ob >> 9) & 1) << 5));
}
__device__ __forceinline__ void stage_rc(int b, int& R, int& C) {
    int st = b / 1024, sb = b % 1024, swz = sb ^ (((sb >> 9) & 1) << 5);
    R = (st >> 1) * 16 + swz / 64; C = (st & 1) * 32 + (swz % 64) / 2;
}

#define G_SA(b, h) (((b) * 4 + (h)) * HTB)
#define G_SB(b, h) (((b) * 4 + 2 + (h)) * HTB)
#define G_STAGE(bufoff, gbase, v0, v1) do { \
    __builtin_amdgcn_global_load_lds((const unsigned*)((const char*)(gbase) + (v0)), (LAS unsigned*)(lds + (bufoff) + ldsw), 16, 0, 0); \
    __builtin_amdgcn_global_load_lds((const unsigned*)((const char*)(gbase) + (v1)), (LAS unsigned*)(lds + (bufoff) + ldsw + 8192), 16, 0, 0); } while (0)
#define G_STAGE_A(b, h, kt) G_STAGE(G_SA(b, h), Ab + (size_t)(kt) * (BK * 2), va[(h) * 2], va[(h) * 2 + 1])
#define G_STAGE_B(b, h, kt) G_STAGE(G_SB(b, h), Bb + (size_t)(h) * hstep + (size_t)(kt) * (BK * 2), vb0, vb1)
#define G_LD8(base) __builtin_shufflevector(*(const LAS i32x4*)(lds + (base)), *(const LAS i32x4*)(lds + (base) + 1024), 0, 1, 2, 3, 4, 5, 6, 7)
#define G_LDA(dst, b, h) do { _Pragma("unroll") for (int m = 0; m < 4; ++m) dst[m] = G_LD8(G_SA(b, h) + laoff + m * 2048); } while (0)
#define G_LDB(dst, b, h) do { _Pragma("unroll") for (int n = 0; n < 2; ++n) dst[n] = G_LD8(G_SB(b, h) + lboff + n * 2048); } while (0)
#define G_LO(v) __builtin_bit_cast(bf16x8, __builtin_shufflevector(v, v, 0, 1, 2, 3))
#define G_HI(v) __builtin_bit_cast(bf16x8, __builtin_shufflevector(v, v, 4, 5, 6, 7))
#define G_MMA(ai, bj, Af, Bf) do { __builtin_amdgcn_s_setprio(1); \
    if (FP8) { \
      _Pragma("unroll") for (int m = 0; m < 4; ++m) _Pragma("unroll") for (int n = 0; n < 2; ++n) \
        asm volatile("v_mfma_f32_16x16x128_f8f6f4 %0, %1, %2, %0" : "+v"(acc[ai][bj][m][n]) : "v"(Bf[n]), "v"(Af[m])); \
    } else { \
      _Pragma("unroll") for (int m = 0; m < 4; ++m) _Pragma("unroll") for (int n = 0; n < 2; ++n) { \
        acc[ai][bj][m][n] = __builtin_amdgcn_mfma_f32_16x16x32_bf16(G_LO(Bf[n]), G_LO(Af[m]), acc[ai][bj][m][n], 0, 0, 0); \
        acc[ai][bj][m][n] = __builtin_amdgcn_mfma_f32_16x16x32_bf16(G_HI(Bf[n]), G_HI(Af[m]), acc[ai][bj][m][n], 0, 0, 0); } } \
    __builtin_amdgcn_s_setprio(0); } while (0)
#define G_WAIT_V(n) asm volatile("s_waitcnt vmcnt(" #n ")" ::: "memory")
#define G_WAIT_L(n) asm volatile("s_waitcnt lgkmcnt(" #n ")" ::: "memory")
#define G_BAR __builtin_amdgcn_s_barrier()
#define G_SCHED __builtin_amdgcn_sched_barrier(0)

__device__ __forceinline__ int gemm_stage_row(int tid, int i) { int R, C; stage_rc(tid * 16 + i * 8192, R, C); return R; }
__device__ __forceinline__ int gemm_stage_col(int tid, int i) { int R, C; stage_rc(tid * 16 + i * 8192, R, C); return C; }

template <bool FP8, class Epi>
__device__ __forceinline__ void gemm_unit(const void* __restrict__ A, const unsigned (&aoffb)[4], const void* __restrict__ Bt, const int PITCH, const Epi& epi, const int NT = 0) {
    LAS unsigned char* lds = (LAS unsigned char*)dynlds;
    const int tid = opaque_tid();
    const int wid = __builtin_amdgcn_readfirstlane(tid >> 6), lane = tid & 63, wr = wid >> 2, wc = wid & 3, fr = lane & 15, fq = lane >> 4;
    const unsigned va[4] = {aoffb[0], aoffb[1], aoffb[2], aoffb[3]};
    unsigned vb0, vb1;
    { int R0, C0, R1, C1; stage_rc(tid * 16, R0, C0); stage_rc(tid * 16 + 8192, R1, C1); vb0 = (unsigned)(R0 * PITCH + C0 * 2); vb1 = (unsigned)(R1 * PITCH + C1 * 2); }
    const char* Ab = (const char*)A; const char* Bb = (const char*)Bt;
    const size_t hstep = (size_t)HALF * PITCH;
    const unsigned ldsw = (unsigned)wid * 1024u;
    const int laoff = lds_byte(wr * 64 + fr, fq * 8), lboff = lds_byte(wc * 32 + fr, fq * 8);
    f32x4 acc[2][2][4][2];
#pragma unroll
    for (int a = 0; a < 2; ++a)
#pragma unroll
        for (int b = 0; b < 2; ++b)
#pragma unroll
            for (int m = 0; m < 4; ++m)
#pragma unroll
                for (int n = 0; n < 2; ++n) acc[a][b][m][n] = (f32x4){0.f, 0.f, 0.f, 0.f};
    i32x8 At[4], B0[2], B1[2];
    const int nt = NT ? NT : PITCH / (BK * 2);
    __syncthreads();
    G_STAGE_B(0, 0, 0); G_STAGE_A(0, 0, 0); G_STAGE_B(0, 1, 0); G_STAGE_A(0, 1, 0);
    if (wr == 1) G_BAR;
    G_WAIT_V(4); G_BAR;
    G_STAGE_B(1, 0, 1); G_STAGE_A(1, 0, 1); G_STAGE_B(1, 1, 1);
    G_WAIT_V(6); G_BAR;
    for (int t = 0; t < nt - 2; t += 2) {
        G_LDB(B0, 0, 0); G_SCHED; G_LDA(At, 0, 0); G_STAGE_A(1, 1, t + 1);
        G_WAIT_L(8); G_BAR; G_WAIT_L(0); G_MMA(0, 0, At, B0); G_BAR; G_SCHED;
        G_LDB(B1, 0, 1); G_STAGE_B(0, 0, t + 2);
        G_BAR; G_WAIT_L(0); G_MMA(0, 1, At, B1); G_BAR;
        G_LDA(At, 0, 1); G_STAGE_A(0, 0, t + 2);
        G_BAR; G_WAIT_L(0); G_MMA(1, 0, At, B0); G_BAR; G_SCHED;
        G_STAGE_B(0, 1, t + 2);
        G_WAIT_V(6); G_BAR; G_MMA(1, 1, At, B1); G_BAR;
        G_LDB(B0, 1, 0); G_SCHED; G_LDA(At, 1, 0); G_STAGE_A(0, 1, t + 2);
        G_WAIT_L(8); G_BAR; G_WAIT_L(0); G_MMA(0, 0, At, B0); G_BAR; G_SCHED;
        G_LDB(B1, 1, 1); G_STAGE_B(1, 0, t + 3);
        G_BAR; G_WAIT_L(0); G_MMA(0, 1, At, B1); G_BAR;
        G_LDA(At, 1, 1); G_STAGE_A(1, 0, t + 3);
        G_BAR; G_WAIT_L(0); G_MMA(1, 0, At, B0); G_BAR; G_SCHED;
        G_STAGE_B(1, 1, t + 3);
        G_WAIT_V(6); G_BAR; G_MMA(1, 1, At, B1); G_BAR;
    }
    { G_LDB(B0, 0, 0); G_WAIT_V(0); G_LDA(At, 0, 0); G_STAGE_A(1, 1, nt - 1);
      G_BAR; G_WAIT_L(0); G_MMA(0, 0, At, B0); G_BAR;
      G_LDB(B1, 0, 1); G_BAR; G_WAIT_L(0); G_MMA(0, 1, At, B1); G_BAR;
      G_LDA(At, 0, 1); G_WAIT_V(4); G_BAR; G_WAIT_L(0); G_MMA(1, 0, At, B0); G_MMA(1, 1, At, B1); G_BAR; }
    { G_LDB(B0, 1, 0); G_LDA(At, 1, 0); G_WAIT_V(2); G_BAR; G_WAIT_L(0); G_MMA(0, 0, At, B0); G_BAR;
      G_LDB(B1, 1, 1); G_WAIT_V(0); G_BAR; G_WAIT_L(0); G_MMA(0, 1, At, B1); G_BAR;
      G_LDA(At, 1, 1); G_BAR; G_WAIT_L(0); G_MMA(1, 0, At, B0); G_MMA(1, 1, At, B1); G_BAR; }
    if (wr == 0) G_BAR;
    if (FP8) asm volatile("s_nop 15\n\ts_nop 15" ::: "memory");
    {
        int tz = threadIdx.x; asm volatile("" : "+v"(tz));
        const int wid2 = tz >> 6, lane2 = tz & 63;
        epi(acc, wid2 >> 2, wid2 & 3, lane2 & 15, lane2 >> 4);
    }
    __syncthreads();
}

template <bool FP8, int EPI_STORES, class Epi>
__device__ __forceinline__ void gemm_unit_pre(const void* __restrict__ A, const unsigned (&aoffb)[4], const void* __restrict__ Bt, const int PITCH, const Epi& epi,
                                              const bool staged, const bool has_next, const void* __restrict__ nA, const void* __restrict__ nB) {
    constexpr int NT = 0;
    LAS unsigned char* lds = (LAS unsigned char*)dynlds;
    const int tid = opaque_tid();
    const int wid = __builtin_amdgcn_readfirstlane(tid >> 6), lane = tid & 63, wr = wid >> 2, wc = wid & 3, fr = lane & 15, fq = lane >> 4;
    const unsigned va[4] = {aoffb[0], aoffb[1], aoffb[2], aoffb[3]};
    unsigned vb0, vb1;
    { int R0, C0, R1, C1; stage_rc(tid * 16, R0, C0); stage_rc(tid * 16 + 8192, R1, C1); vb0 = (unsigned)(R0 * PITCH + C0 * 2); vb1 = (unsigned)(R1 * PITCH + C1 * 2); }
    const char* Ab = (const char*)A; const char* Bb = (const char*)Bt;
    const size_t hstep = (size_t)HALF * PITCH;
    const unsigned ldsw = (unsigned)wid * 1024u;
    const int laoff = lds_byte(wr * 64 + fr, fq * 8), lboff = lds_byte(wc * 32 + fr, fq * 8);
    f32x4 acc[2][2][4][2];
#pragma unroll
    for (int a = 0; a < 2; ++a)
#pragma unroll
        for (int b = 0; b < 2; ++b)
#pragma unroll
            for (int m = 0; m < 4; ++m)
#pragma unroll
                for (int n = 0; n < 2; ++n) acc[a][b][m][n] = (f32x4){0.f, 0.f, 0.f, 0.f};
    i32x8 At[4], B0[2], B1[2];
    const int nt = NT ? NT : PITCH / (BK * 2);
    if (!staged) {
        __syncthreads();
        G_STAGE_B(0, 0, 0); G_STAGE_A(0, 0, 0); G_STAGE_B(0, 1, 0); G_STAGE_A(0, 1, 0);
        if (wr == 1) G_BAR;
        G_WAIT_V(4); G_BAR;
    } else {
        static_assert(EPI_STORES == 8, "the counted wait below is written for 8 stores");
        if (wr == 1) G_BAR;
        G_WAIT_V(8); G_BAR;
    }
    G_STAGE_B(1, 0, 1); G_STAGE_A(1, 0, 1); G_STAGE_B(1, 1, 1);
    G_WAIT_V(6); G_BAR;
    for (int t = 0; t < nt - 2; t += 2) {
        G_LDB(B0, 0, 0); G_SCHED; G_LDA(At, 0, 0); G_STAGE_A(1, 1, t + 1);
        G_WAIT_L(8); G_BAR; G_WAIT_L(0); G_MMA(0, 0, At, B0); G_BAR; G_SCHED;
        G_LDB(B1, 0, 1); G_STAGE_B(0, 0, t + 2);
        G_BAR; G_WAIT_L(0); G_MMA(0, 1, At, B1); G_BAR;
        G_LDA(At, 0, 1); G_STAGE_A(0, 0, t + 2);
        G_BAR; G_WAIT_L(0); G_MMA(1, 0, At, B0); G_BAR; G_SCHED;
        G_STAGE_B(0, 1, t + 2);
        G_WAIT_V(6); G_BAR; G_MMA(1, 1, At, B1); G_BAR;
        G_LDB(B0, 1, 0); G_SCHED; G_LDA(At, 1, 0); G_STAGE_A(0, 1, t + 2);
        G_WAIT_L(8); G_BAR; G_WAIT_L(0); G_MMA(0, 0, At, B0); G_BAR; G_SCHED;
        G_LDB(B1, 1, 1); G_STAGE_B(1, 0, t + 3);
        G_BAR; G_WAIT_L(0); G_MMA(0, 1, At, B1); G_BAR;
        G_LDA(At, 1, 1); G_STAGE_A(1, 0, t + 3);
        G_BAR; G_WAIT_L(0); G_MMA(1, 0, At, B0); G_BAR; G_SCHED;
        G_STAGE_B(1, 1, t + 3);
        G_WAIT_V(6); G_BAR; G_MMA(1, 1, At, B1); G_BAR;
    }
    { G_LDB(B0, 0, 0); G_WAIT_V(0); G_LDA(At, 0, 0); G_STAGE_A(1, 1, nt - 1);
      G_BAR; G_WAIT_L(0); G_MMA(0, 0, At, B0); G_BAR;
      G_LDB(B1, 0, 1); G_BAR; G_WAIT_L(0); G_MMA(0, 1, At, B1); G_BAR;
      G_LDA(At, 0, 1); G_WAIT_V(4); G_BAR; G_WAIT_L(0); G_MMA(1, 0, At, B0); G_MMA(1, 1, At, B1); G_BAR; }
    { G_LDB(B0, 1, 0); G_LDA(At, 1, 0); G_WAIT_V(2); G_BAR; G_WAIT_L(0); G_MMA(0, 0, At, B0); G_BAR;
      G_LDB(B1, 1, 1); G_WAIT_V(0); G_BAR; G_WAIT_L(0); G_MMA(0, 1, At, B1); G_BAR;
      G_LDA(At, 1, 1); G_BAR; G_WAIT_L(0); G_MMA(1, 0, At, B0); G_MMA(1, 1, At, B1); G_BAR; }
    if (wr == 0) G_BAR;
    if (FP8) asm volatile("s_nop 15\n\ts_nop 15" ::: "memory");
    {
        int tz = threadIdx.x; asm volatile("" : "+v"(tz));
        const int wid2 = tz >> 6, lane2 = tz & 63;
        epi.stage(acc, wid2 >> 2, wid2 & 3, lane2 & 15, lane2 >> 4);
    }
    if (has_next) {
        const char* nAb = (const char*)nA; const char* nBb = (const char*)nB;
        int tz2 = threadIdx.x; asm volatile("" : "+v"(tz2));
        int R0, C0, R1, C1; stage_rc(tz2 * 16, R0, C0); stage_rc(tz2 * 16 + 8192, R1, C1);
        const unsigned o0 = (unsigned)(R0 * PITCH + C0 * 2), o1 = (unsigned)(R1 * PITCH + C1 * 2);
        const size_t hs = (size_t)HALF * PITCH;
        {
            const unsigned ldsw = (unsigned)(tz2 >> 6) * 1024u;
            G_STAGE(G_SB(0, 0), nBb, o0, o1); G_STAGE(G_SA(0, 0), nAb, o0, o1); G_STAGE(G_SB(0, 1), nBb + hs, o0, o1); G_STAGE(G_SA(0, 1), nAb + hs, o0, o1);
        }
    }
    epi.store();
    G_WAIT_L(0); G_BAR;
}


struct GUnit { const char* A; const char* B; int u0, u1, u2, u3; };
template <bool FP8, bool GATHER, class Sc>
__device__ __forceinline__ void gemm_stream(Sc& sc, const int PITCH, const int nt) {
    LAS unsigned char* lds = (LAS unsigned char*)dynlds;
    const int tid = opaque_tid();
    const int wid = __builtin_amdgcn_readfirstlane(tid >> 6), lane = tid & 63, wr = wid >> 2, wc = wid & 3, fr = lane & 15, fq = lane >> 4;
    unsigned vb0, vb1, vac[4], van[4];
    { int R0, C0, R1, C1; stage_rc(tid * 16, R0, C0); stage_rc(tid * 16 + 8192, R1, C1); vb0 = (unsigned)(R0 * PITCH + C0 * 2); vb1 = (unsigned)(R1 * PITCH + C1 * 2); }
    const size_t hstep = (size_t)HALF * PITCH, kstep = (size_t)(BK * 2);
    vac[0] = vb0; vac[1] = vb1; vac[2] = vb0 + (unsigned)hstep; vac[3] = vb1 + (unsigned)hstep;
    const unsigned ldsw = (unsigned)wid * 1024u;
    const int laoff = lds_byte(wr * 64 + fr, fq * 8), lboff = lds_byte(wc * 32 + fr, fq * 8);
    GUnit cur, nxt;
    if (!sc.next(0, cur, vac)) return;
    f32x4 acc[2][2][4][2];
#pragma unroll
    for (int a = 0; a < 2; ++a)
#pragma unroll
        for (int b = 0; b < 2; ++b)
#pragma unroll
            for (int m = 0; m < 4; ++m)
#pragma unroll
                for (int n = 0; n < 2; ++n) acc[a][b][m][n] = (f32x4){0.f, 0.f, 0.f, 0.f};
    i32x8 At[4], B0[2], B1[2];
    const char* cA = cur.A; const char* cB = cur.B;
#define S_STA(b, h, base, V) G_STAGE(G_SA(b, h), base, V[(h) * 2], V[(h) * 2 + 1])
#define S_STB(b, h, base) G_STAGE(G_SB(b, h), (base) + (size_t)(h) * hstep, vb0, vb1)
    __syncthreads();
    S_STB(0, 0, cB); S_STA(0, 0, cA, vac); S_STB(0, 1, cB); S_STA(0, 1, cA, vac);
    if (wr == 1) G_BAR;
    G_WAIT_V(4); G_BAR;
    S_STB(1, 0, cB + kstep); S_STA(1, 0, cA + kstep, vac); S_STB(1, 1, cB + kstep);
    G_WAIT_V(6); G_BAR;
    for (int ui = 0;; ++ui) {
        bool has_next;
        if (GATHER) has_next = sc.next(ui + 1, nxt, van); else { unsigned dummy[4]; has_next = sc.next(ui + 1, nxt, dummy); }
        const char* nA = has_next ? nxt.A : cA; const char* nB = has_next ? nxt.B : cB;
        if (GATHER && !has_next) { van[0] = vac[0]; van[1] = vac[1]; van[2] = vac[2]; van[3] = vac[3]; }
        for (int t = 0; t < nt; t += 2) {
            const bool last = (t == nt - 2);
            const char* a1 = cA + (size_t)(t + 1) * kstep;
            const char* a2 = last ? nA : cA + (size_t)(t + 2) * kstep; const char* b2 = last ? nB : cB + (size_t)(t + 2) * kstep;
            const char* a3 = a2 + kstep; const char* b3 = b2 + kstep;
            unsigned vx[4];
            if (GATHER) { vx[0] = last ? van[0] : vac[0]; vx[1] = last ? van[1] : vac[1]; vx[2] = last ? van[2] : vac[2]; vx[3] = last ? van[3] : vac[3]; }
            else { vx[0] = vac[0]; vx[1] = vac[1]; vx[2] = vac[2]; vx[3] = vac[3]; }
            G_LDB(B0, 0, 0); G_SCHED; G_LDA(At, 0, 0); S_STA(1, 1, a1, vac);
            G_WAIT_L(8); G_BAR; G_WAIT_L(0); G_MMA(0, 0, At, B0); G_BAR; G_SCHED;
            G_LDB(B1, 0, 1); S_STB(0, 0, b2);
            G_BAR; G_WAIT_L(0); G_MMA(0, 1, At, B1); G_BAR;
            G_LDA(At, 0, 1); S_STA(0, 0, a2, vx);
            G_BAR; G_WAIT_L(0); G_MMA(1, 0, At, B0); G_BAR; G_SCHED;
            S_STB(0, 1, b2);
            G_WAIT_V(6); G_BAR; G_MMA(1, 1, At, B1); G_BAR;
            G_LDB(B0, 1, 0); G_SCHED; G_LDA(At, 1, 0); S_STA(0, 1, a2, vx);
            G_WAIT_L(8); G_BAR; G_WAIT_L(0); G_MMA(0, 0, At, B0); G_BAR; G_SCHED;
            G_LDB(B1, 1, 1); S_STB(1, 0, b3);
            G_BAR; G_WAIT_L(0); G_MMA(0, 1, At, B1); G_BAR;
            G_LDA(At, 1, 1); S_STA(1, 0, a3, vx);
            G_BAR; G_WAIT_L(0); G_MMA(1, 0, At, B0); G_BAR; G_SCHED;
            S_STB(1, 1, b3);
            G_WAIT_V(6); G_BAR; G_MMA(1, 1, At, B1); G_BAR;
        }
        if (FP8) asm volatile("s_nop 15\n\ts_nop 15" ::: "memory");
        {
            int tz = threadIdx.x; asm volatile("" : "+v"(tz));
            const int wid2 = tz >> 6, lane2 = tz & 63;
            sc.epilogue(acc, cur, wid2 >> 2, wid2 & 3, lane2 & 15, lane2 >> 4);
        }
        if (!has_next) break;
#pragma unroll
        for (int a = 0; a < 2; ++a)
#pragma unroll
            for (int b = 0; b < 2; ++b)
#pragma unroll
                for (int m = 0; m < 4; ++m)
#pragma unroll
                    for (int n = 0; n < 2; ++n) acc[a][b][m][n] = (f32x4){0.f, 0.f, 0.f, 0.f};
        cur = nxt; cA = nA; cB = nB;
        if (GATHER) { vac[0] = van[0]; vac[1] = van[1]; vac[2] = van[2]; vac[3] = van[3]; }
    }
    G_WAIT_V(0);
    if (wr == 0) G_BAR;
    __syncthreads();
#undef S_STA
#undef S_STB
}

__device__ __forceinline__ bool dense_order(int i, int c, int G, int nM, int nN, int& pm, int& pn) {
    const int nwg = nM * nN; const long L = (long)i * G + c; if (L >= nwg) return false;
    int wgid = (int)L; { const int q = nwg / 8, r = nwg % 8, xcd = wgid % 8, off = wgid / 8; wgid = (xcd < r ? xcd * (q + 1) : r * (q + 1) + (xcd - r) * q) + off; }
    const int nig = 8 * nN, gid = wgid / nig, fm = gid * 8, gsz = (nM - fm) < 8 ? (nM - fm) : 8;
    pm = fm + ((wgid % nig) % gsz); pn = (wgid % nig) / gsz; return true;
}

typedef f32x4 AccT[2][2][4][2];

constexpr unsigned TPB = 528;
__device__ __forceinline__ void stage_tile_bf16(const AccT& acc, int wr, int wc, int fr, int fq, float scale) {
    LAS unsigned char* L8 = (LAS unsigned char*)dynlds;
#pragma unroll
    for (int ai = 0; ai < 2; ++ai)
#pragma unroll
        for (int m = 0; m < 4; ++m) {
            const unsigned ro = (unsigned)(ai * 128 + wr * 64 + m * 16 + fr) * TPB + (wc * 32 + fq * 4) * 2;
#pragma unroll
            for (int bj = 0; bj < 2; ++bj)
#pragma unroll
                for (int n = 0; n < 2; ++n) { const f32x4 v = acc[ai][bj][m][n] * scale; u32x2 w; w.x = pk2(v[0], v[1]); w.y = pk2(v[2], v[3]); *(LAS u32x2*)(L8 + ro + (bj * 128 + n * 16) * 2) = w; }
        }
}

struct EpiProj {
    bf16_t* C; int ldc; int row0, col0;
    __device__ __forceinline__ void operator()(const AccT& acc, int wr, int wc, int fr, int fq) const {
        stage_tile_bf16(acc, wr, wc, fr, fq, 1.0f);
        __syncthreads();
        const int tid = opaque_tid(), wave = tid >> 6, lane = tid & 63;
        LAS unsigned char* L8 = (LAS unsigned char*)dynlds;
#pragma unroll 8
        for (int i = 0; i < 32; ++i) {
            const int r = wave * 32 + i;
            *(u32x2*)(C + (size_t)(row0 + r) * ldc + col0 + lane * 4) = *(const LAS u32x2*)(L8 + (unsigned)r * TPB + lane * 8);
        }
    }
};

struct EpiLora {
    bf16_t* LO; const float* lbias; int row0, col0;
    __device__ __forceinline__ void operator()(const AccT& acc, int wr, int wc, int fr, int fq) const {
        const int seg = col0 >> 10, cbase = (col0 & 1023) + wc * 32 + fq * 4;
        const float* bias = lbias + (seg & 3) * DR_;
        LAS unsigned char* L8 = (LAS unsigned char*)dynlds;
#pragma unroll
        for (int bj = 0; bj < 2; ++bj)
#pragma unroll
            for (int n = 0; n < 2; ++n) {
                const int c = cbase + bj * 128 + n * 16;
                f32x4 bv = (f32x4){0.f, 0.f, 0.f, 0.f};
                if (seg < 4) bv = *(const f32x4*)(bias + c);
#pragma unroll
                for (int ai = 0; ai < 2; ++ai)
#pragma unroll
                    for (int m = 0; m < 4; ++m) {
                        const f32x4 v = acc[ai][bj][m][n] + bv; float o[4];
#pragma unroll
                        for (int j = 0; j < 4; ++j) {
                            const float xx = v[j];
                            if (seg < 2) o[j] = 1.0f - __expf(-0.60653066f * sigmoidf_(xx));
                            else if (seg < 4) o[j] = sigmoidf_(xx);
                            else o[j] = xx;
                        }
                        u32x2 w; w.x = pk2(o[0], o[1]); w.y = pk2(o[2], o[3]);
                        *(LAS u32x2*)(L8 + (unsigned)(ai * 128 + wr * 64 + m * 16 + fr) * TPB + (bj * 128 + wc * 32 + n * 16 + fq * 4) * 2) = w;
                    }
            }
        __syncthreads();
        const int tid = opaque_tid(), wave = tid >> 6, lane = tid & 63;
        bf16_t* outp = LO + (size_t)seg * T_ * DR_ + (col0 & 1023);
#pragma unroll 8
        for (int i = 0; i < 32; ++i) {
            const int r = wave * 32 + i;
            *(u32x2*)(outp + (size_t)(row0 + r) * DR_ + lane * 4) = *(const LAS u32x2*)(L8 + (unsigned)r * TPB + lane * 8);
        }
    }
};

struct EpiWout {
    const float* x; const float* gate; float* out; float* ssq; int row0, col0;
    __device__ __forceinline__ void ldx(f32x4 (&xv)[8], int g, int wr, int wc, int fr, int fq) const {
        const int c = col0 + (g >> 1) * 128 + wc * 32 + (g & 1) * 16 + fq * 4;
#pragma unroll
        for (int ai = 0; ai < 2; ++ai)
#pragma unroll
            for (int m = 0; m < 4; ++m) xv[ai * 4 + m] = *(const f32x4*)(x + (size_t)(row0 + ai * 128 + wr * 64 + m * 16 + fr) * D_ + c);
    }
    __device__ __forceinline__ void operator()(const AccT& acc, int wr, int wc, int fr, int fq) const {
        float ss[2][4];
#pragma unroll
        for (int ai = 0; ai < 2; ++ai)
#pragma unroll
            for (int m = 0; m < 4; ++m) ss[ai][m] = 0.f;
#pragma unroll
        for (int g = 0; g < 4; ++g) {
            const int bj = g >> 1, n = g & 1;
            const int c = col0 + bj * 128 + wc * 32 + n * 16 + fq * 4;
            const f32x4 gv = *(const f32x4*)(gate + c);
            f32x4 xa[8];
            ldx(xa, g, wr, wc, fr, fq);
#pragma unroll
            for (int ai = 0; ai < 2; ++ai)
#pragma unroll
                for (int m = 0; m < 4; ++m) {
                    const size_t o = (size_t)(row0 + ai * 128 + wr * 64 + m * 16 + fr) * D_ + c;
                    const f32x4 r = xa[ai * 4 + m] + gv * acc[ai][bj][m][n];
                    *(f32x4*)(out + o) = r;
                    ss[ai][m] += r[0] * r[0] + r[1] * r[1] + r[2] * r[2] + r[3] * r[3];
                }
        }
#pragma unroll
        for (int ai = 0; ai < 2; ++ai)
#pragma unroll
            for (int m = 0; m < 4; ++m) {
                float v = ss[ai][m];
                v += __shfl_xor(v, 16); v += __shfl_xor(v, 32);
                if (fq == 0) ssq[(size_t)(row0 + ai * 128 + wr * 64 + m * 16 + fr) * 32 + (col0 >> 8) * 4 + wc] = v;
            }
    }
};

struct EpiGateUp {
    fp8_t* act; size_t arow0; int ncol0;
    __device__ __forceinline__ void operator()(const AccT& acc, int wr, int wc, int fr, int fq) const {
        LAS unsigned char* L8 = (LAS unsigned char*)dynlds;
        constexpr unsigned TP8 = 144;
#pragma unroll
        for (int ai = 0; ai < 2; ++ai)
#pragma unroll
            for (int m = 0; m < 4; ++m) {
#pragma unroll
                for (int n = 0; n < 2; ++n) {
                    const f32x4 g = acc[ai][0][m][n] * (1.0f / 64.0f), u = acc[ai][1][m][n] * (1.0f / 64.0f); float o[4];
#pragma unroll
                    for (int j = 0; j < 4; ++j) o[j] = g[j] * sigmoidf_(g[j]) * u[j];
                    *(LAS unsigned*)(L8 + (unsigned)(ai * 128 + wr * 64 + m * 16 + fr) * TP8 + wc * 32 + n * 16 + fq * 4) = pk4_fp8(o[0], o[1], o[2], o[3]);
                }
            }
        __syncthreads();
        const int tid = opaque_tid(), wave = tid >> 6, lane = tid & 63;
#pragma unroll
        for (int i = 0; i < 4; ++i) {
            const int r = wave * 32 + i * 8 + (lane >> 3);
            *(u32x4*)(act + (arow0 + r) * EFF + ncol0 + (lane & 7) * 16) = *(const LAS u32x4*)(L8 + (unsigned)r * TP8 + (lane & 7) * 16);
        }
    }
};

constexpr float SLOT_SCALE = 16.0f;
constexpr unsigned DR_STAGE = 65536;
constexpr unsigned DUMP_ROW = T_ * NSLOT;
template <bool ROUTED>
struct EpiDownRouted {
    fp8_t* slot; const unsigned* list; const float* gw; int r0, cnt, col0;
    static constexpr unsigned TQ = 272;
    __device__ __forceinline__ void stage(const AccT& acc, int wr, int wc, int fr, int fq) const {
        LAS unsigned char* L8 = (LAS unsigned char*)dynlds + DR_STAGE;
        LAS unsigned* rowslot = (LAS unsigned*)(L8 + 256 * TQ);
        unsigned sl[8]; float gg[8];
#pragma unroll
        for (int q = 0; q < 8; ++q) {
            const int lr = (q >> 2) * 128 + wr * 64 + (q & 3) * 16 + fr, rr = r0 + lr;
            if (ROUTED) { const int rc = rr < LIST_CAP ? rr : LIST_CAP - 1; const unsigned v = list[rc]; gg[q] = gw[rc] * (SLOT_SCALE / 32.0f); sl[q] = (rr < cnt) ? v : 0xffffffffu; }
            else { sl[q] = (unsigned)rr * NSLOT + TOPK; gg[q] = SLOT_SCALE / 32.0f; }
        }
#pragma unroll
        for (int ai = 0; ai < 2; ++ai)
#pragma unroll
            for (int m = 0; m < 4; ++m) {
                const int q = ai * 4 + m, lr = ai * 128 + wr * 64 + m * 16 + fr;
                if (wc == 0 && fq == 0) rowslot[lr] = (sl[q] != 0xffffffffu) ? sl[q] : DUMP_ROW;
                const unsigned ro = (unsigned)lr * TQ + wc * 32 + fq * 4;
#pragma unroll
                for (int bj = 0; bj < 2; ++bj)
#pragma unroll
                    for (int n = 0; n < 2; ++n) { const f32x4 v = acc[ai][bj][m][n] * gg[q]; *(LAS unsigned*)(L8 + ro + bj * 128 + n * 16) = pk4_fp8(v[0], v[1], v[2], v[3]); }
            }
        __syncthreads();
    }
    __device__ __forceinline__ void store() const {
        LAS unsigned char* L8 = (LAS unsigned char*)dynlds + DR_STAGE;
        LAS unsigned* rowslot = (LAS unsigned*)(L8 + 256 * TQ);
        const int tid = opaque_tid(), wave = tid >> 6, lane = tid & 63;
#pragma unroll
        for (int i = 0; i < 8; ++i) {
            const int r = wave * 32 + i * 4 + (lane >> 4);
            const unsigned sr = rowslot[r];
            *(u32x4*)(slot + (size_t)sr * D_ + col0 + (lane & 15) * 16) = *(const LAS u32x4*)(L8 + (unsigned)r * TQ + (lane & 15) * 16);
        }
    }
};

__device__ __forceinline__ int map_row(int mode, int n) {
    if (mode == 1) return ((n >> 7) << 8) + (n & 127);
    if (mode == 2) return ((n >> 7) << 8) + 128 + (n & 127);
    if (mode == 3) return n < RWKV_IN_ ? n : n + 96;
    return n;
}
__device__ __forceinline__ void cvt_wave_tile(const float* __restrict__ W, int N, int Kv, int k0, int n0, bf16_t* __restrict__ dst, int dld, int mode, int dcol0, float* scr, int lane) {
    f32x4 tv[8];
#pragma unroll
    for (int i = 0; i < 8; ++i) {
        const int kk = 8 * i + (lane >> 3);
        tv[i] = (f32x4){0.f, 0.f, 0.f, 0.f};
        if (k0 + kk < Kv) tv[i] = *(const f32x4*)(W + (size_t)(k0 + kk) * N + n0 + (lane & 7) * 4);
    }
#pragma unroll
    for (int i = 0; i < 8; ++i) {
        const int kk = 8 * i + (lane >> 3);
#pragma unroll
        for (int j = 0; j < 4; ++j) scr[kk * 33 + (lane & 7) * 4 + j] = tv[i][j];
    }
    asm volatile("s_waitcnt lgkmcnt(0)" ::: "memory");
    const int c = lane & 7;
#pragma unroll
    for (int j = 0; j < 4; ++j) {
        const int n = (lane >> 3) + 8 * j; const float* sp = scr + (8 * c) * 33 + n;
        uint4 o; o.x = pk2(sp[0 * 33], sp[1 * 33]); o.y = pk2(sp[2 * 33], sp[3 * 33]); o.z = pk2(sp[4 * 33], sp[5 * 33]); o.w = pk2(sp[6 * 33], sp[7 * 33]);
        *(uint4*)(dst + (size_t)map_row(mode, n0 + n) * dld + dcol0 + k0 + 8 * c) = o;
    }
    asm volatile("s_waitcnt lgkmcnt(0)" ::: "memory");
}
__device__ __forceinline__ void cvt_f8_load(const float* __restrict__ W, int N, int k0, int n0, float (&tv)[32], int lane) {
#pragma unroll
    for (int i = 0; i < 8; ++i) {
        const float* Wi = W + (size_t)(k0 + 16 * i) * N + n0;
        const f32x4 v = *(const f32x4*)(Wi + (unsigned)((lane >> 2) * N + (lane & 3) * 4));
        tv[4 * i] = v[0]; tv[4 * i + 1] = v[1]; tv[4 * i + 2] = v[2]; tv[4 * i + 3] = v[3];
    }
}
__device__ __forceinline__ void cvt_f8_finish(const float (&tv)[32], int k0, int n0, fp8_t* __restrict__ dst, int dld, int mode, float scl, float* scr, int lane) {
#pragma unroll
    for (int i = 0; i < 8; ++i)
#pragma unroll
        for (int j = 0; j < 4; ++j) scr[(16 * i + (lane >> 2)) * 17 + (lane & 3) * 4 + j] = tv[4 * i + j];
    asm volatile("s_waitcnt lgkmcnt(0)" ::: "memory");
#pragma unroll
    for (int q = 0; q < 2; ++q) {
        const int pr = lane + 64 * q, n = pr >> 3, ck = pr & 7; const float* sp = scr + (ck * 16) * 17 + n;
        uint4 o;
        o.x = pk4_fp8(sp[0 * 17] * scl, sp[1 * 17] * scl, sp[2 * 17] * scl, sp[3 * 17] * scl);
        o.y = pk4_fp8(sp[4 * 17] * scl, sp[5 * 17] * scl, sp[6 * 17] * scl, sp[7 * 17] * scl);
        o.z = pk4_fp8(sp[8 * 17] * scl, sp[9 * 17] * scl, sp[10 * 17] * scl, sp[11 * 17] * scl);
        o.w = pk4_fp8(sp[12 * 17] * scl, sp[13 * 17] * scl, sp[14 * 17] * scl, sp[15 * 17] * scl);
        *(uint4*)(dst + (size_t)map_row(mode, n0 + n) * dld + k0 + ck * 16) = o;
    }
    asm volatile("s_waitcnt lgkmcnt(0)" ::: "memory");
}
__device__ __forceinline__ void cvt_wave_tile_f8(const float* __restrict__ W, int N, int k0, int n0, fp8_t* __restrict__ dst, int dld, int mode, float scl, float* scr, int lane) {
    float tv[32]; cvt_f8_load(W, N, k0, n0, tv, lane); cvt_f8_finish(tv, k0, n0, dst, dld, mode, scl, scr, lane);
}
__device__ __forceinline__ void cvt_expert_load(const Params& p, int wt, float (&tv)[32], int lane) {
    const int mtx = wt >> 15, r = wt & 32767, e = r >> 9, rr = r & 511;
    if (mtx < 2) cvt_f8_load((mtx ? p.w_up_e : p.w_gate_e) + (size_t)e * 2048 * 512, 512, (rr >> 5) * 128, (rr & 31) * 16, tv, lane);
    else cvt_f8_load(p.w_down_e + (size_t)e * 512 * 2048, 2048, (rr >> 7) * 128, (rr & 127) * 16, tv, lane);
}
__device__ __forceinline__ void cvt_expert_finish(const Params& p, int wt, const float (&tv)[32], float* scr, int lane) {
    const int mtx = wt >> 15, r = wt & 32767, e = r >> 9, rr = r & 511;
    if (mtx < 2) cvt_f8_finish(tv, (rr >> 5) * 128, (rr & 31) * 16, p.We1q + (size_t)e * 1024 * 2048, 2048, 1 + mtx, 64.0f, scr, lane);
    else cvt_f8_finish(tv, (rr >> 7) * 128, (rr & 127) * 16, p.We2q + (size_t)e * 2048 * 512, 512, 0, 32.0f, scr, lane);
}
__device__ __forceinline__ void cvt_expert_tile(const Params& p, int wt, float* scr, int lane) {
    float tv[32]; cvt_expert_load(p, wt, tv, lane); cvt_expert_finish(p, wt, tv, scr, lane);
}

constexpr int W_IN = 32 * 205, W_OUT = 32 * 64, W_S = 32 * 16, W_SD = 8 * 64, W_L = 32, W_G = 3 * 32;
constexpr int W_DEFER = W_OUT + 2 * W_S + W_SD, W_TOTAL = W_IN + W_DEFER + 4 * W_L + W_G;
__device__ __forceinline__ void small_tile(const Params& p, int r, float* scr, int lane) {
    if (r < W_IN) { cvt_wave_tile(p.w_in, 6560, 2048, (r / 205) * 64, (r % 205) * 32, p.Win, 2048, 3, 0, scr, lane); return; } r -= W_IN;
    if (r < W_OUT) { cvt_wave_tile(p.w_out, 2048, 2048, (r >> 6) * 64, (r & 63) * 32, p.Wout, 2048, 0, 0, scr, lane); return; } r -= W_OUT;
    if (r < W_S) { cvt_wave_tile_f8(p.w_gate_s, 512, (r >> 5) * 128, (r & 31) * 16, p.Ws1q, 2048, 1, 64.0f, scr, lane); return; } r -= W_S;
    if (r < W_S) { cvt_wave_tile_f8(p.w_up_s, 512, (r >> 5) * 128, (r & 31) * 16, p.Ws1q, 2048, 2, 64.0f, scr, lane); return; } r -= W_S;
    if (r < W_SD) { cvt_wave_tile_f8(p.w_down_s, 2048, (r >> 7) * 128, (r & 127) * 16, p.Ws2q, 512, 0, 32.0f, scr, lane); return; } r -= W_SD;
    if (r < W_L) { cvt_wave_tile(p.w_up_f, 1024, 64, 0, r * 32, p.Wlora, 512, 0, 0, scr, lane); return; } r -= W_L;
    if (r < W_L) { cvt_wave_tile(p.w_up_b, 1024, 64, 0, r * 32, p.Wlora + (size_t)1024 * 512, 512, 0, 64, scr, lane); return; } r -= W_L;
    if (r < W_L) { cvt_wave_tile(p.a_up_f, 1024, 64, 0, r * 32, p.Wlora + (size_t)2048 * 512, 512, 0, 128, scr, lane); return; } r -= W_L;
    if (r < W_L) { cvt_wave_tile(p.a_up_b, 1024, 64, 0, r * 32, p.Wlora + (size_t)3072 * 512, 512, 0, 192, scr, lane); return; } r -= W_L;
    cvt_wave_tile(p.g_up, 1024, 160, (r >> 5) * 64, (r & 31) * 32, p.Wlora + (size_t)4096 * 512, 512, 0, 256, scr, lane);
}
constexpr int CVT_ITEMS = 3 * 32768 / 32, PRE_PER_WG = 0;
__device__ __forceinline__ void tail_split(int G, int& first_idle, int& n_idle) {
    const int rem = ((T_ / 256) * (NPROJ / 256)) % G;
    first_idle = rem == 0 ? G : rem; n_idle = G - first_idle;
}
__device__ __forceinline__ int conv_prefilled(int G) { int f, n; tail_split(G, f, n); const int v = n * PRE_PER_WG; return v < CVT_ITEMS ? v : CVT_ITEMS; }

__device__ __forceinline__ void phase_prologue(const Params& p) {
    const int tid = opaque_tid(), wave = tid >> 6, lane = tid & 63, bid = blockIdx.x, nb = gridDim.x;
    for (int u = bid; u < 192; u += nb) {
        float* sc = (float*)dynlds; float* red = sc + 4 * D_;
        __syncthreads();
        for (int i = tid; i < 4 * D_; i += NTHREADS) { const float cv = p.c[i]; sc[i] = cv * sigmoidf_(cv); }
        __syncthreads();
        float acc[4][4];
#pragma unroll
        for (int b = 0; b < 4; ++b)
#pragma unroll
            for (int j = 0; j < 4; ++j) acc[b][j] = 0.f;
        const int rg = lane >> 4, c4 = (lane & 15) * 4;
        const float* wp = p.w_ada + (size_t)(wave * 256 + rg) * 12288 + u * 64 + c4;
#pragma unroll 16
        for (int it = 0; it < 64; ++it) {
            const float4 wv = *(const float4*)(wp + (size_t)it * 4 * 12288);
            const int k = wave * 256 + it * 4 + rg;
#pragma unroll
            for (int b = 0; b < 4; ++b) { const float sv = sc[b * D_ + k]; acc[b][0] += sv * wv.x; acc[b][1] += sv * wv.y; acc[b][2] += sv * wv.z; acc[b][3] += sv * wv.w; }
        }
#pragma unroll
        for (int b = 0; b < 4; ++b)
#pragma unroll
            for (int j = 0; j < 4; ++j) red[(wave * 16 + b * 4 + j) * 64 + lane] = acc[b][j];
        __syncthreads();
        if (tid < 256) {
            const int b = tid >> 6, col = tid & 63, cl = col >> 2, j = col & 3;
            float sm = 0.f;
#pragma unroll
            for (int w = 0; w < 8; ++w)
#pragma unroll
                for (int g = 0; g < 4; ++g) sm += red[(w * 16 + b * 4 + j) * 64 + g * 16 + cl];
            p.mod[b * 12288 + u * 64 + col] = sm + p.b_ada[u * 64 + col];
        }
        __syncthreads();
    }
    for (int i = bid * NTHREADS + tid; i < 4 * DR_; i += nb * NTHREADS) {
        const int sg = i >> 10, c = i & 1023;
        float v = p.w0_f[c]; if (sg == 1) v = p.w0_b[c]; if (sg == 2) v = p.a0_f[c]; if (sg == 3) v = p.a0_b[c];
        p.lbias[i] = v;
    }
    for (int i = bid * NTHREADS + tid; i < 96 * D_ / 8; i += nb * NTHREADS) *(uint4*)(p.Win + (size_t)RWKV_IN_ * D_ + (size_t)i * 8) = make_uint4(0u, 0u, 0u, 0u);
    {
        float* scr = (float*)dynlds + wave * 2176;
        int fi, ni; tail_split(nb, fi, ni);
        const bool defer = ni > 0;
        __syncthreads();
        for (int it = bid * 8 + wave; it < (defer ? W_TOTAL - W_DEFER : W_TOTAL); it += nb * 8) {
            int r = it; if (defer && r >= W_IN) r += W_DEFER;
            small_tile(p, r, scr, lane);
        }
        __syncthreads();
    }
}

__device__ __forceinline__ void phase_norm1(const Params& p) {
    const int tid = opaque_tid(), wave = tid >> 6, lane = tid & 63;
    for (int row = blockIdx.x * 8 + wave; row < T_; row += gridDim.x * 8) {
        const int b = row >> 12;
        const float4* xr = (const float4*)(p.x + (size_t)row * D_) + lane;
        float4 v[8]; float ss = 0.f;
#pragma unroll
        for (int i = 0; i < 8; ++i) { v[i] = xr[i * 64]; ss += v[i].x * v[i].x + v[i].y * v[i].y + v[i].z * v[i].z + v[i].w * v[i].w; }
        ss = wave_sum(ss);
        const float rstd = rsqrtf(ss * (1.0f / D_) + 1e-6f);
        const float* modb = p.mod + b * 12288;
        bf16_t* hr = p.H + (size_t)row * D_;
#pragma unroll
        for (int i = 0; i < 8; ++i) {
            const int c = i * 256 + lane * 4;
            const float4 nw = *(const float4*)(p.norm1_w + c), sh = *(const float4*)(modb + c), sc = *(const float4*)(modb + 2048 + c);
            u32x2 w;
            w.x = pk2(v[i].x * rstd * nw.x * (1.f + sc.x) + sh.x, v[i].y * rstd * nw.y * (1.f + sc.y) + sh.y);
            w.y = pk2(v[i].z * rstd * nw.z * (1.f + sc.z) + sh.z, v[i].w * rstd * nw.w * (1.f + sc.w) + sh.w);
            *(u32x2*)(hr + c) = w;
        }
    }
}

__device__ __forceinline__ void dense_aoff(unsigned (&aoff)[4], int row0, int pitch) {
    const int tid = opaque_tid();
    int R0, C0, R1, C1; stage_rc(tid * 16, R0, C0); stage_rc(tid * 16 + 8192, R1, C1);
    aoff[0] = (unsigned)(row0 + R0) * pitch + C0 * 2; aoff[1] = (unsigned)(row0 + R1) * pitch + C1 * 2;
    aoff[2] = (unsigned)(row0 + 128 + R0) * pitch + C0 * 2; aoff[3] = (unsigned)(row0 + 128 + R1) * pitch + C1 * 2;
}

__device__ __forceinline__ void phase_gemm_in(const Params& p) {
    for (int i = 0;; ++i) {
        int pm, pn; if (!dense_order(i, blockIdx.x, gridDim.x, T_ / 256, NPROJ / 256, pm, pn)) break;
        unsigned aoff[4]; dense_aoff(aoff, pm * 256, D_ * 2);
        EpiProj epi{p.proj, NPROJ, pm * 256, pn * 256};
        gemm_unit<false>(p.H, aoff, p.Win + (size_t)pn * 256 * D_, D_ * 2, epi);
    }
    int fi, ni; tail_split(gridDim.x, fi, ni);
    if ((int)blockIdx.x >= fi) {
        const int tid = opaque_tid(), wave = tid >> 6, lane = tid & 63, j = blockIdx.x - fi;
        float* scr = (float*)dynlds + wave * 2176;
        for (int it = j * 8 + wave; it < W_DEFER; it += ni * 8) small_tile(p, W_IN + it, scr, lane);
#pragma unroll 1
        for (int k = 0; k < PRE_PER_WG; ++k) {
            const int item = j * PRE_PER_WG + k;
            if (item < CVT_ITEMS) {
#pragma unroll 1
                for (int q = 0; q < 4; ++q) cvt_expert_tile(p, item * 32 + wave * 4 + q, scr, lane);
            }
        }
        __syncthreads();
    }
}
__device__ __forceinline__ void phase_gemm_lora(const Params& p) {
    for (int i = 0;; ++i) {
        int pm, pn; if (!dense_order(i, blockIdx.x, gridDim.x, T_ / 256, 4096 / 256, pm, pn)) break;
        const int koff = 0;
        unsigned aoff[4]; dense_aoff(aoff, pm * 256, 512 * 2);
        EpiLora epi{p.LO, p.lbias, pm * 256, pn * 256};
        gemm_unit<false>((const char*)p.Alora + koff, aoff, (const char*)(p.Wlora + (size_t)pn * 256 * 512) + koff, 512 * 2, epi, 4);
    }
}
__device__ __forceinline__ void phase_gemm_out(const Params& p) {
    for (int i = 0;; ++i) {
        int pm, pn; if (!dense_order(i, blockIdx.x, gridDim.x, T_ / 256, D_ / 256, pm, pn)) break;
        unsigned aoff[4]; dense_aoff(aoff, pm * 256, D_ * 2);
        EpiWout epi{p.x, p.mod + ((pm * 256) >> 12) * 12288 + 4096, p.out, p.ssq, pm * 256, pn * 256};
        gemm_unit<false>(p.ycat, aoff, p.Wout + (size_t)pn * 256 * D_, D_ * 2, epi);
    }
}

__device__ __forceinline__ void shifted8(const Params& p, int t, int ch, float (&z)[8]) {
    const int s = t & (SEQ_ - 1);
    const bf16_t* pr = p.proj + (size_t)t * NPROJ + ch;
    const uint4 cur = *(const uint4*)pr;
    uint4 prv = make_uint4(0u, 0u, 0u, 0u), nxt = make_uint4(0u, 0u, 0u, 0u);
    if (s > 0) prv = *(const uint4*)(pr - NPROJ);
    if (s < SEQ_ - 1) nxt = *(const uint4*)(pr + NPROJ);
    float a[8], b[8], c[8]; unpack8(prv, a); unpack8(cur, b); unpack8(nxt, c);
    const float* sw = p.rwkv_shift + ch;
#pragma unroll
    for (int j = 0; j < 8; ++j) z[j] = sw[j] * a[j] + sw[RWKV_IN_ + j] * b[j] + sw[2 * RWKV_IN_ + j] * c[j];
}

__device__ __forceinline__ void phase_prep(const Params& p) {
    const int tid = opaque_tid();
    for (int u = blockIdx.x; u < T_ / 64; u += gridDim.x) {
        const int t0 = u * 64;
        {
            const int gl = tid & 127, tq = tid >> 7;
#pragma unroll 1
            for (int seg = 0; seg < 3; ++seg) {
                const int ch = gl * 8, pc = seg * 1024 + ch;
                float w0[8], w1[8], w2[8], kkw[8];
#pragma unroll
                for (int j = 0; j < 8; ++j) { w0[j] = p.rwkv_shift[pc + j]; w1[j] = p.rwkv_shift[RWKV_IN_ + pc + j]; w2[j] = p.rwkv_shift[2 * RWKV_IN_ + pc + j]; kkw[j] = p.k_k[ch + j]; }
                const int tb = t0 + tq * 16;
                const bf16_t* pr = p.proj + (size_t)tb * NPROJ + pc;
                float a[8], b[8], c[8];
                { uint4 prv = make_uint4(0u, 0u, 0u, 0u); if ((tb & (SEQ_ - 1)) > 0) prv = *(const uint4*)(pr - NPROJ); unpack8(prv, a); unpack8(*(const uint4*)pr, b); }
#pragma unroll 8
                for (int j16 = 0; j16 < 16; ++j16) {
                    const int t = tb + j16;
                    uint4 nxt = make_uint4(0u, 0u, 0u, 0u);
                    if ((t & (SEQ_ - 1)) < SEQ_ - 1) nxt = *(const uint4*)(pr + (size_t)(j16 + 1) * NPROJ);
                    unpack8(nxt, c);
                    float z[8], kkv[8]; float ss = 0.f;
#pragma unroll
                    for (int j = 0; j < 8; ++j) { z[j] = w0[j] * a[j] + w1[j] * b[j] + w2[j] * c[j]; kkv[j] = z[j] * kkw[j]; ss += kkv[j] * kkv[j]; a[j] = b[j]; b[j] = c[j]; }
                    ss = red8_sum(ss);
                    const size_t o = (size_t)t * DR_ + ch;
                    if (seg == 0) *(uint4*)(p.rb + o) = pack8(z);
                    else if (seg == 2) *(uint4*)(p.vb + o) = pack8(z);
                    else {
                        *(uint4*)(p.kb + o) = pack8(z);
                        const float sc = rsqrtf(fmaxf(ss, 1e-12f));
#pragma unroll
                        for (int j = 0; j < 8; ++j) kkv[j] *= sc;
                        *(uint4*)(p.kkb + o) = pack8(kkv);
                    }
                }
            }
        }
#pragma unroll 4
        for (int it = tid; it < 64 * 64; it += NTHREADS) {
            const int tl = it >> 6, g = it & 63, t = t0 + tl;
            float z[8];
            if (g < 52) {
                shifted8(p, t, PC_L + g * 8, z);
                if (g < 16) {
#pragma unroll
                    for (int j = 0; j < 8; ++j) z[j] = tanhf(z[j]);
                } else if (g >= 32) {
#pragma unroll
                    for (int j = 0; j < 8; ++j) z[j] = sigmoidf_(z[j]);
                }
            } else {
#pragma unroll
                for (int j = 0; j < 8; ++j) z[j] = 0.f;
            }
            *(uint4*)(p.Alora + (size_t)t * 512 + g * 8) = pack8(z);
        }
    }
}

__device__ __forceinline__ void prep_na_tile(const Params& p, const int t0) {
    const int tid = opaque_tid();
    {
#pragma unroll 8
        for (int it = tid; it < 64 * 256; it += NTHREADS) {
            const int tl = it >> 8, g = it & 255, t = t0 + tl, isk = g >> 7, ch = (g & 127) * 8;
            const uint4 raw = *(const uint4*)(p.proj + (size_t)t * NPROJ + (isk ? PC_KN : PC_Q) + ch);
            float v[8]; unpack8(raw, v);
            float ss = 0.f;
#pragma unroll
            for (int j = 0; j < 8; ++j) ss += v[j] * v[j];
            ss = red8_sum(ss);
            const float rs = rsqrtf(ss * (1.0f / 64.0f) + 1e-6f) * (isk ? 1.0f : 0.125f);
            const float* nw = (isk ? p.kn_w : p.qn_w) + (ch & 63);
#pragma unroll
            for (int j = 0; j < 8; ++j) v[j] = v[j] * rs * nw[j];
            *(uint4*)((isk ? p.KN : p.QN) + ((size_t)((t >> 12) * 16 + (ch >> 6)) * SEQ_ + (t & (SEQ_ - 1))) * 64 + (ch & 63)) = pack8(v);
        }
        bf16_t* sT = (bf16_t*)dynlds;
        __syncthreads();
#pragma unroll 8
        for (int it = tid; it < 128 * 64; it += NTHREADS) {
            const int tl = it & 63, g = it >> 6;
            const uint4 raw = *(const uint4*)(p.proj + (size_t)(t0 + tl) * NPROJ + PC_VN + g * 8);
            const unsigned w[4] = {raw.x, raw.y, raw.z, raw.w};
#pragma unroll
            for (int j = 0; j < 4; ++j) { sT[(g * 8 + 2 * j) * 64 + tl] = (bf16_t)(w[j] & 0xffffu); sT[(g * 8 + 2 * j + 1) * 64 + tl] = (bf16_t)(w[j] >> 16); }
        }
        __syncthreads();
        {
            const int b = t0 >> 12, s0 = t0 & (SEQ_ - 1);
#pragma unroll 8
            for (int it = tid; it < 1024 * 8; it += NTHREADS) {
                const int ch = ((it >> 9) << 6) | (it & 63), t8 = (it >> 6) & 7;
                const uint4 v = *(const uint4*)(sT + ch * 64 + t8 * 8);
                *(uint4*)(p.VT + (((size_t)(b * 16 + (ch >> 6)) * (SEQ_ / 8) + (s0 >> 3) + t8) * 64 + (ch & 63)) * 8) = v;
            }
        }
        __syncthreads();
    }
}

typedef short s16x4 __attribute__((ext_vector_type(4)));
constexpr int CVT_TILES = 3 * 32768;
constexpr unsigned SLOT = 9216, SPITCH = 144;
__device__ __forceinline__ bf16x8 lds16(unsigned off) { return *(const LAS bf16x8*)((LAS unsigned char*)dynlds + off); }
template <bool SWAP>
__device__ __forceinline__ void mm_acc(f32x4 (&acc)[2], unsigned X, unsigned Y, int tm, int tn0, int fr, int fq) {
#pragma unroll
    for (int ks = 0; ks < 2; ++ks) {
        const bf16x8 xa = lds16(X + (unsigned)(tm * 16 + fr) * SPITCH + ks * 64 + fq * 16);
#pragma unroll
        for (int q = 0; q < 2; ++q) {
            const bf16x8 yb = lds16(Y + (unsigned)((tn0 + q) * 16 + fr) * SPITCH + ks * 64 + fq * 16);
            acc[q] = SWAP ? __builtin_amdgcn_mfma_f32_16x16x32_bf16(yb, xa, acc[q], 0, 0, 0) : __builtin_amdgcn_mfma_f32_16x16x32_bf16(xa, yb, acc[q], 0, 0, 0);
        }
    }
}
__device__ __forceinline__ void st_rows(unsigned D, const f32x4& v, int tm, int tn, int fr, int fq) {
    u32x2 w; w.x = pk2(v[0], v[1]); w.y = pk2(v[2], v[3]);
    *(LAS u32x2*)((LAS unsigned char*)dynlds + D + (unsigned)(tm * 16 + fr) * SPITCH + (tn * 16 + fq * 4) * 2) = w;
}
__device__ __forceinline__ void st_tr(unsigned DT, const f32x4& v, int tm, int tn, int fr, int fq, bool diag) {
    const int m = tm * 16 + fr;
    const int n0 = tn * 16 + fq * 4;
    float d[4];
#pragma unroll
    for (int e = 0; e < 4; ++e) d[e] = diag ? __uint_as_float(0x3f800000u & (unsigned)((((n0 + e) ^ m) - 1) >> 31)) : 0.f;
    const unsigned w0 = pk2(v[0] + d[0], v[1] + d[1]);
    const unsigned w1 = pk2(v[2] + d[2], v[3] + d[3]);
    LAS bf16_t* base = (LAS bf16_t*)((LAS unsigned char*)dynlds + DT) + (unsigned)(tn * 16 + fq * 4) * (SPITCH / 2) + m;
    base[0] = (bf16_t)(w0 & 0xffffu); base[SPITCH / 2] = (bf16_t)(w0 >> 16); base[SPITCH] = (bf16_t)(w1 & 0xffffu); base[3 * (SPITCH / 2)] = (bf16_t)(w1 >> 16);
}
__device__ __forceinline__ f32x4 ld_rows(unsigned D, int tm, int tn, int fr, int fq) {
    const u32x2 w = *(const LAS u32x2*)((LAS unsigned char*)dynlds + D + (unsigned)(tm * 16 + fr) * SPITCH + (tn * 16 + fq * 4) * 2);
    return (f32x4){bflo(w.x), bfhi(w.x), bflo(w.y), bfhi(w.y)};
}

template <bool REV>
__device__ __forceinline__ void scan_unit(const Params& p, int b, int h) {
    const int tid = opaque_tid(), wave = tid >> 6, lane = tid & 63, fr = lane & 15, fq = lane >> 4, tm = wave >> 1, tn0 = (wave & 1) * 2;
    constexpr unsigned O_SB = 0 * SLOT, O_VT = 1 * SLOT, O_BHT = 2 * SLOT, O_KHT = 3 * SLOT, O_RT = 4 * SLOT, O_MBRT = 5 * SLOT, O_MKRT = 6 * SLOT, O_MKA = 7 * SLOT,
                       O_ATT = 8 * SLOT, O_AT = 9 * SLOT, O_BT = 10 * SLOT, O_KT = 11 * SLOT, O_NA = 12 * SLOT, O_LA = 13 * SLOT, O_NB = 14 * SLOT, O_LB = 15 * SLOT,
                       O_PA = O_AT, O_PB = O_BT, O_U = O_KT, O_M1 = O_KT, O_M2 = 16 * SLOT, O_X2T = O_NA, O_X1T = O_LA, O_CUM = O_NA  ;
    LAS unsigned char* L8 = (LAS unsigned char*)dynlds;
    LAS float* cum = (LAS float*)(L8 + O_CUM); LAS float* btot = (LAS float*)(L8 + O_M2);
    const bf16_t* omd = p.LO + (size_t)(REV ? 1 : 0) * T_ * DR_;
    const bf16_t* asg = p.LO + (size_t)(REV ? 3 : 2) * T_ * DR_;
    bf16_t* yout = p.H + (size_t)(REV ? 1 : 0) * T_ * DR_;
    f32x4 Sf[2];
    Sf[0] = (f32x4){0.f, 0.f, 0.f, 0.f}; Sf[1] = Sf[0];
    __syncthreads();
    st_rows(O_SB, Sf[0], tm, tn0, fr, fq); st_rows(O_SB, Sf[1], tm, tn0 + 1, fr, fq);
    const int pj = tid & 63, ptg = tid >> 6;
    const int ptl = tid >> 3, pcg = tid & 7;
    const float ka1 = p.k_a[h * 64 + pj];
    float ka8[8];
#pragma unroll
    for (int e = 0; e < 8; ++e) ka8[e] = p.k_a[h * 64 + pcg * 8 + e];
    unsigned r_om[8], r_kk[8], r_as[8], r_k[8], r_v[8];
    uint4 q_kk, q_as, q_om, q_k, q_r;
    auto load_chunk = [&](int c) {
#pragma unroll
        for (int e = 0; e < 8; ++e) {
            const int u = c * 64 + ptg * 8 + e; const int t = REV ? (SEQ_ - 1 - u) : u;
            const size_t tb = (size_t)(b * SEQ_ + t) * DR_ + h * 64 + pj;
            r_om[e] = omd[tb]; r_kk[e] = p.kkb[tb]; r_as[e] = asg[tb]; r_k[e] = p.kb[tb]; r_v[e] = p.vb[tb];
        }
        const int u2 = c * 64 + ptl; const int t2 = REV ? (SEQ_ - 1 - u2) : u2;
        const size_t base = (size_t)(b * SEQ_ + t2) * DR_ + h * 64 + pcg * 8;
        q_kk = *(const uint4*)(p.kkb + base); q_as = *(const uint4*)(asg + base); q_om = *(const uint4*)(omd + base);
        q_k = *(const uint4*)(p.kb + base); q_r = *(const uint4*)(p.rb + base);
    };
    load_chunk(0);
#pragma unroll 1
    for (int c = 0; c < SEQ_ / 64; ++c) {
        float cp[8];
        cp[0] = 1.0f - bflo(r_om[0]);
#pragma unroll
        for (int e = 1; e < 8; ++e) cp[e] = cp[e - 1] * (1.0f - bflo(r_om[e]));
        btot[ptg * 64 + pj] = cp[7];
        __syncthreads();
        float pre = 1.f, tot = 1.f;
#pragma unroll
        for (int g = 0; g < 8; ++g) { const float v = btot[g * 64 + pj]; pre *= (g < ptg) ? v : 1.f; tot *= v; }
        {
            float o0[8], o1[8], o2[8], o3[8];
#pragma unroll
            for (int e = 0; e < 8; ++e) {
                const float W = pre * cp[e], wm = (e == 0) ? pre : pre * cp[e > 0 ? e - 1 : 0];
                cum[(ptg * 8 + e) * 64 + pj] = W;
                const float kkv = bflo(r_kk[e]), av = bflo(r_as[e]), kv = bflo(r_k[e]), vv = bflo(r_v[e]);
                const float rat = tot * __builtin_amdgcn_rcpf(W);
                o0[e] = -kkv * wm; o1[e] = kkv * av * rat; o2[e] = kv * (1.0f + (av - 1.0f) * ka1) * rat; o3[e] = vv;
            }
            const unsigned ro = (unsigned)pj * SPITCH + ptg * 16;
            *(LAS u32x4*)(L8 + O_ATT + ro) = pack8v(o0); *(LAS u32x4*)(L8 + O_BHT + ro) = pack8v(o1); *(LAS u32x4*)(L8 + O_KHT + ro) = pack8v(o2); *(LAS u32x4*)(L8 + O_VT + ro) = pack8v(o3);
        }
        __syncthreads();
        float wl[2][4];
        {
            float kk[8], av[8], om[8], kv[8], rv[8];
            unpack8(q_kk, kk); unpack8(q_as, av); unpack8(q_om, om); unpack8(q_k, kv); unpack8(q_r, rv);
            const f32x4 c0 = *(const LAS f32x4*)(cum + ptl * 64 + pcg * 8), c1 = *(const LAS f32x4*)(cum + ptl * 64 + pcg * 8 + 4);
            const int pl = ptl > 0 ? ptl - 1 : 0;
            f32x4 d0 = *(const LAS f32x4*)(cum + pl * 64 + pcg * 8), d1 = *(const LAS f32x4*)(cum + pl * 64 + pcg * 8 + 4);
            if (ptl == 0) { d0 = (f32x4){1.f, 1.f, 1.f, 1.f}; d1 = d0; }
            const float cu[8] = {c0.x, c0.y, c0.z, c0.w, c1.x, c1.y, c1.z, c1.w}, cm[8] = {d0.x, d0.y, d0.z, d0.w, d1.x, d1.y, d1.z, d1.w};
            float o0[8], o1[8], o2[8], o3[8];
#pragma unroll
            for (int e = 0; e < 8; ++e) {
                const float wm = cm[e], iw = __builtin_amdgcn_rcpf(cu[e]);
                o0[e] = -kk[e] * wm; o1[e] = kk[e] * av[e] * iw; o2[e] = kv[e] * (1.0f + (av[e] - 1.0f) * ka8[e]) * iw;
                o3[e] = rv[e] * (REV ? wm : cu[e]);
            }
            const unsigned ro = (unsigned)ptl * SPITCH + pcg * 16;
            *(LAS u32x4*)(L8 + O_AT + ro) = pack8v(o0); *(LAS u32x4*)(L8 + O_BT + ro) = pack8v(o1); *(LAS u32x4*)(L8 + O_KT + ro) = pack8v(o2); *(LAS u32x4*)(L8 + O_RT + ro) = pack8v(o3);
#pragma unroll
            for (int q = 0; q < 2; ++q) {
                const f32x4 cw = *(const LAS f32x4*)(cum + 63 * 64 + (tn0 + q) * 16 + fq * 4);
                wl[q][0] = cw.x; wl[q][1] = cw.y; wl[q][2] = cw.z; wl[q][3] = cw.w;
            }
        }
        if (c + 1 < SEQ_ / 64) load_chunk(c + 1);
        __builtin_amdgcn_sched_barrier(0);
        __syncthreads();
        {
            f32x4 a0[2] = {{0.f, 0.f, 0.f, 0.f}, {0.f, 0.f, 0.f, 0.f}}, a1[2] = {a0[0], a0[0]}, a2[2] = {a0[0], a0[0]}, a3[2] = {a0[0], a0[0]};
            mm_acc<true>(a0, O_BT, O_AT, tm, tn0, fr, fq); mm_acc<true>(a1, O_KT, O_AT, tm, tn0, fr, fq);
            mm_acc<true>(a2, O_RT, O_BT, tm, tn0, fr, fq); mm_acc<true>(a3, O_RT, O_KT, tm, tn0, fr, fq);
            const int m = tm * 16 + fr;
            f32x4 dd[2], m1[2], m2[2];
#pragma unroll
            for (int q = 0; q < 2; ++q) {
#pragma unroll
                for (int e = 0; e < 4; ++e) {
                    const int n = (tn0 + q) * 16 + fq * 4 + e;
                    const unsigned up = (unsigned)((m - n) >> 31), lo = (unsigned)((REV ? (n - m) : (n - m - 1)) >> 31);
                    const unsigned s16 = (unsigned)((((n ^ m) >> 4) - 1) >> 31), s32 = (unsigned)((((n ^ m) >> 5) - 1) >> 31);
                    const unsigned v0 = __float_as_uint(a0[q][e]) & up;
                    dd[q][e] = __uint_as_float(v0 & s16); m1[q][e] = __uint_as_float(v0 & s32 & ~s16); m2[q][e] = __uint_as_float(v0 & ~s32);
                    a1[q][e] = __uint_as_float(__float_as_uint(a1[q][e]) & up); a2[q][e] = __uint_as_float(__float_as_uint(a2[q][e]) & lo); a3[q][e] = __uint_as_float(__float_as_uint(a3[q][e]) & lo);
                }
            }
            const int dq = tm - tn0;
            const bool own = (dq == 0) || (dq == 1);
            f32x4 e1 = {0.f, 0.f, 0.f, 0.f};
            if (own) {
#pragma unroll
                for (int ks = 0; ks < 2; ++ks) {
                    const bf16x8 xa = lds16(O_BT + (unsigned)(tm * 16 + fr) * SPITCH + ks * 64 + fq * 16), yb = lds16(O_AT + (unsigned)(tm * 16 + fr) * SPITCH + ks * 64 + fq * 16);
                    e1 = __builtin_amdgcn_mfma_f32_16x16x32_bf16(xa, yb, e1, 0, 0, 0);
                }
            }
            __syncthreads();
            f32x4 qi = {0.f, 0.f, 0.f, 0.f}, qti = qi;
            if (own) {
                f32x4 E, ET = dq ? dd[1] : dd[0], Q, QT;
#pragma unroll
                for (int e = 0; e < 4; ++e) {
                    const int cc = fq * 4 + e;
                    E[e] = __uint_as_float(__float_as_uint(e1[e]) & (unsigned)((cc - fr) >> 31));
                    const float idn = __uint_as_float(0x3f800000u & (unsigned)(((cc ^ fr) - 1) >> 31));
                    Q[e] = E[e] + idn; QT[e] = ET[e] + idn;
                }
#define PK4S(v) __builtin_bit_cast(s16x4, (u32x2){pk2((v)[0], (v)[1]), pk2((v)[2], (v)[3])})
#define MM16(Xb, Yb, C) __builtin_amdgcn_mfma_f32_16x16x16bf16_1k(Yb, Xb, C, 0, 0, 0)
#pragma unroll
                for (int lv = 0; lv < 3; ++lv) {
                    const s16x4 Eb = PK4S(E), ETb = PK4S(ET), Qb = PK4S(Q);
                    const f32x4 zz = {0.f, 0.f, 0.f, 0.f};
                    const f32x4 E2 = MM16(Eb, ETb, zz), ET2 = MM16(ETb, Eb, zz);
                    const s16x4 ET2b = PK4S(ET2);
                    Q = MM16(Qb, ET2b, Q);
                    QT = MM16(ET2b, Qb, QT);
                    E = E2; ET = ET2;
                }
#undef MM16
#undef PK4S
                qi = Q; qti = QT;
            }
#pragma unroll
            for (int q = 0; q < 2; ++q) {
                const bool dg = own && (q == dq);
                const f32x4 zz = {0.f, 0.f, 0.f, 0.f};
                st_rows(O_PB, dg ? qi : zz, tm, tn0 + q, fr, fq); st_rows(O_LA, dg ? qti : zz, tm, tn0 + q, fr, fq);
                st_tr(O_M1, m1[q], tm, tn0 + q, fr, fq, false); st_tr(O_M2, m2[q], tm, tn0 + q, fr, fq, false);
                st_rows(O_MKA, a1[q], tm, tn0 + q, fr, fq); st_rows(O_MBRT, a2[q], tm, tn0 + q, fr, fq); st_rows(O_MKRT, a3[q], tm, tn0 + q, fr, fq);
            }
        }
        __syncthreads();
        {
            constexpr unsigned O_DINV = O_PB, O_DINVT = O_LA, O_Z1T = O_NA, O_Z2P = O_NB, O_G1 = O_LB, O_WT = O_LA, O_P = O_PA;
            { f32x4 z[2] = {{0.f, 0.f, 0.f, 0.f}, {0.f, 0.f, 0.f, 0.f}}, y[2] = {z[0], z[0]};
              mm_acc<true>(z, O_M1, O_DINVT, tm, tn0, fr, fq); mm_acc<true>(y, O_M2, O_DINVT, tm, tn0, fr, fq);
#pragma unroll
              for (int q = 0; q < 2; ++q) { st_tr(O_Z1T, z[q], tm, tn0 + q, fr, fq, false); st_rows(O_Z2P, y[q], tm, tn0 + q, fr, fq); } }
            __syncthreads();
            { f32x4 g[2], w[2];
              g[0] = ld_rows(O_DINV, tm, tn0, fr, fq); g[1] = ld_rows(O_DINV, tm, tn0 + 1, fr, fq); mm_acc<true>(g, O_DINV, O_Z1T, tm, tn0, fr, fq);
              w[0] = ld_rows(O_Z2P, tm, tn0, fr, fq); w[1] = ld_rows(O_Z2P, tm, tn0 + 1, fr, fq); mm_acc<true>(w, O_Z2P, O_Z1T, tm, tn0, fr, fq);
#pragma unroll
              for (int q = 0; q < 2; ++q) { st_rows(O_G1, g[q], tm, tn0 + q, fr, fq); st_tr(O_WT, w[q], tm, tn0 + q, fr, fq, false); } }
            __syncthreads();
            { f32x4 g[2]; g[0] = ld_rows(O_G1, tm, tn0, fr, fq); g[1] = ld_rows(O_G1, tm, tn0 + 1, fr, fq); mm_acc<true>(g, O_G1, O_WT, tm, tn0, fr, fq);
              st_rows(O_P, g[0], tm, tn0, fr, fq); st_rows(O_P, g[1], tm, tn0 + 1, fr, fq); }
            __syncthreads();
            f32x4 x2[2] = {{0.f, 0.f, 0.f, 0.f}, {0.f, 0.f, 0.f, 0.f}}, x1[2] = {x2[0], x2[0]};
            mm_acc<true>(x2, O_P, O_ATT, tm, tn0, fr, fq); mm_acc<true>(x1, O_P, O_MKA, tm, tn0, fr, fq);
#pragma unroll
            for (int q = 0; q < 2; ++q) { st_rows(O_X2T, x2[q], tm, tn0 + q, fr, fq); st_rows(O_X1T, x1[q], tm, tn0 + q, fr, fq); }
        }
        __syncthreads();
        f32x4 yv[2] = {{0.f, 0.f, 0.f, 0.f}, {0.f, 0.f, 0.f, 0.f}};
        {
            f32x4 uu[2] = {{0.f, 0.f, 0.f, 0.f}, {0.f, 0.f, 0.f, 0.f}};
            mm_acc<true>(uu, O_SB, O_X2T, tm, tn0, fr, fq); mm_acc<true>(uu, O_VT, O_X1T, tm, tn0, fr, fq);
            st_rows(O_U, uu[0], tm, tn0, fr, fq); st_rows(O_U, uu[1], tm, tn0 + 1, fr, fq);
            mm_acc<false>(yv, O_SB, O_RT, tm, tn0, fr, fq); mm_acc<false>(yv, O_VT, O_MKRT, tm, tn0, fr, fq);
        }
        __syncthreads();
        {
#pragma unroll
            for (int q = 0; q < 2; ++q)
#pragma unroll
                for (int e = 0; e < 4; ++e) Sf[q][e] *= wl[q][e];
            mm_acc<true>(Sf, O_U, O_BHT, tm, tn0, fr, fq); mm_acc<true>(Sf, O_VT, O_KHT, tm, tn0, fr, fq);
            st_rows(O_SB, Sf[0], tm, tn0, fr, fq); st_rows(O_SB, Sf[1], tm, tn0 + 1, fr, fq);
            mm_acc<false>(yv, O_U, O_MBRT, tm, tn0, fr, fq);
#pragma unroll
            for (int q = 0; q < 2; ++q) {
                const int u = c * 64 + (tn0 + q) * 16 + fr; const int t = REV ? (SEQ_ - 1 - u) : u;
                u32x2 w; w.x = pk2(yv[q][0], yv[q][1]); w.y = pk2(yv[q][2], yv[q][3]);
                *(u32x2*)(yout + (size_t)(b * SEQ_ + t) * DR_ + h * 64 + tm * 16 + fq * 4) = w;
            }
        }
    }
    __syncthreads();
}

constexpr int NA_KP = 144, NA_P_OFF = 576 * NA_KP  , NA_BIAS_OFF = NA_P_OFF + 8 * 8448  ;
__device__ __forceinline__ void na_unit(const Params& p, int bu) {
    const int tid = opaque_tid(), wave = tid >> 6, lane = tid & 63, fr = lane & 15, fq = lane >> 4;
    const int b = bu >> 9, h = (bu >> 5) & 15, ip = bu & 31;
    LAS unsigned char* L8 = (LAS unsigned char*)dynlds;
    LAS float* rbias = (LAS float*)(L8 + NA_BIAS_OFF);
    LAS bf16_t* Pb = (LAS bf16_t*)(L8 + NA_P_OFF) + wave * (16 * 264);
    const int i0 = ip * 2, rs0 = min(max(i0 - 4, 0), 56);
    const bf16_t* qh = p.QN + (size_t)(b * 16 + h) * SEQ_ * 64; const bf16_t* kh = p.KN + (size_t)(b * 16 + h) * SEQ_ * 64; const bf16_t* vh = p.VT + (size_t)(b * 16 + h) * SEQ_ * 64;
    uint4 vreg[9];
#pragma unroll
    for (int j = 0; j < 9; ++j) {
        const int c = tid + j * NTHREADS;
        const int krow = min(rs0 + (c >> 9), 63), tok = krow * 64 + ((c >> 3) & 63), pc = c & 7;
        const uint4 kv = *(const uint4*)(kh + (size_t)tok * 64 + pc * 8);
        *(LAS u32x4*)(L8 + (unsigned)((c >> 3) * NA_KP + pc * 16)) = (u32x4){kv.x, kv.y, kv.z, kv.w};
        const int vrow = min(rs0 + (c >> 9), 63);
        vreg[j] = *(const uint4*)(vh + ((size_t)(vrow * 8 + ((c >> 6) & 7)) * 64 + (c & 63)) * 8);
    }
    for (int i = tid; i < 465; i += NTHREADS) rbias[i] = p.rel_bias[h * 465 + i];
    __syncthreads();
    const int i = i0 + (wave >> 2), cb = wave & 3;
    const int rs = min(max(i - 4, 0), 56), kc0 = min(max(cb * 16 - 8, 0), 32), lrow = rs - rs0;
    const bf16x8 aq0 = *(const bf16x8*)(qh + (size_t)(i * 64 + cb * 16 + fr) * 64 + fq * 8), aq1 = *(const bf16x8*)(qh + (size_t)(i * 64 + cb * 16 + fr) * 64 + 32 + fq * 8);
    float s[8][2][4];
#pragma unroll
    for (int kr = 0; kr < 8; ++kr)
#pragma unroll
        for (int hh = 0; hh < 2; ++hh) {
            const unsigned ko = (unsigned)(((lrow + kr) * 64 + kc0 + hh * 16 + fr) * NA_KP + fq * 16);
            const bf16x8 bk0 = *(const LAS bf16x8*)(L8 + ko), bk1 = *(const LAS bf16x8*)(L8 + ko + 64);
            f32x4 acc = (f32x4){0.f, 0.f, 0.f, 0.f};
            acc = __builtin_amdgcn_mfma_f32_16x16x32_bf16(aq0, bk0, acc, 0, 0, 0);
            acc = __builtin_amdgcn_mfma_f32_16x16x32_bf16(aq1, bk1, acc, 0, 0, 0);
            const int kc = kc0 + hh * 16 + fr;
#pragma unroll
            for (int jj = 0; jj < 4; ++jj) {
                const int qc = cb * 16 + fq * 4 + jj, wc0 = min(max(qc - 8, 0), 48);
                const unsigned vm = (unsigned)(((wc0 - kc - 1) >> 31) & ((kc - wc0 - 16) >> 31));
                const int bi = (rs + kr - i + 7) * 31 + min(max(kc - qc + 15, 0), 30);
                const float sv = acc[jj] + rbias[bi];
                s[kr][hh][jj] = __uint_as_float((__float_as_uint(sv) & vm) | (0xff800000u & ~vm));
            }
        }
    float mx[4], sm[4];
#pragma unroll
    for (int jj = 0; jj < 4; ++jj) {
        float m = -INFINITY;
#pragma unroll
        for (int kr = 0; kr < 8; ++kr) m = fmaxf(m, fmaxf(s[kr][0][jj], s[kr][1][jj]));
        mx[jj] = red16_max(m);
        float t = 0.f;
#pragma unroll
        for (int kr = 0; kr < 8; ++kr)
#pragma unroll
            for (int hh = 0; hh < 2; ++hh) { const float e = __expf(s[kr][hh][jj] - mx[jj]); s[kr][hh][jj] = e; t += e; }
        sm[jj] = red16_sum(t);
    }
#pragma unroll
    for (int kr = 0; kr < 8; ++kr)
#pragma unroll
        for (int hh = 0; hh < 2; ++hh)
#pragma unroll
            for (int jj = 0; jj < 4; jj += 2) {
                const unsigned w = pk2(s[kr][hh][jj], s[kr][hh][jj + 1]);
                Pb[(fq * 4 + jj) * 264 + kr * 32 + hh * 16 + fr] = (bf16_t)(w & 0xffffu);
                Pb[(fq * 4 + jj + 1) * 264 + kr * 32 + hh * 16 + fr] = (bf16_t)(w >> 16);
            }
    __syncthreads();
#pragma unroll
    for (int j = 0; j < 9; ++j) { const int c = tid + j * NTHREADS; *(LAS u32x4*)(L8 + (unsigned)c * 16) = (u32x4){vreg[j].x, vreg[j].y, vreg[j].z, vreg[j].w}; }
    __syncthreads();
    f32x4 o[4];
#pragma unroll
    for (int dt = 0; dt < 4; ++dt) o[dt] = (f32x4){0.f, 0.f, 0.f, 0.f};
#pragma unroll
    for (int kr = 0; kr < 8; ++kr) {
        const bf16x8 ap = *(const LAS bf16x8*)(Pb + fr * 264 + kr * 32 + fq * 8);
#pragma unroll
        for (int dt = 0; dt < 4; ++dt) {
            const bf16x8 bv = *(const LAS bf16x8*)(L8 + (unsigned)((((lrow + kr) * 8 + (kc0 >> 3) + fq) * 64 + dt * 16 + fr) * 16));
            o[dt] = __builtin_amdgcn_mfma_f32_16x16x32_bf16(ap, bv, o[dt], 0, 0, 0);
        }
    }
#pragma unroll
    for (int jj = 0; jj < 4; ++jj) {
        const float inv = 1.0f / sm[jj];
        bf16_t* orow = p.ycat + ((size_t)b * SEQ_ + i * 64 + cb * 16 + fq * 4 + jj) * D_ + DR_ + h * 64 + fr;
#pragma unroll
        for (int dt = 0; dt < 4; ++dt) orow[dt * 16] = (bf16_t)(pk2(o[dt][jj] * inv, 0.f) & 0xffffu);
    }
    __syncthreads();
}

constexpr int Q_PREP = T_ / 64;
__device__ __forceinline__ void phase_mix(const Params& p) {
    const int G = gridDim.x, bid = blockIdx.x;
    const bool split = (G % 16) == 0;
    if (!split || ((bid >> 3) & 1) == 0) {
        const int sidx = split ? ((bid >> 4) * 8 + (bid & 7)) : bid, nscan = split ? G / 2 : G;
        for (int u = sidx; u < 128; u += nscan) {
            const int b = u >> 5, h = (u >> 1) & 15;
            if (u & 1) scan_unit<true>(p, b, h); else scan_unit<false>(p, b, h);
        }
    }
    const int tid = opaque_tid(), wave = tid >> 6, lane = tid & 63;
    int* qslot = (int*)(dynlds + CTRL_OFF + 512);
    float* scr = (float*)dynlds + wave * 2176;
    __syncthreads();
    if (tid == 0) *qslot = (int)atomicAdd(p.qctr, 1u);
    __syncthreads();
    int it = __builtin_amdgcn_readfirstlane(*qslot);
    bool na_ready = false;
    const int npre = conv_prefilled(G);
    const int C = CVT_ITEMS - npre, n_alt = C < 2048 ? C : 2048, c_lead = C - n_alt;
    const int Q_GL = Q_PREP + 256, Q_LEAD = Q_GL + c_lead, Q_ALT = Q_LEAD + 2 * n_alt, Q_TOTAL = Q_ALT + (2048 - n_alt);
    while (it < Q_TOTAL) {
        __syncthreads();
        unsigned nxt = 0u;
        if (tid == 0) nxt = atomicAdd(p.qctr, 1u);
        int kind, idx;
        if (it < Q_PREP) { kind = 0; idx = it; }
        else if (it < Q_GL) { kind = 3; idx = it - Q_PREP; }
        else if (it < Q_LEAD) { kind = 1; idx = it - Q_GL; }
        else if (it < Q_ALT) { const int k2 = it - Q_LEAD; kind = 1 + (k2 & 1); idx = (k2 & 1) ? (k2 >> 1) : c_lead + (k2 >> 1); }
        else { kind = 2; idx = n_alt + (it - Q_ALT); }
        if (kind == 0) {
            prep_na_tile(p, idx * 64);
            asm volatile("s_waitcnt vmcnt(0)" ::: "memory");
            __syncthreads();
            if (tid == 0) { __builtin_amdgcn_fence(__ATOMIC_RELEASE, "agent"); asm volatile("s_waitcnt vmcnt(0)" ::: "memory"); (void)xb_add(p.qctr + 32, 1u); }
        } else if (kind == 1) {
            const int wt = (idx + npre) * 32 + __builtin_amdgcn_readfirstlane(wave) * 4;
            float tv0[32], tv1[32];
            cvt_expert_load(p, wt, tv0, lane); cvt_expert_load(p, wt + 1, tv1, lane);
            cvt_expert_finish(p, wt, tv0, scr, lane); cvt_expert_load(p, wt + 2, tv0, lane);
            cvt_expert_finish(p, wt + 1, tv1, scr, lane); cvt_expert_load(p, wt + 3, tv1, lane);
            cvt_expert_finish(p, wt + 2, tv0, scr, lane); cvt_expert_finish(p, wt + 3, tv1, scr, lane);
        } else if (kind == 3) {
            const int j = idx, pm = j >> 2, pn = 16 + (j & 3);
            unsigned aoff[4]; dense_aoff(aoff, pm * 256, 512 * 2);
            EpiLora epi{p.LO, p.lbias, pm * 256, pn * 256};
            gemm_unit<false>((const char*)p.Alora + 4 * BK * 2, aoff, (const char*)(p.Wlora + (size_t)pn * 256 * 512) + 4 * BK * 2, 512 * 2, epi, 4);
        } else {
            if (!na_ready) {
                if (tid == 0) {
                    unsigned sp = 0u;
                    while (xb_ld(p.qctr + 32) < (unsigned)Q_PREP) { __builtin_amdgcn_s_sleep(2); if (++sp > (1u << 22)) break; }
                    __builtin_amdgcn_fence(__ATOMIC_ACQUIRE, "agent");
                    asm volatile("s_waitcnt vmcnt(0)" ::: "memory");
                }
                __syncthreads();
                na_ready = true;
            }
            na_unit(p, idx);
        }
        if (tid == 0) *qslot = (int)nxt;
        __syncthreads();
        it = __builtin_amdgcn_readfirstlane(*qslot);
    }
    __syncthreads();
}

__device__ __forceinline__ void phase_combine(const Params& p) {
    const bf16_t* yf = p.H; const bf16_t* yb = p.H + (size_t)T_ * DR_;
    const bf16_t* af = p.LO + (size_t)2 * T_ * DR_; const bf16_t* gg = p.LO + (size_t)4 * T_ * DR_;
    const int stride = gridDim.x * NTHREADS, total = T_ * 128;
    int it = blockIdx.x * NTHREADS + threadIdx.x;
    u32x4 q[7];
    {
        const size_t o = (size_t)(it >> 7) * DR_ + (it & 127) * 8;
        q[0] = *(const u32x4*)(yf + o); q[1] = *(const u32x4*)(yb + o); q[2] = *(const u32x4*)(p.rb + o); q[3] = *(const u32x4*)(p.kb + o);
        q[4] = *(const u32x4*)(af + o); q[5] = *(const u32x4*)(p.vb + o); q[6] = *(const u32x4*)(gg + o);
    }
    for (; it < total; it += stride) {
        const int t = it >> 7, ch = (it & 127) * 8;
        const int itn = (it + stride < total) ? it + stride : it;
        u32x4 qn[7];
        {
            const size_t o = (size_t)(itn >> 7) * DR_ + (itn & 127) * 8;
            qn[0] = *(const u32x4*)(yf + o); qn[1] = *(const u32x4*)(yb + o); qn[2] = *(const u32x4*)(p.rb + o); qn[3] = *(const u32x4*)(p.kb + o);
            qn[4] = *(const u32x4*)(af + o); qn[5] = *(const u32x4*)(p.vb + o); qn[6] = *(const u32x4*)(gg + o);
        }
        float a[8], b[8], r[8], k[8], av[8], v[8], g[8], y[8];
#define UQ(i, dst) unpack8(make_uint4(q[i].x, q[i].y, q[i].z, q[i].w), dst)
        UQ(0, a); UQ(1, b); UQ(2, r); UQ(3, k); UQ(4, av); UQ(5, v); UQ(6, g);
#undef UQ
        float s1 = 0.f, bs = 0.f;
#pragma unroll
        for (int j = 0; j < 8; ++j) {
            y[j] = a[j] + b[j]; s1 += y[j];
            const float kf = k[j] * (1.0f + (av[j] - 1.0f) * p.k_a[ch + j]);
            bs += r[j] * kf * p.r_k[ch + j];
        }
        s1 = red8_sum(s1); bs = red8_sum(bs);
        const float mu = s1 * (1.0f / 64.0f);
        float s2 = 0.f;
#pragma unroll
        for (int j = 0; j < 8; ++j) { const float d = y[j] - mu; s2 += d * d; }
        s2 = red8_sum(s2);
        const float rstd = rsqrtf(s2 * (1.0f / 64.0f) + 64e-5f);
        float outv[8];
#pragma unroll
        for (int j = 0; j < 8; ++j) outv[j] = ((y[j] - mu) * rstd * p.ln_w[ch + j] + p.ln_b[ch + j] + bs * v[j]) * g[j];
        *(uint4*)(p.ycat + (size_t)t * D_ + ch) = pack8(outv);
#pragma unroll
        for (int i = 0; i < 7; ++i) q[i] = qn[i];
    }
}

__device__ __forceinline__ unsigned long long route_row(float logit, float rbias, int lane, float* gwv) {
    const float score = sigmoidf_(logit);
    const float bsd = score + rbias;
    const float m1 = red8_max(bsd);
    const unsigned long long eq = __ballot(bsd == m1);
    const unsigned gm = (unsigned)(eq >> (lane & 56)) & 0xffu;
    const int first = __ffs(gm) - 1;
    const float ex = ((lane & 7) == first) ? -INFINITY : bsd;
    const float m2 = red8_max(ex);
    const float gs = m1 + m2;
    const int g = lane >> 3; int rank = 0;
#pragma unroll
    for (int gp = 0; gp < 8; ++gp) { const float o = __shfl(gs, gp * 8); rank += ((o > gs) || (o == gs && gp < g)) ? 1 : 0; }
    float cur = (rank < 4) ? bsd : -INFINITY;
    unsigned long long sel = 0ull;
#pragma unroll 1
    for (int itk = 0; itk < TOPK; ++itk) {
        const float mxv = wave_max(cur);
        const unsigned long long em = __ballot(cur == mxv);
        const int idx = __ffsll((long long)em) - 1;
        sel |= 1ull << idx;
        if (lane == idx) cur = -INFINITY;
    }
    const bool me = (sel >> lane) & 1ull;
    const float ssum = wave_sum(me ? score : 0.f);
    *gwv = score / ssum * 2.5f;
    return sel;
}

__device__ __forceinline__ void phase_norm2_router(const Params& p) {
    const int tid = opaque_tid(), wave = tid >> 6, lane = tid & 63, fr = lane & 15, fq = lane >> 4;
    constexpr int HP = 260;
    float* hsl = (float*)dynlds;
    float* lg = hsl + 64 * HP;
    const float rbias = p.router_bias[lane];
    const int rt = wave >> 1, eh = wave & 1;
    for (int u = blockIdx.x; u < T_ / 64; u += gridDim.x) {
        const int row0 = u * 64 + wave * 8, b = row0 >> 12;
        const float* modb = p.mod + b * 12288;
        float rstd[8];
#pragma unroll
        for (int r = 0; r < 8; ++r) {
            const float v = (lane < 32) ? p.ssq[(size_t)(row0 + r) * 32 + lane] : 0.f;
            rstd[r] = rsqrtf(wave_sum(v) * (1.0f / D_) + 1e-6f);
        }
        f32x4 lacc[2]; lacc[0] = (f32x4){0.f, 0.f, 0.f, 0.f}; lacc[1] = lacc[0];
        float* Bs = lg + 64 * 65;
        const int bk0 = tid >> 4, bq4 = (tid & 15) * 4, bdq = bq4 ^ ((bk0 & 3) * 16);
        f32x4 xq[8], bq[8]; float4 nwq, shq, scq;
#define P8_PREFETCH(slv) { const int kbp = (slv) * 256 + lane * 4; \
            nwq = *(const float4*)(p.norm2_w + kbp); shq = *(const float4*)(modb + 6144 + kbp); scq = *(const float4*)(modb + 8192 + kbp); \
            _Pragma("unroll") for (int r = 0; r < 8; ++r) xq[r] = *(const f32x4*)(p.out + (size_t)(row0 + r) * D_ + kbp); \
            _Pragma("unroll") for (int j = 0; j < 8; ++j) bq[j] = *(const f32x4*)(p.w_router + (size_t)((slv) * 256 + bk0 + j * 32) * NEXP + bq4); }
        P8_PREFETCH(0)
#pragma unroll 1
        for (int sl = 0; sl < 8; ++sl) {
            const int kb = sl * 256 + lane * 4;
            const float4 g4 = make_float4(nwq.x * (1.f + scq.x), nwq.y * (1.f + scq.y), nwq.z * (1.f + scq.z), nwq.w * (1.f + scq.w)), sh = shq;
            __syncthreads();
#pragma unroll
            for (int r = 0; r < 8; ++r) {
                const f32x4 xv = xq[r];
                float4 hv; hv.x = xv.x * rstd[r] * g4.x + sh.x; hv.y = xv.y * rstd[r] * g4.y + sh.y; hv.z = xv.z * rstd[r] * g4.z + sh.z; hv.w = xv.w * rstd[r] * g4.w + sh.w;
                *(unsigned*)(p.H8 + (size_t)(row0 + r) * D_ + kb) = pk4_fp8(hv.x, hv.y, hv.z, hv.w);
                *(float4*)(hsl + (wave * 8 + r) * HP + lane * 4) = hv;
            }
#pragma unroll
            for (int j = 0; j < 8; ++j) *(f32x4*)(Bs + (bk0 + j * 32) * NEXP + bdq) = bq[j];
            if (sl + 1 < 8) P8_PREFETCH(sl + 1)
            __syncthreads();
            const float* ap = hsl + (rt * 16 + fr) * HP + fq;
            const float* b0p = Bs + fq * NEXP + ((eh * 32 + fr) ^ (fq * 16));
            const float* b1p = Bs + fq * NEXP + ((eh * 32 + 16 + fr) ^ (fq * 16));
#pragma unroll 16
            for (int k4 = 0; k4 < 64; ++k4) {
                const float av = ap[k4 * 4];
                const float b0 = b0p[k4 * 4 * NEXP], b1 = b1p[k4 * 4 * NEXP];
                lacc[0] = __builtin_amdgcn_mfma_f32_16x16x4f32(av, b0, lacc[0], 0, 0, 0);
                lacc[1] = __builtin_amdgcn_mfma_f32_16x16x4f32(av, b1, lacc[1], 0, 0, 0);
            }
        }
#pragma unroll
        for (int nt = 0; nt < 2; ++nt)
#pragma unroll
            for (int jj = 0; jj < 4; ++jj) lg[(rt * 16 + fq * 4 + jj) * 65 + eh * 32 + nt * 16 + fr] = lacc[nt][jj];
        int* lcnt = (int*)(dynlds + CTRL_OFF + 64); int* lbase = lcnt + 64;
        __syncthreads();
        if (tid < 64) lcnt[tid] = 0;
        __syncthreads();
        unsigned long long selm[8]; int lrank[8]; float gwr[8];
#pragma unroll
        for (int r = 0; r < 8; ++r) {
            selm[r] = route_row(lg[(wave * 8 + r) * 65 + lane], rbias, lane, &gwr[r]);
            lrank[r] = 0;
            if ((selm[r] >> lane) & 1ull) lrank[r] = atomicAdd(lcnt + lane, 1);
        }
        __syncthreads();
        if (tid < 64) lbase[tid] = (int)atomicAdd(p.cnt + tid * 64, (unsigned)lcnt[tid]);
        __syncthreads();
        const int mybase = lbase[lane];
#pragma unroll
        for (int r = 0; r < 8; ++r) {
            if ((selm[r] >> lane) & 1ull) {
                const int kidx = __popcll(selm[r] & ((1ull << lane) - 1ull));
                const unsigned slot = (unsigned)(row0 + r) * NSLOT + kidx;
                p.list[(size_t)lane * LIST_CAP + mybase + lrank[r]] = slot;
                p.gw[(size_t)lane * LIST_CAP + mybase + lrank[r]] = gwr[r];
            }
        }
    }
}

__device__ __forceinline__ int build_tile_table(const Params& p, int* tstart) {
    __syncthreads();
    if (threadIdx.x == 0) {
        int s = 0;
        for (int e = 0; e < NEXP; ++e) { tstart[e] = s; s += ((int)p.cnt[e * 64] + 255) >> 8; }
        tstart[NEXP] = s;
    }
    __syncthreads();
    return tstart[NEXP];
}

__device__ __forceinline__ void phase_moe_up(const Params& p) {
    int* s_tstart = (int*)(dynlds + CTRL_OFF + 64);
    const int R = build_tile_table(p, s_tstart);
    const int nunits = (R + T_ / 256) * 4;
    const int tid = opaque_tid();
    int R0, C0, R1, C1; stage_rc(tid * 16, R0, C0); stage_rc(tid * 16 + 8192, R1, C1);
    int e = 0;
    for (int u = blockIdx.x; u < nunits; u += gridDim.x) {
        const int mt = u >> 2, nt = u & 3;
        unsigned aoff[4]; const fp8_t* Bt;
        if (mt < R) {
            while (s_tstart[e + 1] <= mt) ++e;
            const int r0 = (mt - s_tstart[e]) * 256, cnt = (int)p.cnt[e * 64];
            const unsigned* lst = p.list + (size_t)e * LIST_CAP;
            const int lr[4] = {R0, R1, 128 + R0, 128 + R1}; const int lc[4] = {C0, C1, C0, C1};
#pragma unroll
            for (int q = 0; q < 4; ++q) { const int rr = r0 + lr[q]; const unsigned v = lst[rr < LIST_CAP ? rr : LIST_CAP - 1]; const unsigned tok = rr < cnt ? v / NSLOT : 0u; aoff[q] = tok * D_ + lc[q] * 2; }
            Bt = p.We1q + (size_t)e * 1024 * D_ + (size_t)nt * 256 * D_;
        } else {
            dense_aoff(aoff, (mt - R) * 256, D_);
            Bt = p.Ws1q + (size_t)nt * 256 * D_;
        }
        EpiGateUp epi{p.actq, (size_t)mt * 256, nt * 128};
        gemm_unit<true>(p.H8, aoff, Bt, D_, epi);
    }
}

__device__ __forceinline__ void phase_moe_down(const Params& p) {
    int* s_tstart2 = (int*)(dynlds + CTRL_OFF + 64);
    const int R = build_tile_table(p, s_tstart2);
    const int nunits = (R + T_ / 256) * 8;
    int e = 0;
    bool staged = false;
    for (int u = blockIdx.x; u < nunits; u += gridDim.x) {
        const int mt = u >> 3, nt = u & 7;
        unsigned aoff[4]; dense_aoff(aoff, 0, EFF);
        if (mt < R) { while (s_tstart2[e + 1] <= mt) ++e; }
        const int un = u + gridDim.x, mtn = un >> 3, ntn = un & 7; const bool has_next = un < nunits;
        int en = e;
        if (has_next && mtn < R) { while (s_tstart2[en + 1] <= mtn) ++en; }
        const fp8_t* nA = p.actq + (size_t)mtn * 256 * EFF;
        const fp8_t* nB = (mtn < R) ? p.We2q + (size_t)en * D_ * EFF + (size_t)ntn * 256 * EFF : p.Ws2q + (size_t)ntn * 256 * EFF;
        const fp8_t* cA = p.actq + (size_t)mt * 256 * EFF;
        if (mt < R) {
            const int r0 = (mt - s_tstart2[e]) * 256;
            EpiDownRouted<true> epi{p.slot, p.list + (size_t)e * LIST_CAP, p.gw + (size_t)e * LIST_CAP, r0, (int)p.cnt[e * 64], nt * 256};
            gemm_unit_pre<true, 8>(cA, aoff, p.We2q + (size_t)e * D_ * EFF + (size_t)nt * 256 * EFF, EFF, epi, staged, has_next, nA, nB);
        } else {
            EpiDownRouted<false> epi{p.slot, nullptr, p.gw, (mt - R) * 256, T_, nt * 256};
            gemm_unit_pre<true, 8>(cA, aoff, p.Ws2q + (size_t)nt * 256 * EFF, EFF, epi, staged, has_next, nA, nB);
        }
        staged = has_next;
    }
}

__device__ __forceinline__ void phase_final(const Params& p) {
    for (int it = blockIdx.x * NTHREADS + opaque_tid(); it < T_ * (D_ / 8); it += gridDim.x * NTHREADS) {
        const int t = it >> 8, c = (it & 255) * 8;
        float acc[8];
#pragma unroll
        for (int j = 0; j < 8; ++j) acc[j] = 0.f;
#pragma unroll
        for (int k = 0; k < NSLOT; ++k) {
            const u32x2 w = *(const u32x2*)(p.slot + ((size_t)t * NSLOT + k) * D_ + c);
            const f32x2 a0 = __builtin_amdgcn_cvt_pk_f32_fp8(w.x, false), a1 = __builtin_amdgcn_cvt_pk_f32_fp8(w.x, true), a2 = __builtin_amdgcn_cvt_pk_f32_fp8(w.y, false), a3 = __builtin_amdgcn_cvt_pk_f32_fp8(w.y, true);
            acc[0] += a0.x; acc[1] += a0.y; acc[2] += a1.x; acc[3] += a1.y; acc[4] += a2.x; acc[5] += a2.y; acc[6] += a3.x; acc[7] += a3.y;
        }
#pragma unroll
        for (int j = 0; j < 8; ++j) acc[j] *= (1.0f / SLOT_SCALE);
        const float* gate = p.mod + (t >> 12) * 12288 + 10240 + c;
        const f32x4 g0 = *(const f32x4*)gate, g1 = *(const f32x4*)(gate + 4);
        float* op = p.out + (size_t)t * D_ + c;
        const f32x4 x0 = *(const f32x4*)op, x1 = *(const f32x4*)(op + 4);
        *(f32x4*)op = x0 + g0 * (f32x4){acc[0], acc[1], acc[2], acc[3]};
        *(f32x4*)(op + 4) = x1 + g1 * (f32x4){acc[4], acc[5], acc[6], acc[7]};
    }
}

constexpr int N_PHASES = 12;
__global__ void __launch_bounds__(NTHREADS, 2) fwd_kernel(Params p) {
    LAS unsigned* xbw = (LAS unsigned*)(dynlds + CTRL_OFF);
    if (threadIdx.x == 0) { xbw[0] = 0u; xbw[1] = 0u; xbw[2] = 0u; xbw[3] = 0u; }
    __syncthreads();
    const int lo = (int)p.ph_lo, hi = (int)p.ph_hi;
    const bool multi = (hi - lo) > 1;
    XcdBarrier bar; bar.bar = p.bar; bar.x = 0; bar.st = (volatile LAS unsigned*)xbw;
    if (multi) bar = xcd_barrier_post(p.bar, (volatile LAS unsigned*)xbw);
#ifdef ONLY_PHASE
#define PHASE(k, call) if ((k) == ONLY_PHASE) { if (lo <= (k) && (k) < hi) { call; if ((k) + 1 < hi) xcd_barrier(bar); } }
#else
#define PHASE(k, call) if (lo <= (k) && (k) < hi) { call; if (DUP_PHASE == (k)) { xcd_barrier(bar); call; } if ((k) + 1 < hi) xcd_barrier(bar); }
#endif
    PHASE(0, phase_prologue(p))
    PHASE(1, phase_norm1(p))
    PHASE(2, phase_gemm_in(p))
    PHASE(3, phase_prep(p))
    PHASE(4, phase_gemm_lora(p))
    PHASE(5, phase_mix(p))
    PHASE(6, phase_combine(p))
    PHASE(7, phase_gemm_out(p))
    PHASE(8, phase_norm2_router(p))
    PHASE(9, phase_moe_up(p))
    PHASE(10, phase_moe_down(p))
    PHASE(11, phase_final(p))
#undef PHASE
}

static inline size_t al256(size_t x) { return (x + 255) & ~(size_t)255; }

extern "C" void kernel_launch(void* const* d_in, const int* in_sizes, int n_in, void* d_out, int out_size, void* d_ws, size_t ws_size, hipStream_t stream) {
    static int grid = 0;
    size_t off = 0;
    const size_t o_bar = off;   off = al256(off + XCD_BAR_WORDS * 4);
    const size_t o_mod = off;   off = al256(off + (size_t)NB_ * 12288 * 4);
    const size_t o_cnt = off;   off = al256(off + NEXP * 256 + 256);
    const size_t o_lbias = off; off = al256(off + 4 * DR_ * 4);
    const size_t o_wlora = off; off = al256(off + (size_t)5120 * 512 * 2);
    const size_t zero_end = off;
    const size_t o_we1 = off;   off = al256(off + (size_t)NEXP * 1024 * D_ * 2);
    const size_t o_we2 = off;   off = al256(off + (size_t)NEXP * D_ * EFF * 2);
    const size_t o_ws1 = off;   off = al256(off + (size_t)1024 * D_ * 2);
    const size_t o_ws2 = off;   off = al256(off + (size_t)D_ * EFF * 2);
    const size_t o_h = off;     off = al256(off + (size_t)T_ * D_ * 2);
    const size_t o_ssq = off;   off = al256(off + (size_t)T_ * 32 * 4);
    const size_t arena = off;
    size_t m = arena;
    const size_t o_win = m;   m = al256(m + (size_t)NPROJ * D_ * 2);
    const size_t o_wout = m;  m = al256(m + (size_t)D_ * D_ * 2);
    const size_t o_proj = m;  m = al256(m + (size_t)T_ * NPROJ * 2);
    const size_t o_alora = m; m = al256(m + (size_t)T_ * 512 * 2);
    const size_t o_qn = m;    m = al256(m + (size_t)T_ * DR_ * 2);
    const size_t o_kn = m;    m = al256(m + (size_t)T_ * DR_ * 2);
    const size_t o_vt = m;    m = al256(m + (size_t)T_ * DR_ * 2);
    const size_t o_ycat = m;  m = al256(m + (size_t)T_ * D_ * 2);
    const size_t o_lo = m;    m = al256(m + (size_t)5 * T_ * DR_ * 2);
    size_t f = arena;
    const size_t o_slot = f;  f = al256(f + (size_t)T_ * NSLOT * D_ * 2);
    const size_t o_act = f;   f = al256(f + (size_t)(T_ * TOPK + NEXP * 256 + T_) * EFF * 2);
    const size_t o_list = f;  f = al256(f + (size_t)NEXP * LIST_CAP * 4);
    const size_t o_gw = f;    f = al256(f + (size_t)NEXP * LIST_CAP * 4);
    const size_t ws_need = m > f ? m : f;

    if (grid == 0) {
        if (n_in != 34 || out_size != T_ * D_ || ws_size < ws_need) { fprintf(stderr, "kernel_launch: unexpected problem (n_in %d, out %d, ws %zu, need %zu)\n", n_in, out_size, ws_size, ws_need); grid = -1; return; }
        int dev = 0, cus = 0;
        if (hipGetDevice(&dev) != hipSuccess || hipDeviceGetAttribute(&cus, hipDeviceAttributeMultiprocessorCount, dev) != hipSuccess) { grid = -1; return; }
        if (hipFuncSetAttribute((const void*)fwd_kernel, hipFuncAttributeMaxDynamicSharedMemorySize, DYN_LDS) != hipSuccess) { fprintf(stderr, "kernel_launch: hipFuncSetAttribute failed\n"); grid = -1; return; }
        int per_cu = 0;
        (void)hipOccupancyMaxActiveBlocksPerMultiprocessor(&per_cu, (const void*)fwd_kernel, NTHREADS, DYN_LDS);
        (void)hipGetLastError();
        if (per_cu < 1) fprintf(stderr, "kernel_launch: occupancy query reports %d blocks per CU\n", per_cu);
        grid = cus;
    }
    if (grid < 0) return;
    char* ws = (char*)d_ws;
    hipMemsetAsync(ws, 0, zero_end, stream);
    Params p{};
    const float* const* in = (const float* const*)d_in;
    p.x = in[0]; p.c = in[1]; p.w_ada = in[2]; p.b_ada = in[3]; p.norm1_w = in[4]; p.w_in = in[5]; p.rwkv_shift = in[6]; p.w0_f = in[7]; p.w_up_f = in[8];
    p.w0_b = in[9]; p.w_up_b = in[10]; p.a0_f = in[11]; p.a_up_f = in[12]; p.a0_b = in[13]; p.a_up_b = in[14]; p.g_up = in[15]; p.k_k = in[16]; p.k_a = in[17];
    p.r_k = in[18]; p.ln_w = in[19]; p.ln_b = in[20]; p.qn_w = in[21]; p.kn_w = in[22]; p.rel_bias = in[23]; p.w_out = in[24]; p.norm2_w = in[25];
    p.w_router = in[26]; p.router_bias = in[27]; p.w_gate_e = in[28]; p.w_up_e = in[29]; p.w_down_e = in[30]; p.w_gate_s = in[31]; p.w_up_s = in[32]; p.w_down_s = in[33];
    p.out = (float*)d_out;
    p.bar = (unsigned*)(ws + o_bar); p.mod = (float*)(ws + o_mod); p.cnt = (unsigned*)(ws + o_cnt); p.qctr = p.cnt + NEXP * 64; p.lbias = (float*)(ws + o_lbias);
    p.Wlora = (bf16_t*)(ws + o_wlora); p.We1q = (fp8_t*)(ws + o_we1); p.We2q = (fp8_t*)(ws + o_we2); p.Ws1q = (fp8_t*)(ws + o_ws1); p.Ws2q = (fp8_t*)(ws + o_ws2); p.H8 = (fp8_t*)(ws + o_h);
    p.H = (bf16_t*)(ws + o_h); p.Win = (bf16_t*)(ws + o_win); p.Wout = (bf16_t*)(ws + o_wout); p.proj = (bf16_t*)(ws + o_proj); p.LO = (bf16_t*)(ws + o_lo);
    p.Alora = (bf16_t*)(ws + o_alora); p.QN = (bf16_t*)(ws + o_qn); p.KN = (bf16_t*)(ws + o_kn); p.VT = (bf16_t*)(ws + o_vt); p.ycat = (bf16_t*)(ws + o_ycat);
    p.rb = (bf16_t*)d_out; p.kb = p.rb + (size_t)T_ * DR_; p.vb = p.kb + (size_t)T_ * DR_; p.kkb = p.vb + (size_t)T_ * DR_;
    p.slot = (fp8_t*)(ws + o_slot); p.actq = (fp8_t*)(ws + o_act); p.list = (unsigned*)(ws + o_list); p.gw = (float*)(ws + o_gw);
    p.ssq = (float*)(ws + o_ssq);
#if N_LAUNCH_SPLIT
    for (int k = 0; k < N_PHASES; ++k) {
        p.ph_lo = k; p.ph_hi = k + 1;
        hipLaunchKernelGGL(fwd_kernel, dim3(grid), dim3(NTHREADS), DYN_LDS, stream, p);
    }
#else
    p.ph_lo = 0; p.ph_hi = N_PHASES;
    hipLaunchKernelGGL(fwd_kernel, dim3(grid), dim3(NTHREADS), DYN_LDS, stream, p);
#endif
    (void)in_sizes;
}
```
